# Optimizing an MI355X kernel written in HIP

```python
import jax, jax.numpy as jnp
from jax import lax
import numpy as np

D_MODEL = 4096
BATCH = 2
SEQ = 8192
DEPTH = 1

EPS = 1e-6
ROPE_THETA = 10000.0

MLA_HEADS = 16
MLA_Q_LORA = 1024
MLA_KV_LORA = 512
MLA_NOPE_DIM = 128
MLA_ROPE_DIM = 64
MLA_QK_DIM = MLA_NOPE_DIM + MLA_ROPE_DIM
MLA_V_DIM = 128
MLA_WIDTH = MLA_HEADS * MLA_V_DIM
Q_BLK = 128

GLA_HEADS = 4
GLA_V_WIDTH = D_MODEL - MLA_WIDTH
GLA_K_WIDTH = GLA_V_WIDTH // 2
GLA_HEAD_K = GLA_K_WIDTH // GLA_HEADS
GLA_HEAD_V = GLA_V_WIDTH // GLA_HEADS
GLA_GATE_RANK = 16
GLA_GATE_TAU = 16.0
GLA_CHUNK = 64

MIX_WIDTH = MLA_WIDTH + GLA_V_WIDTH
IN_SIZES = (MLA_Q_LORA, MLA_KV_LORA, MLA_ROPE_DIM, GLA_K_WIDTH, GLA_K_WIDTH, GLA_V_WIDTH, GLA_GATE_RANK, GLA_V_WIDTH)
IN_WIDTH = int(sum(IN_SIZES))
IN_SPLIT_POINTS = tuple(int(c) for c in np.cumsum(IN_SIZES)[:-1])

MEM_TOKENS = 256
XATTN_HEADS = 4
XATTN_HEAD_DIM = 256
XATTN_WIDTH = XATTN_HEADS * XATTN_HEAD_DIM

PEER_HEADS = 8
PEER_N_KEYS = 128
PEER_N_EXPERTS = PEER_N_KEYS * PEER_N_KEYS
PEER_QUERY_DIM = 256
PEER_HALF = PEER_QUERY_DIM // 2
PEER_TOPK = 16
PEER_TOK_BLK = 64

kernel_name = 'hybrid_mla_gla_peer_block'


def rms_norm(x, g):
    xf = x.astype(jnp.float32)
    y = xf * lax.rsqrt(jnp.mean(xf * xf, axis=-1, keepdims=True) + EPS)
    return (y * g.astype(jnp.float32)).astype(x.dtype)


def apply_rope(x, positions):
    d = x.shape[-1]
    inv_freq = ROPE_THETA ** (-jnp.arange(0, d, 2, dtype=jnp.float32) / d)
    ang = positions.astype(jnp.float32)[:, :, None] * inv_freq
    cos = jnp.cos(ang)[:, :, None, :]
    sin = jnp.sin(ang)[:, :, None, :]
    x1, x2 = jnp.split(x.astype(jnp.float32), 2, axis=-1)
    return jnp.concatenate([x1 * cos - x2 * sin, x2 * cos + x1 * sin], axis=-1).astype(x.dtype)


def causal_block_attention(q, k, v, scale):
    seq = q.shape[1]
    outs = []
    for blk in range(seq // Q_BLK):
        lo, hi = blk * Q_BLK, (blk + 1) * Q_BLK
        s = jnp.einsum('bqhd,bkhd->bhqk', q[:, lo:hi], k[:, :hi]).astype(jnp.float32) * scale
        mask = jnp.arange(hi)[None, :] <= jnp.arange(lo, hi)[:, None]
        s = jnp.where(mask, s, -jnp.inf)
        p = jax.nn.softmax(s, axis=-1).astype(v.dtype)
        outs.append(jnp.einsum('bhqk,bkhd->bqhd', p, v[:, :hi]))
    return jnp.concatenate(outs, axis=1)


def gla_chunked(q, k, v, g):
    B, S, H, dk = q.shape
    dv = v.shape[-1]
    C = GLA_CHUNK
    N = S // C

    def to_chunks(t):
        return t.reshape(B, N, C, H, t.shape[-1]).transpose(0, 3, 1, 2, 4)

    q, k, v, g = to_chunks(q), to_chunks(k), to_chunks(v), to_chunks(g)
    b = jnp.cumsum(g, axis=3)
    b_last = b[:, :, :, -1:, :]
    qe = q * (dk ** -0.5) * jnp.exp(b)
    ke = k * jnp.exp(-b)
    kd = k * jnp.exp(b_last - b)
    causal = jnp.tril(jnp.ones((C, C), dtype=bool))
    att = jnp.where(causal, jnp.einsum('bhncd,bhnjd->bhncj', qe, ke), 0.0)
    o_intra = jnp.einsum('bhncj,bhnjv->bhncv', att, v)

    def step(state, inp):
        qe_n, kd_n, v_n, dec_n = inp
        o_n = jnp.einsum('bhcd,bhdv->bhcv', qe_n, state)
        state = state * dec_n[..., None] + jnp.einsum('bhcd,bhcv->bhdv', kd_n, v_n)
        return state, o_n

    xs = (jnp.moveaxis(qe, 2, 0), jnp.moveaxis(kd, 2, 0), jnp.moveaxis(v, 2, 0),
          jnp.moveaxis(jnp.exp(b_last[:, :, :, 0, :]), 2, 0))
    state0 = jnp.zeros((B, H, dk, dv), jnp.float32)
    _, o_inter = lax.scan(step, state0, xs)
    o = o_intra + jnp.moveaxis(o_inter, 0, 2)
    return o.transpose(0, 2, 3, 1, 4).reshape(B, S, H, dv)


def hybrid_mixer(xn, positions, w_in, mla_q_norm, w_uq, mla_kv_norm, w_ukv, mla_out_norm,
                 w_gate_up, b_gate, gla_out_norm, w_out):
    B, S, _ = xn.shape
    h = xn @ w_in
    c_q, c_kv, k_r, g_q, g_k, g_v, g_lr, g_og = jnp.split(h, IN_SPLIT_POINTS, axis=-1)

    q = (rms_norm(c_q, mla_q_norm) @ w_uq).reshape(B, S, MLA_HEADS, MLA_QK_DIM)
    q_full = jnp.concatenate([q[..., :MLA_NOPE_DIM], apply_rope(q[..., MLA_NOPE_DIM:], positions)], axis=-1)
    kv = (rms_norm(c_kv, mla_kv_norm) @ w_ukv).reshape(B, S, MLA_HEADS, MLA_NOPE_DIM + MLA_V_DIM)
    k_nope, v_mla = kv[..., :MLA_NOPE_DIM], kv[..., MLA_NOPE_DIM:]
    k_rope = apply_rope(k_r[:, :, None, :], positions)
    k_full = jnp.concatenate([k_nope, jnp.broadcast_to(k_rope, (B, S, MLA_HEADS, MLA_ROPE_DIM))], axis=-1)
    o_mla = causal_block_attention(q_full, k_full, v_mla, MLA_QK_DIM ** -0.5).reshape(B, S, MLA_WIDTH)
    o_mla = rms_norm(o_mla, mla_out_norm)

    log_a = jax.nn.log_sigmoid((g_lr @ w_gate_up + b_gate).astype(jnp.float32)) / GLA_GATE_TAU
    f32 = jnp.float32
    o_gla = gla_chunked(g_q.astype(f32).reshape(B, S, GLA_HEADS, GLA_HEAD_K),
                        g_k.astype(f32).reshape(B, S, GLA_HEADS, GLA_HEAD_K),
                        g_v.astype(f32).reshape(B, S, GLA_HEADS, GLA_HEAD_V),
                        log_a.reshape(B, S, GLA_HEADS, GLA_HEAD_K))
    o_gla = rms_norm(o_gla, gla_out_norm).reshape(B, S, GLA_V_WIDTH) * jax.nn.silu(g_og.astype(f32))

    mixed = jnp.concatenate([o_mla, o_gla.astype(xn.dtype)], axis=-1)
    return mixed @ w_out


def memory_cross_attention(xn, mn, w_cq, w_ck, w_cv, w_co):
    B, S, _ = xn.shape
    M = mn.shape[1]
    q = (xn @ w_cq).reshape(B, S, XATTN_HEADS, XATTN_HEAD_DIM)
    k = (mn @ w_ck).reshape(B, M, XATTN_HEADS, XATTN_HEAD_DIM)
    v = (mn @ w_cv).reshape(B, M, XATTN_HEADS, XATTN_HEAD_DIM)
    s = jnp.einsum('bshd,bmhd->bhsm', q, k).astype(jnp.float32) * (XATTN_HEAD_DIM ** -0.5)
    p = jax.nn.softmax(s, axis=-1).astype(v.dtype)
    o = jnp.einsum('bhsm,bmhd->bshd', p, v).reshape(B, S, XATTN_WIDTH)
    return o @ w_co


def peer_ffn(xn, w_peer_q, peer_sub_keys, peer_u, peer_v):
    B, S, D = xn.shape
    q = (xn @ w_peer_q).reshape(B, S, PEER_HEADS, 2, PEER_HALF)
    s = jnp.einsum('bshpd,hpnd->bshpn', q, peer_sub_keys).astype(jnp.float32)
    top_s, top_i = lax.top_k(s, PEER_TOPK)
    cand = top_s[..., 0, :, None] + top_s[..., 1, None, :]
    cand_s, cand_i = lax.top_k(cand.reshape(B, S, PEER_HEADS, PEER_TOPK * PEER_TOPK), PEER_TOPK)
    i1 = jnp.take_along_axis(top_i[..., 0, :], cand_i // PEER_TOPK, axis=-1)
    i2 = jnp.take_along_axis(top_i[..., 1, :], cand_i % PEER_TOPK, axis=-1)
    expert = i1 * PEER_N_KEYS + i2
    gate = jax.nn.softmax(cand_s, axis=-1).astype(xn.dtype)

    n_blk = (B * S) // PEER_TOK_BLK
    xb = xn.reshape(n_blk, PEER_TOK_BLK, D)
    eb = expert.reshape(n_blk, PEER_TOK_BLK, PEER_HEADS * PEER_TOPK)
    gb = gate.reshape(n_blk, PEER_TOK_BLK, PEER_HEADS * PEER_TOPK)

    def token_block(args):
        xt, et, gt = args
        a = jax.nn.gelu(jnp.einsum('td,ted->te', xt, peer_u[et]), approximate=False) * gt
        return jnp.einsum('te,ted->td', a, peer_v[et])

    return lax.map(token_block, (xb, eb, gb)).reshape(B, S, D)


def setup_inputs(seed: int = 0) -> dict:
    key = jax.random.key(seed)
    ks = jax.random.split(key, 32)
    f32 = jnp.float32
    L = DEPTH

    def normal(k, shape, scale):
        return jax.random.normal(k, shape, f32) * scale

    def gain(k, shape):
        return 1.0 + 0.01 * jax.random.normal(k, shape, f32)

    return {
        'x': normal(ks[0], (BATCH, SEQ, D_MODEL), 1.0),
        'mem': normal(ks[1], (BATCH, MEM_TOKENS, D_MODEL), 1.0),
        'positions': jnp.arange(SEQ, dtype=jnp.int32)[None, :]
                     + jax.random.randint(ks[2], (BATCH, 1), 0, 4096, dtype=jnp.int32),
        'norm_mem': gain(ks[3], (D_MODEL,)),
        'norm_mix': gain(ks[4], (L, D_MODEL)),
        'w_in': normal(ks[5], (L, D_MODEL, IN_WIDTH), D_MODEL ** -0.5),
        'mla_q_norm': gain(ks[6], (L, MLA_Q_LORA)),
        'w_uq': normal(ks[7], (L, MLA_Q_LORA, MLA_HEADS * MLA_QK_DIM), MLA_Q_LORA ** -0.5),
        'mla_kv_norm': gain(ks[8], (L, MLA_KV_LORA)),
        'w_ukv': normal(ks[9], (L, MLA_KV_LORA, MLA_HEADS * (MLA_NOPE_DIM + MLA_V_DIM)), MLA_KV_LORA ** -0.5),
        'mla_out_norm': gain(ks[10], (L, MLA_WIDTH)),
        'w_gate_up': normal(ks[11], (L, GLA_GATE_RANK, GLA_K_WIDTH), GLA_GATE_RANK ** -0.5),
        'b_gate': normal(ks[12], (L, GLA_K_WIDTH), 0.1),
        'gla_out_norm': gain(ks[13], (L, GLA_HEAD_V)),
        'w_out': normal(ks[14], (L, MIX_WIDTH, D_MODEL), MIX_WIDTH ** -0.5),
        'norm_cross': gain(ks[15], (L, D_MODEL)),
        'w_cq': normal(ks[16], (L, D_MODEL, XATTN_WIDTH), D_MODEL ** -0.5),
        'w_ck': normal(ks[17], (L, D_MODEL, XATTN_WIDTH), D_MODEL ** -0.5),
        'w_cv': normal(ks[18], (L, D_MODEL, XATTN_WIDTH), D_MODEL ** -0.5),
        'w_co': normal(ks[19], (L, XATTN_WIDTH, D_MODEL), XATTN_WIDTH ** -0.5),
        'norm_ffn': gain(ks[20], (L, D_MODEL)),
        'w_peer_q': normal(ks[21], (L, D_MODEL, PEER_HEADS * PEER_QUERY_DIM), D_MODEL ** -0.5),
        'peer_sub_keys': normal(ks[22], (L, PEER_HEADS, 2, PEER_N_KEYS, PEER_HALF), PEER_HALF ** -0.5),
        'peer_u': normal(ks[23], (L, PEER_N_EXPERTS, D_MODEL), D_MODEL ** -0.5),
        'peer_v': normal(ks[24], (L, PEER_N_EXPERTS, D_MODEL), PEER_HEADS ** -0.5),
        'norm_final': gain(ks[25], (D_MODEL,)),
    }


def reference(x, mem, positions, norm_mem, norm_mix, w_in, mla_q_norm, w_uq, mla_kv_norm, w_ukv,
              mla_out_norm, w_gate_up, b_gate, gla_out_norm, w_out, norm_cross, w_cq, w_ck, w_cv, w_co,
              norm_ffn, w_peer_q, peer_sub_keys, peer_u, peer_v, norm_final):
    mn = rms_norm(mem, norm_mem)
    h = x
    for l in range(DEPTH):
        h = h + hybrid_mixer(rms_norm(h, norm_mix[l]), positions, w_in[l], mla_q_norm[l], w_uq[l],
                             mla_kv_norm[l], w_ukv[l], mla_out_norm[l], w_gate_up[l], b_gate[l],
                             gla_out_norm[l], w_out[l])
        h = h + memory_cross_attention(rms_norm(h, norm_cross[l]), mn, w_cq[l], w_ck[l], w_cv[l], w_co[l])
        h = h + peer_ffn(rms_norm(h, norm_ffn[l]), w_peer_q[l], peer_sub_keys[l], peer_u[l], peer_v[l])
    return rms_norm(h, norm_final)
```

```cpp
#include <hip/hip_runtime.h>
#include <cstdio>
#include <cstdint>

#define LAS __attribute__((address_space(3)))
typedef unsigned short bf16_t;
typedef short bf16x8 __attribute__((ext_vector_type(8)));
typedef short s16x4 __attribute__((ext_vector_type(4)));
typedef float f32x4 __attribute__((ext_vector_type(4)));
typedef float f32x16 __attribute__((ext_vector_type(16)));
typedef unsigned u32x4 __attribute__((ext_vector_type(4)));
typedef unsigned u32x2 __attribute__((ext_vector_type(2)));

constexpr int D = 4096, NB = 2, SEQ = 8192, M = NB * SEQ;
constexpr float EPS = 1e-6f;
constexpr int MEMT = 256, MROWS = NB * MEMT;
constexpr int IN_W = 7760, IN_WP = 7936;
constexpr int NWAVES = 8, NTHREADS = 512;

constexpr size_t al256(size_t x) { return (x + 255) & ~(size_t)255; }
constexpr size_t WS_CTL = 0, CTL_BYTES = 65536;
constexpr size_t WS_WIN = WS_CTL + CTL_BYTES;
constexpr size_t WS_WUQ = WS_WIN + (size_t)IN_WP * D * 2;
constexpr size_t WS_WUKV = WS_WUQ + (size_t)3072 * 1024 * 2;
constexpr size_t WS_WOUT = WS_WUKV + (size_t)4096 * 512 * 2;
constexpr size_t WS_WCQ = WS_WOUT + (size_t)D * D * 2;
constexpr size_t WS_WCK = WS_WCQ + (size_t)1024 * D * 2;
constexpr size_t WS_WCV = WS_WCK + (size_t)1024 * D * 2;
constexpr size_t WS_WCO = WS_WCV + (size_t)1024 * D * 2;
constexpr size_t WS_WPQ = WS_WCO + (size_t)D * 1024 * 2;
constexpr size_t WS_KEYS = WS_WPQ + (size_t)2048 * D * 2;
constexpr size_t WS_MN = WS_KEYS + (size_t)8 * 2 * 128 * 128 * 2;
constexpr size_t WS_KC = WS_MN + (size_t)MROWS * D * 2;
constexpr size_t WS_VC = WS_KC + (size_t)MROWS * 1024 * 2;
constexpr size_t WS_ROPE = WS_VC + (size_t)MROWS * 1024 * 2;
constexpr size_t WS_RSTDX = WS_ROPE + (size_t)M * 32 * 4 * 2;
constexpr size_t WS_RSTDQ = WS_RSTDX + (size_t)M * 4;
constexpr size_t WS_RSTDKV = WS_RSTDQ + (size_t)M * 4;
constexpr size_t WS_SSQ1 = WS_RSTDKV + (size_t)M * 4;
constexpr size_t WS_SSQ2 = WS_SSQ1 + (size_t)M * 64 * 4;
constexpr size_t WS_XB = WS_SSQ2 + (size_t)M * 64 * 4;
constexpr size_t WS_CQ = WS_XB + (size_t)M * D * 2;
constexpr size_t WS_CKV = WS_CQ + (size_t)M * 1024 * 2;
constexpr size_t WS_GQ = WS_CKV + (size_t)M * 512 * 2;
constexpr size_t WS_GK = WS_GQ + (size_t)M * 1024 * 2;
constexpr size_t WS_GV = WS_GK + (size_t)M * 1024 * 2;
constexpr size_t WS_GOG = WS_GV + (size_t)M * 2048 * 2;
constexpr size_t WS_SM = WS_GOG + (size_t)M * 2048 * 2;
constexpr size_t WS_Q = WS_SM + (size_t)M * 256 * 2;
constexpr size_t WS_KV = WS_Q + (size_t)M * 3072 * 2;
constexpr size_t WS_KROPE = WS_KV + (size_t)M * 4096 * 2;
constexpr size_t WS_OMLA = WS_KROPE + (size_t)M * 64 * 2;
constexpr size_t WS_OGLA = WS_OMLA + (size_t)M * 2048 * 2;
constexpr size_t WS_QEP = WS_OGLA + (size_t)M * 2048 * 2;
constexpr size_t WS_KEP = WS_QEP + (size_t)M * 1024 * 2;
constexpr size_t WS_KDT = WS_KEP + (size_t)M * 1024 * 2;
constexpr size_t WS_ATT = WS_KDT + (size_t)M * 1024 * 2;
constexpr size_t WS_DEC = WS_ATT + (size_t)1024 * 64 * 64 * 2;
constexpr size_t WS_RSTD1 = WS_DEC + (size_t)1024 * 256 * 4;
constexpr size_t WS_RSTD2 = WS_RSTD1 + (size_t)M * 4;
constexpr size_t WS_END0 = WS_RSTD2 + (size_t)M * 4;
constexpr size_t WS_QC = WS_Q;
constexpr size_t WS_OC = WS_Q + (size_t)M * 1024 * 2;
constexpr size_t WS_H1B = WS_KV;
constexpr size_t WS_H2B = WS_XB;
constexpr size_t WS_QP = WS_Q;
constexpr int PEER_ROW_BYTES = 2176;
constexpr size_t PEER_VAL_BYTES = (size_t)8 * 16384 * 256;
constexpr size_t WS_PD = WS_Q;
constexpr size_t WS_ACT = WS_OGLA;
constexpr size_t WS_H3B = WS_KV;
constexpr size_t WS_XQ = WS_KV;
constexpr size_t WS_XQS = WS_XQ + (size_t)M * D;
constexpr size_t WS_SSQ3 = WS_SSQ1;
constexpr size_t WS_UB = WS_CQ;
constexpr size_t WS_VB = WS_UB + (size_t)16384 * PEER_ROW_BYTES;
constexpr size_t WS_USC = WS_VB + (size_t)16384 * PEER_ROW_BYTES;
constexpr size_t WS_VSC = WS_USC + (size_t)16384 * 4;
constexpr size_t WS_IDS = WS_VSC + (size_t)16384 * 4;
constexpr size_t WS_GATES = WS_IDS + (size_t)M * 128 * 4;
static_assert(WS_GATES + (size_t)M * 128 * 4 <= WS_Q, "peer scratch overlaps q_p");

__device__ __forceinline__ unsigned cvt_pk_bf16(float lo, float hi) { unsigned r; asm volatile("v_cvt_pk_bf16_f32 %0, %1, %2" : "=v"(r) : "v"(lo), "v"(hi)); return r; }
__device__ __forceinline__ float bf2f(unsigned short b) { return __uint_as_float(((unsigned)b) << 16); }
#define DPP_ADD(v, ctrl, rmask) (v) += __int_as_float(__builtin_amdgcn_update_dpp(0, __float_as_int(v), (ctrl), (rmask), 0xF, false))
__device__ __forceinline__ float wave_sum(float v) {
    DPP_ADD(v, 0xB1, 0xF); DPP_ADD(v, 0x4E, 0xF); DPP_ADD(v, 0x141, 0xF); DPP_ADD(v, 0x140, 0xF);
    DPP_ADD(v, 0x142, 0xA); DPP_ADD(v, 0x143, 0xC);
    return __int_as_float(__builtin_amdgcn_readlane(__float_as_int(v), 63));
}
#define LDS_WAIT() asm volatile("s_waitcnt lgkmcnt(0)" ::: "memory")
__device__ __forceinline__ bf16x8 pack8(f32x4 a, f32x4 b) {
    u32x4 w = {cvt_pk_bf16(a[0], a[1]), cvt_pk_bf16(a[2], a[3]), cvt_pk_bf16(b[0], b[1]), cvt_pk_bf16(b[2], b[3])};
    return *reinterpret_cast<bf16x8*>(&w);
}

#define XB_TMO      128
#define XB_XCNT(j)  (256  + 64 * (j))
#define XB_XSUB(j)  (1280 + 64 * (j))
#define XB_XGEN(j)  (2304 + 64 * (j))
#define XB_TOP      3328
#define XB_TOPGEN   3392
#define XCD_BAR_WORDS 3456
#define XB_SPIN_CAP (1u << 22)

__device__ __forceinline__ unsigned xb_ld(unsigned* p)              { return __hip_atomic_load(p, __ATOMIC_RELAXED, __HIP_MEMORY_SCOPE_AGENT); }
__device__ __forceinline__ unsigned xb_add(unsigned* p, unsigned v) { return __hip_atomic_fetch_add(p, v, __ATOMIC_RELAXED, __HIP_MEMORY_SCOPE_AGENT); }
__device__ __forceinline__ unsigned xb_xcc_id() { return (unsigned)__builtin_amdgcn_s_getreg((3 << 11) | 20) & 0xFu; }
#define XB_SPIN(cond, bar) do { unsigned _sp = 0; while (cond) { __builtin_amdgcn_s_sleep(1); \
    if ((++_sp & 255u) == 0u) { if (xb_ld(&(bar)[XB_TMO])) break; if (_sp > XB_SPIN_CAP) { atomicAdd(&(bar)[XB_TMO], 1u); break; } } } } while (0)

struct XcdBarrier { unsigned* bar; unsigned x; volatile LAS unsigned* st; };

__device__ __forceinline__ XcdBarrier xcd_barrier_post(unsigned* bar, volatile LAS unsigned* st) {
    XcdBarrier b; b.bar = bar; b.x = xb_xcc_id(); b.st = st;
    if (threadIdx.x == 0) st[2] = xb_add(&bar[XB_XCNT(b.x)], 1u);
    return b;
}
__device__ __forceinline__ void xcd_barrier_complete(unsigned* bar, unsigned x, unsigned& nloc, unsigned& nx) {
    const unsigned G = gridDim.x * gridDim.y * gridDim.z;
    unsigned sum, cnt, mine, sp = 0u;
    for (;;) {
        sum = 0u; cnt = 0u; mine = 0u;
#pragma unroll
        for (unsigned j = 0; j < 16; ++j) { const unsigned c = xb_ld(&bar[XB_XCNT(j)]); sum += c; cnt += (c > 0u) ? 1u : 0u; mine = (j == x) ? c : mine; }
        if (sum == G) break;
        __builtin_amdgcn_s_sleep(1);
        if ((++sp & 255u) == 0u) { if (xb_ld(&bar[XB_TMO])) break; if (sp > XB_SPIN_CAP) { atomicAdd(&bar[XB_TMO], 1u); break; } }
    }
    nloc = mine > 0u ? mine : 1u; nx = cnt > 0u ? cnt : 1u;
}
__device__ __forceinline__ void xcd_barrier(const XcdBarrier& b) {
    asm volatile("s_waitcnt vmcnt(0)" ::: "memory");
    __syncthreads();
    if (threadIdx.x == 0) {
        unsigned* bar = b.bar;
        __builtin_amdgcn_s_waitcnt(0);
        unsigned nloc = b.st[0], nx = b.st[1];
        if (nloc == 0u) { xcd_barrier_complete(bar, b.x, nloc, nx); b.st[0] = nloc; b.st[1] = nx; }
        const unsigned old = xb_add(&bar[XB_XSUB(b.x)], 1u);
        const unsigned gen = old / nloc;
        if (old + 1u == (gen + 1u) * nloc) {
            __builtin_amdgcn_fence(__ATOMIC_RELEASE, "agent");
            asm volatile("s_waitcnt vmcnt(0)" ::: "memory");
            const unsigned og = xb_add(&bar[XB_TOP], 1u);
            const unsigned tg = og / nx;
            if (og + 1u == (tg + 1u) * nx) xb_add(&bar[XB_TOPGEN], 1u);
            else XB_SPIN(xb_ld(&bar[XB_TOPGEN]) == tg, bar);
            __builtin_amdgcn_fence(__ATOMIC_ACQUIRE, "agent");
            xb_add(&bar[XB_XGEN(b.x)], 1u);
            asm volatile("s_waitcnt vmcnt(0)" ::: "memory");
        } else {
            XB_SPIN(xb_ld(&bar[XB_XGEN(b.x)]) == gen, bar);
            __builtin_amdgcn_fence(__ATOMIC_ACQUIRE, "agent");
            asm volatile("s_waitcnt vmcnt(0)" ::: "memory");
        }
    }
    __syncthreads();
}


namespace pg8 {
constexpr int BM = 256, BK = 64, HALF = 128, HTB = HALF * BK * 2, NXCD = 8, WGM = 8;
__host__ __device__ __forceinline__ int lds_byte(int r, int c) { const int st = (r >> 4) * 2 + (c >> 5), rr = r & 15, cc = c & 31, ob = rr * 64 + cc * 2; return st * 1024 + (ob ^ (((ob >> 9) & 1) << 5)); }
__host__ __device__ __forceinline__ void stage_rc(int b, int& R, int& C) { const int st = b / 1024, sb = b % 1024, swz = sb ^ (((sb >> 9) & 1) << 5); R = (st >> 1) * 16 + swz / 64; C = (st & 1) * 32 + (swz % 64) / 2; }
__host__ __device__ __forceinline__ int perm32(int rho) { const int n = rho >> 4, i = rho & 15; return 8 * (i >> 2) + 4 * n + (i & 3); }
struct Unit { int pm, pn; };
struct Gemm { const bf16_t* A; const bf16_t* Bt; int M, N, K, lda, ldb; };
struct StaticOrder {
    int nM, nN, nwg, G, c;
    __host__ __device__ void init(int M_, int N_, int G_, int c_) { nM = M_ / BM; nN = N_ / BM; nwg = nM * nN; G = G_; c = c_; }
    __host__ __device__ bool next(int i, Unit& u) const {
        const long L = (long)i * G + c; if (L >= nwg) return false;
        int wgid = (int)L; { const int q = nwg / NXCD, r = nwg % NXCD, xcd = wgid % NXCD, off = wgid / NXCD; wgid = (xcd < r ? xcd * (q + 1) : r * (q + 1) + (xcd - r) * q) + off; }
        const int nig = WGM * nN, gid = wgid / nig, fm = gid * WGM, gsz = (nM - fm) < WGM ? (nM - fm) : WGM;
        u.pm = fm + ((wgid % nig) % gsz); u.pn = (wgid % nig) / gsz; return true;
    }
};
template <class Epi>
__device__ __forceinline__ void gemm_phase(LAS unsigned char* lds, const Gemm g, const StaticOrder& S, const Epi& E, const bool perm) {
    int tid_ = threadIdx.x; asm volatile("" : "+v"(tid_));
    const int tid = tid_, wid = __builtin_amdgcn_readfirstlane(tid >> 6), lane = tid & 63, wr = wid >> 2, wc = wid & 3, fr = lane & 15, fq = lane >> 4;
    const int K = g.K, nt = K / BK;
    unsigned voffA[2], voffB[2];
#pragma unroll
    for (int i = 0; i < 2; ++i) { int R, C; stage_rc(tid * 16 + i * 8192, R, C); const int Rb = perm ? ((R & ~31) + perm32(R & 31)) : R;
        voffA[i] = (unsigned)(R * g.lda + C) * 2u; voffB[i] = (unsigned)(Rb * g.ldb + C) * 2u; }
    const size_t kstep = (size_t)(BK * 2);
    const size_t hstepA = (size_t)HALF * g.lda * 2, hstepB = (size_t)HALF * g.ldb * 2;
    const size_t tstepA = 2 * hstepA, tstepB = 2 * hstepB;
    const unsigned ldsw = (unsigned)wid * 1024u;
    const int aoff = lds_byte(wr * 64 + fr, fq * 8), boff = lds_byte(wc * 32 + fr, fq * 8);
#define PG8_SA(b, h) (((b) * 2 + (h)) * HTB)
#define PG8_SB(b, h) ((4 + (b) * 2 + (h)) * HTB)
#define PG8_STAGE(bufoff, gbase, voff) do { _Pragma("unroll") for (int _i = 0; _i < 2; ++_i) \
        __builtin_amdgcn_global_load_lds((const unsigned*)((const char*)(gbase) + (voff)[_i]), (LAS unsigned*)(lds + (bufoff) + ldsw + _i * 8192), 16, 0, 0); } while (0)
#define PG8_LDA(dst, b, h) do { _Pragma("unroll") for (int m = 0; m < 4; ++m) _Pragma("unroll") for (int k = 0; k < 2; ++k) dst[m][k] = *(const LAS bf16x8*)(lds + PG8_SA(b, h) + aoff + m * 2048 + k * 1024); } while (0)
#define PG8_LDB(dst, b, h) do { _Pragma("unroll") for (int n = 0; n < 2; ++n) _Pragma("unroll") for (int k = 0; k < 2; ++k) dst[n][k] = *(const LAS bf16x8*)(lds + PG8_SB(b, h) + boff + n * 2048 + k * 1024); } while (0)
#define PG8_MMA(ai, bj, At, Bt) do { __builtin_amdgcn_s_setprio(1); _Pragma("unroll") for (int m = 0; m < 4; ++m) _Pragma("unroll") for (int n = 0; n < 2; ++n) _Pragma("unroll") for (int k = 0; k < 2; ++k) \
        acc[ai][bj][m][n] = __builtin_amdgcn_mfma_f32_16x16x32_bf16(Bt[n][k], At[m][k], acc[ai][bj][m][n], 0, 0, 0); __builtin_amdgcn_s_setprio(0); } while (0)
#define PG8_WAIT_V(n) asm volatile("s_waitcnt vmcnt(" #n ")" ::: "memory")
#define PG8_WAIT_L(n) asm volatile("s_waitcnt lgkmcnt(" #n ")" ::: "memory")
#define PG8_BAR __builtin_amdgcn_s_barrier()
#define PG8_SCHED __builtin_amdgcn_sched_barrier(0)
    Unit cur, nxt; int ui = 0;
    if (!S.next(0, cur)) return;
    f32x4 acc[2][2][4][2];
#pragma unroll
    for (int a = 0; a < 2; ++a)
#pragma unroll
        for (int b = 0; b < 2; ++b)
#pragma unroll
            for (int m = 0; m < 4; ++m)
#pragma unroll
                for (int n = 0; n < 2; ++n) acc[a][b][m][n] = (f32x4){0.f, 0.f, 0.f, 0.f};
    bf16x8 At[4][2], B0[2][2], B1[2][2];
    const char* cA = (const char*)g.A + (size_t)cur.pm * tstepA; const char* cB = (const char*)g.Bt + (size_t)cur.pn * tstepB;
    PG8_STAGE(PG8_SB(0, 0), cB, voffB); PG8_STAGE(PG8_SA(0, 0), cA, voffA); PG8_STAGE(PG8_SB(0, 1), cB + hstepB, voffB); PG8_STAGE(PG8_SA(0, 1), cA + hstepA, voffA);
    if (wr == 1) PG8_BAR;
    PG8_WAIT_V(4); PG8_BAR;
    PG8_STAGE(PG8_SB(1, 0), cB + kstep, voffB); PG8_STAGE(PG8_SA(1, 0), cA + kstep, voffA); PG8_STAGE(PG8_SB(1, 1), cB + hstepB + kstep, voffB);
    PG8_WAIT_V(6); PG8_BAR;
    for (;;) {
        const bool has_next = S.next(ui + 1, nxt);
        const char* nA = has_next ? (const char*)g.A + (size_t)nxt.pm * tstepA : cA; const char* nB = has_next ? (const char*)g.Bt + (size_t)nxt.pn * tstepB : cB;
        for (int t = 0; t < nt; t += 2) {
            const bool last = (t == nt - 2);
            const char* a1 = cA + (size_t)(t + 1) * kstep;
            const char* a2 = last ? nA : cA + (size_t)(t + 2) * kstep; const char* b2 = last ? nB : cB + (size_t)(t + 2) * kstep;
            const char* a3 = a2 + kstep; const char* b3 = b2 + kstep;
            PG8_LDB(B0, 0, 0); PG8_SCHED; PG8_LDA(At, 0, 0); PG8_STAGE(PG8_SA(1, 1), a1 + hstepA, voffA);
            PG8_WAIT_L(8); PG8_BAR; PG8_WAIT_L(0); PG8_MMA(0, 0, At, B0); PG8_BAR; PG8_SCHED;
            PG8_LDB(B1, 0, 1); PG8_STAGE(PG8_SB(0, 0), b2, voffB);
            PG8_BAR; PG8_WAIT_L(0); PG8_MMA(0, 1, At, B1); PG8_BAR;
            PG8_LDA(At, 0, 1); PG8_STAGE(PG8_SA(0, 0), a2, voffA);
            PG8_BAR; PG8_WAIT_L(0); PG8_MMA(1, 0, At, B0); PG8_BAR; PG8_SCHED;
            PG8_STAGE(PG8_SB(0, 1), b2 + hstepB, voffB);
            PG8_WAIT_V(6); PG8_BAR; PG8_MMA(1, 1, At, B1); PG8_BAR;
            PG8_LDB(B0, 1, 0); PG8_SCHED; PG8_LDA(At, 1, 0); PG8_STAGE(PG8_SA(0, 1), a2 + hstepA, voffA);
            PG8_WAIT_L(8); PG8_BAR; PG8_WAIT_L(0); PG8_MMA(0, 0, At, B0); PG8_BAR; PG8_SCHED;
            PG8_LDB(B1, 1, 1); PG8_STAGE(PG8_SB(1, 0), b3, voffB);
            PG8_BAR; PG8_WAIT_L(0); PG8_MMA(0, 1, At, B1); PG8_BAR;
            PG8_LDA(At, 1, 1); PG8_STAGE(PG8_SA(1, 0), a3, voffA);
            PG8_BAR; PG8_WAIT_L(0); PG8_MMA(1, 0, At, B0); PG8_BAR; PG8_SCHED;
            PG8_STAGE(PG8_SB(1, 1), b3 + hstepB, voffB);
            PG8_WAIT_V(6); PG8_BAR; PG8_MMA(1, 1, At, B1); PG8_BAR;
        }
        E(acc, cur, wr, wc, fr, fq);
        if (!has_next) break;
#pragma unroll
        for (int a = 0; a < 2; ++a)
#pragma unroll
            for (int b = 0; b < 2; ++b)
#pragma unroll
                for (int m = 0; m < 4; ++m)
#pragma unroll
                    for (int n = 0; n < 2; ++n) acc[a][b][m][n] = (f32x4){0.f, 0.f, 0.f, 0.f};
        cur = nxt; cA = nA; cB = nB; ++ui;
    }
    PG8_WAIT_V(0);
    if (wr == 0) PG8_BAR;
    PG8_BAR;
#undef PG8_SA
#undef PG8_SB
#undef PG8_STAGE
#undef PG8_LDA
#undef PG8_LDB
#undef PG8_MMA
#undef PG8_WAIT_V
#undef PG8_WAIT_L
#undef PG8_BAR
#undef PG8_SCHED
}

struct EpiRowScaleBf16 {
    static constexpr bool PERM = true;
    const float* rs; bf16_t* base; int ldc;
    __device__ __forceinline__ void store(const f32x4 (&acc)[2][2][4][2], bf16_t* __restrict__ dst, int ld, int ctile, const Unit& u, int wr, int wc, int fr, int fq) const {
        const int row0 = u.pm * BM + wr * 64 + fr, col0 = ctile * BM + wc * 32 + 8 * fq;
        float sv[2][4];
        const float* __restrict__ rsp = rs;
#pragma unroll
        for (int ai = 0; ai < 2; ++ai)
#pragma unroll
            for (int m = 0; m < 4; ++m) sv[ai][m] = rsp ? rsp[row0 + ai * HALF + m * 16] : 1.0f;
#pragma unroll
        for (int ai = 0; ai < 2; ++ai)
#pragma unroll
            for (int m = 0; m < 4; ++m) { const int row = row0 + ai * HALF + m * 16; const float s = sv[ai][m]; bf16_t* rowp = dst + (size_t)row * ld + col0;
#pragma unroll
                for (int bj = 0; bj < 2; ++bj) { const f32x4 v0 = acc[ai][bj][m][0] * s, v1 = acc[ai][bj][m][1] * s;
                    u32x4 w; w.x = cvt_pk_bf16(v0[0], v0[1]); w.y = cvt_pk_bf16(v0[2], v0[3]); w.z = cvt_pk_bf16(v1[0], v1[1]); w.w = cvt_pk_bf16(v1[2], v1[3]);
                    *(u32x4*)(rowp + bj * HALF) = w; } }
    }
    __device__ __forceinline__ void operator()(const f32x4 (&acc)[2][2][4][2], const Unit& u, int wr, int wc, int fr, int fq) const { store(acc, base, ldc, u.pn, u, wr, wc, fr, fq); }
};
struct EpiInProj : EpiRowScaleBf16 {
    unsigned char* ws;
    __device__ __forceinline__ void operator()(const f32x4 (&acc)[2][2][4][2], const Unit& u, int wr, int wc, int fr, int fq) const {
        const int pn = u.pn; size_t off; int ld, t0;
        if (pn < 4) { off = WS_CQ; ld = 1024; t0 = 0; } else if (pn < 6) { off = WS_CKV; ld = 512; t0 = 4; } else if (pn < 10) { off = WS_GQ; ld = 1024; t0 = 6; }
        else if (pn < 14) { off = WS_GK; ld = 1024; t0 = 10; } else if (pn < 22) { off = WS_GV; ld = 2048; t0 = 14; } else if (pn < 30) { off = WS_GOG; ld = 2048; t0 = 22; }
        else { off = WS_SM; ld = 256; t0 = 30; }
        store(acc, (bf16_t*)(ws + off), ld, pn - t0, u, wr, wc, fr, fq);
    }
};
struct EpiResidual {
    static constexpr bool PERM = true;
    const float* basef; const bf16_t* baseb; bf16_t* hb; float* ssq; int ldc; int nslots;
    __device__ __forceinline__ void operator()(const f32x4 (&acc)[2][2][4][2], const Unit& u, int wr, int wc, int fr, int fq) const {
        const int row0 = u.pm * BM + wr * 64 + fr, col0 = u.pn * BM + wc * 32 + 8 * fq;
        const float* __restrict__ bf = basef; const bf16_t* __restrict__ bb = baseb; bf16_t* __restrict__ ho = hb;
        if (bf) {
#pragma unroll
            for (int ai = 0; ai < 2; ++ai)
#pragma unroll
                for (int mp = 0; mp < 2; ++mp) {
                    f32x4 bs[2][2][2];
#pragma unroll
                    for (int mm = 0; mm < 2; ++mm) { const size_t off = (size_t)(row0 + ai * HALF + (2 * mp + mm) * 16) * ldc + col0;
#pragma unroll
                        for (int bj = 0; bj < 2; ++bj)
#pragma unroll
                            for (int n = 0; n < 2; ++n) bs[mm][bj][n] = *(const f32x4*)(bf + off + bj * HALF + n * 4); }
#pragma unroll
                    for (int mm = 0; mm < 2; ++mm) { const int m = 2 * mp + mm; const int row = row0 + ai * HALF + m * 16; const size_t off = (size_t)row * ldc + col0; float ss = 0.f;
#pragma unroll
                        for (int bj = 0; bj < 2; ++bj) { const f32x4 h0 = bs[mm][bj][0] + acc[ai][bj][m][0], h1 = bs[mm][bj][1] + acc[ai][bj][m][1];
                            u32x4 w; w.x = cvt_pk_bf16(h0[0], h0[1]); w.y = cvt_pk_bf16(h0[2], h0[3]); w.z = cvt_pk_bf16(h1[0], h1[1]); w.w = cvt_pk_bf16(h1[2], h1[3]);
                            *(u32x4*)(ho + off + bj * HALF) = w;
                            ss += ((h0[0] * h0[0] + h0[1] * h0[1]) + (h0[2] * h0[2] + h0[3] * h0[3])) + ((h1[0] * h1[0] + h1[1] * h1[1]) + (h1[2] * h1[2] + h1[3] * h1[3])); }
                        ss += __shfl_xor(ss, 16); ss += __shfl_xor(ss, 32);
                        if (fq == 0) ssq[(size_t)row * nslots + u.pn * 4 + wc] = ss; }
                }
        } else {
#pragma unroll
            for (int ai = 0; ai < 2; ++ai) {
                u32x4 bs[4][2];
#pragma unroll
                for (int m = 0; m < 4; ++m) { const size_t off = (size_t)(row0 + ai * HALF + m * 16) * ldc + col0;
#pragma unroll
                    for (int bj = 0; bj < 2; ++bj) bs[m][bj] = *(const u32x4*)(bb + off + bj * HALF); }
#pragma unroll
                for (int m = 0; m < 4; ++m) { const int row = row0 + ai * HALF + m * 16; const size_t off = (size_t)row * ldc + col0; float ss = 0.f;
#pragma unroll
                    for (int bj = 0; bj < 2; ++bj) { const u32x4 q = bs[m][bj];
                        const f32x4 h0 = (f32x4){__uint_as_float(q.x << 16), __uint_as_float(q.x & 0xffff0000u), __uint_as_float(q.y << 16), __uint_as_float(q.y & 0xffff0000u)} + acc[ai][bj][m][0];
                        const f32x4 h1 = (f32x4){__uint_as_float(q.z << 16), __uint_as_float(q.z & 0xffff0000u), __uint_as_float(q.w << 16), __uint_as_float(q.w & 0xffff0000u)} + acc[ai][bj][m][1];
                        u32x4 w; w.x = cvt_pk_bf16(h0[0], h0[1]); w.y = cvt_pk_bf16(h0[2], h0[3]); w.z = cvt_pk_bf16(h1[0], h1[1]); w.w = cvt_pk_bf16(h1[2], h1[3]);
                        *(u32x4*)(ho + off + bj * HALF) = w;
                        ss += ((h0[0] * h0[0] + h0[1] * h0[1]) + (h0[2] * h0[2] + h0[3] * h0[3])) + ((h1[0] * h1[0] + h1[1] * h1[1]) + (h1[2] * h1[2] + h1[3] * h1[3])); }
                    ss += __shfl_xor(ss, 16); ss += __shfl_xor(ss, 32);
                    if (fq == 0) ssq[(size_t)row * nslots + u.pn * 4 + wc] = ss; }
            }
        }
    }
};
}


struct GemmDesc { unsigned long long a_off, b_off, d_off, rs_off, ssq_off; int M, N, K, lda, ldb, ldc, kind, base_is_x, crot; };
constexpr unsigned long long NO_OFF = ~0ull;
__device__ __constant__ GemmDesc g_gemm[9] = {
      {WS_XB,  WS_WIN,  0,      WS_RSTDX,  NO_OFF,  M,     IN_WP, D,    D,    D,    0,    1, 0, 0},
      {WS_MN,  WS_WCK,  WS_KC,  NO_OFF,    NO_OFF,  MROWS, 1024,  D,    D,    D,    1024, 0, 0, 64},
      {WS_MN,  WS_WCV,  WS_VC,  NO_OFF,    NO_OFF,  MROWS, 1024,  D,    D,    D,    1024, 0, 0, 56},
      {WS_CQ,  WS_WUQ,  WS_Q,   WS_RSTDQ,  NO_OFF,  M,     3072,  1024, 1024, 1024, 3072, 0, 0, 0},
      {WS_CKV, WS_WUKV, WS_KV,  WS_RSTDKV, NO_OFF,  M,     4096,  512,  512,  512,  4096, 0, 0, 0},
      {WS_XB,  WS_WOUT, WS_H1B, NO_OFF,    WS_SSQ1, M,     D,     D,    D,    D,    D,    2, 1, 0},
      {WS_H1B, WS_WCQ,  WS_QC,  WS_RSTD1,  NO_OFF,  M,     1024,  D,    D,    D,    1024, 0, 0, 0},
      {WS_OC,  WS_WCO,  WS_H2B, NO_OFF,    WS_SSQ2, M,     D,     1024, 1024, 1024, D,    2, 0, 0},
      {WS_H2B, WS_WPQ,  WS_QP,  WS_RSTD2,  NO_OFF,  M,     2048,  D,    D,    D,    2048, 0, 0, 0},
};
template <int KINDS>
struct EpiGeneric {
    int kind; pg8::EpiInProj ein; pg8::EpiResidual eres;
    __device__ __forceinline__ void operator()(const f32x4 (&acc)[2][2][4][2], const pg8::Unit& u, int wr, int wc, int fr, int fq) const {
        if ((KINDS & 4) && (kind == 2 || KINDS == 4)) eres(acc, u, wr, wc, fr, fq);
        else if ((KINDS & 2) && (kind == 1 || KINDS == 2)) ein(acc, u, wr, wc, fr, fq);
        else if (KINDS & 1) ein.pg8::EpiRowScaleBf16::operator()(acc, u, wr, wc, fr, fq);
    }
};
template <int KINDS>
__device__ __forceinline__ void gemm_run(LAS unsigned char* lds, const float* x_in, float* out, unsigned char* ws, int idx, int G, int bid) {
    const GemmDesc d = g_gemm[idx];
    pg8::Gemm g{(const bf16_t*)(ws + d.a_off), (const bf16_t*)(ws + d.b_off), d.M, d.N, d.K, d.lda, d.ldb};
    pg8::StaticOrder S; S.init(d.M, d.N, G, (bid + d.crot) % G);
    EpiGeneric<KINDS> E{};
    E.kind = d.kind;
    E.ein.rs = d.rs_off == NO_OFF ? nullptr : (const float*)(ws + d.rs_off); E.ein.base = (bf16_t*)(ws + d.d_off); E.ein.ldc = d.ldc; E.ein.ws = ws;
    E.eres.basef = d.base_is_x ? x_in : nullptr; E.eres.baseb = (const bf16_t*)(ws + WS_H1B); E.eres.hb = (bf16_t*)(ws + d.d_off); E.eres.ssq = (float*)(ws + (d.ssq_off == NO_OFF ? 0ull : d.ssq_off)); E.eres.ldc = d.ldc; E.eres.nslots = 64;
    pg8::gemm_phase(lds, g, S, E, true);
}

namespace att {
constexpr int KVBLK = 64;
constexpr float THR = 8.f;
#define SBAR() __builtin_amdgcn_sched_barrier(0)
__device__ __forceinline__ int v_st(int k, int c) { const int kk = (k & ~0xC) | ((k & 4) << 1) | ((k & 8) >> 1); return ((kk >> 3) * 4 + (c >> 5)) * 512 + ((kk & 7) * 32 + (c & 31)) * 2; }
__device__ __forceinline__ int v_rd_base(int lane) { return ((lane & 3) << 3) | (((lane >> 2) & 3) << 6) | (((lane >> 4) & 1) << 5) | (((lane >> 5) & 1) << 8); }
constexpr int v_rd_off(int d0, int ks, int half) { return d0 * 512 + ks * 4096 + half * 2048; }
__device__ __forceinline__ int crow(int r, int hi) { return (r & 3) + 8 * (r >> 2) + 4 * hi; }
__device__ __forceinline__ void mask_tile(f32x16& p0, f32x16& p1, int dq, unsigned W) {
    const float NEG = -__builtin_inff();
#pragma unroll
    for (int r = 0; r < 16; ++r) {
        const int c = (r & 3) + 8 * (r >> 2);
        if ((unsigned)(dq - c) >= W) p0[r] = NEG;
        if ((unsigned)(dq - c - 32) >= W) p1[r] = NEG;
    }
}
__device__ __forceinline__ void partialSM(f32x16& p0, f32x16& p1, float& m_reg, float& mn, float& alpha, const float SCALE) {
    float pmax = p0[0];
#pragma unroll
    for (int r = 1; r < 16; ++r) pmax = fmaxf(pmax, p0[r]);
#pragma unroll
    for (int r = 0; r < 16; ++r) pmax = fmaxf(pmax, p1[r]);
    { auto rr = __builtin_amdgcn_permlane32_swap(__float_as_uint(pmax), __float_as_uint(pmax), false, false);
      pmax = fmaxf(__uint_as_float(rr[0]), __uint_as_float(rr[1])); }
    const float C2 = 1.4426950408889634f * SCALE;
    if (__builtin_expect(__all((pmax - m_reg) * SCALE <= THR), 1)) { mn = m_reg; alpha = 1.f; }
    else { mn = fmaxf(m_reg, pmax); alpha = __builtin_amdgcn_exp2f((m_reg - mn) * C2); m_reg = mn; }
    const float mnL = -mn * C2;
#pragma unroll
    for (int r = 0; r < 16; ++r) p0[r] = fmaf(p0[r], C2, mnL);
#pragma unroll
    for (int r = 0; r < 16; ++r) p1[r] = fmaf(p1[r], C2, mnL);
#pragma unroll
    for (int r = 0; r < 16; ++r) p0[r] = __builtin_amdgcn_exp2f(p0[r]);
}
__device__ __forceinline__ void finishSM(f32x16& p0, f32x16& p1, float alpha, float& l_reg, bf16x8& pa0, bf16x8& pa1, bf16x8& pa2, bf16x8& pa3) {
#pragma unroll
    for (int r = 0; r < 16; ++r) p1[r] = __builtin_amdgcn_exp2f(p1[r]);
    float ps = 0;
#pragma unroll
    for (int r = 0; r < 16; ++r) ps += p0[r];
#pragma unroll
    for (int r = 0; r < 16; ++r) ps += p1[r];
    { auto rr = __builtin_amdgcn_permlane32_swap(__float_as_uint(ps), __float_as_uint(ps), false, false);
      ps = __uint_as_float(rr[0]) + __uint_as_float(rr[1]); }
    l_reg = l_reg * alpha + ps;
#define PK4(P, B_, OUT) do { unsigned a0 = cvt_pk_bf16(P[B_+0], P[B_+1]), a1 = cvt_pk_bf16(P[B_+2], P[B_+3]);                          \
        unsigned b0 = cvt_pk_bf16(P[B_+4], P[B_+5]), b1 = cvt_pk_bf16(P[B_+6], P[B_+7]);                                             \
        auto r0 = __builtin_amdgcn_permlane32_swap(a0, b0, false, false); auto r1 = __builtin_amdgcn_permlane32_swap(a1, b1, false, false); \
        u32x4 w = {r0[0], r1[0], r0[1], r1[1]}; OUT = *reinterpret_cast<bf16x8*>(&w); } while (0)
    PK4(p0, 0, pa0); PK4(p0, 8, pa1); PK4(p1, 0, pa2); PK4(p1, 8, pa3);
#undef PK4
}
template <int DQK>
__device__ __forceinline__ void qkt(f32x16& p0, f32x16& p1, const LAS char* Kt, int r32, int hi, const bf16x8* qr) {
    constexpr int PITCH = DQK * 2;
    p0 = f32x16{}; p1 = f32x16{};
    const LAS char* kb[4];
#pragma unroll
    for (int dd = 0; dd < 4; ++dd) kb[dd] = Kt + r32 * PITCH + (((dd * 16 + hi * 8) * 2) ^ ((r32 & 7) << 4));
#pragma unroll
    for (int d0 = 0; d0 < DQK / 16; ++d0) { const LAS char* a = kb[d0 & 3] + (d0 >> 2) * 128;
        bf16x8 b0 = *reinterpret_cast<const LAS bf16x8*>(a);
        bf16x8 b1 = *reinterpret_cast<const LAS bf16x8*>(a + 32 * PITCH);
        p0 = __builtin_amdgcn_mfma_f32_32x32x16_bf16(b0, qr[d0], p0, 0, 0, 0);
        p1 = __builtin_amdgcn_mfma_f32_32x32x16_bf16(b1, qr[d0], p1, 0, 0, 0); }
}
template <int VOFF>
__device__ __forceinline__ void pv_tile(f32x16* o, int vaddr, bf16x8 pa0, bf16x8 pa1, bf16x8 pa2, bf16x8 pa3) {
#define TRRD(dst, off) asm volatile("ds_read_b64_tr_b16 %0, %1 offset:%2" : "=&v"(dst) : "v"(vaddr), "i"(off) : "memory")
#define PV_D0(d0) do { s16x4 l0, l1, l2, l3, h0, h1, h2, h3; constexpr int b_ = VOFF + v_rd_off(d0, 0, 0); \
        TRRD(l0, b_); TRRD(h0, b_ + 2048); TRRD(l1, b_ + 4096); TRRD(h1, b_ + 6144); TRRD(l2, b_ + 8192); TRRD(h2, b_ + 10240); TRRD(l3, b_ + 12288); TRRD(h3, b_ + 14336); \
        asm volatile("s_waitcnt lgkmcnt(0)" ::: "memory"); SBAR();   \
        o[d0] = __builtin_amdgcn_mfma_f32_32x32x16_bf16(pa0, (bf16x8){l0[0], l0[1], l0[2], l0[3], h0[0], h0[1], h0[2], h0[3]}, o[d0], 0, 0, 0);   \
        o[d0] = __builtin_amdgcn_mfma_f32_32x32x16_bf16(pa1, (bf16x8){l1[0], l1[1], l1[2], l1[3], h1[0], h1[1], h1[2], h1[3]}, o[d0], 0, 0, 0);   \
        o[d0] = __builtin_amdgcn_mfma_f32_32x32x16_bf16(pa2, (bf16x8){l2[0], l2[1], l2[2], l2[3], h2[0], h2[1], h2[2], h2[3]}, o[d0], 0, 0, 0);   \
        o[d0] = __builtin_amdgcn_mfma_f32_32x32x16_bf16(pa3, (bf16x8){l3[0], l3[1], l3[2], l3[3], h3[0], h3[1], h3[2], h3[3]}, o[d0], 0, 0, 0); } while (0)
    PV_D0(0); PV_D0(1); PV_D0(2); PV_D0(3);
#undef PV_D0
#undef TRRD
}

constexpr int MLA_TILE = 16384;
constexpr int MLA_V_OFF = 0, MLA_KN_OFF = 2 * MLA_TILE, MLA_KR_OFF = 4 * MLA_TILE, MLA_KR_BYTES = 8192, MLA_WS_OFF = MLA_KR_OFF + 2 * MLA_KR_BYTES;
__device__ __forceinline__ void mla_block(LAS char* lds, const bf16_t* __restrict__ q, const bf16_t* __restrict__ kv, const bf16_t* __restrict__ krope,
                                          const float* __restrict__ cs, const float* __restrict__ sn, bf16_t* __restrict__ omla, int b, int h, int qb) {
    const float SCALE = 0.07216878364870322f;
    int tid_ = threadIdx.x; asm volatile("" : "+v"(tid_));
    const int tid = tid_, wid = __builtin_amdgcn_readfirstlane(tid >> 6), lane = tid & 63, r32 = lane & 31, hi = lane >> 5;
    LAS float* wsf = (LAS float*)(lds + MLA_WS_OFF) + wid * 64; LAS float* li_l = wsf; LAS float* al_l = wsf + 32;
    const int P0 = qb * 256, tb = b * SEQ;
    const int NT = (P0 + 256) / KVBLK;
    const int qlo = P0 + wid * 32, qm = qlo + r32 - 4 * hi;
    bf16x8 qr[12];
    { const size_t qrow = (size_t)(tb + qlo + r32); const bf16_t* qp = q + qrow * 3072 + h * 192;
#pragma unroll
      for (int d0 = 0; d0 < 8; ++d0) qr[d0] = *(const bf16x8*)(qp + d0 * 16 + hi * 8);
      const bf16x8 x8 = *(const bf16x8*)(qp + 128 + hi * 8), x9 = *(const bf16x8*)(qp + 144 + hi * 8), x10 = *(const bf16x8*)(qp + 160 + hi * 8), x11 = *(const bf16x8*)(qp + 176 + hi * 8);
      const float* cp = cs + qrow * 32 + hi * 8; const float* sp = sn + qrow * 32 + hi * 8;
      float n8[8], n9[8], n10[8], n11[8];
#pragma unroll
      for (int e = 0; e < 8; ++e) { const float c0 = cp[e], s0 = sp[e], c1 = cp[16 + e], s1 = sp[16 + e];
          const float a8 = bf2f((unsigned short)x8[e]), a9 = bf2f((unsigned short)x9[e]), a10 = bf2f((unsigned short)x10[e]), a11 = bf2f((unsigned short)x11[e]);
          n8[e] = a8 * c0 - a10 * s0; n10[e] = a10 * c0 + a8 * s0; n9[e] = a9 * c1 - a11 * s1; n11[e] = a11 * c1 + a9 * s1; }
      qr[8] = pack8((f32x4){n8[0], n8[1], n8[2], n8[3]}, (f32x4){n8[4], n8[5], n8[6], n8[7]});
      qr[9] = pack8((f32x4){n9[0], n9[1], n9[2], n9[3]}, (f32x4){n9[4], n9[5], n9[6], n9[7]});
      qr[10] = pack8((f32x4){n10[0], n10[1], n10[2], n10[3]}, (f32x4){n10[4], n10[5], n10[6], n10[7]});
      qr[11] = pack8((f32x4){n11[0], n11[1], n11[2], n11[3]}, (f32x4){n11[4], n11[5], n11[6], n11[7]}); }
    unsigned voff_kn, voff_v, voff_kr;
    { const int row = tid >> 4, cp_ = tid & 15, g = cp_ >> 3, j = cp_ & 7;
      voff_kn = (unsigned)(row * 8192 + (h * 256 + (g * 8 + (j ^ (row & 7))) * 8) * 2);
      const int kk = (tid >> 7) * 8 + ((tid & 31) >> 2), key = (kk & ~0xC) | ((kk & 4) << 1) | ((kk & 8) >> 1), c = ((tid >> 5) & 3) * 32 + (tid & 3) * 8;
      voff_v = (unsigned)(key * 8192 + (h * 256 + 128 + c) * 2);
      const int prow = tid >> 4, half = (tid >> 3) & 1, jr = (tid & 7) ^ (prow & 7);
      voff_kr = (unsigned)((prow + 32 * half) * 128 + jr * 16); }
    const char* kvb = (const char*)(kv + (size_t)tb * 4096); const char* krb = (const char*)(krope + (size_t)tb * 64);
    const unsigned ldsw = (unsigned)wid * 1024u;
#define GLDS(gp, lp) __builtin_amdgcn_global_load_lds((const unsigned*)(gp), (LAS unsigned*)(lp), 16, 0, 0)
#define ST_ISSUE(kb_, BF) do { const char* kt_ = kvb + (size_t)(kb_) * 8192;                                                              \
        GLDS(kt_ + voff_kn, lds + MLA_KN_OFF + (BF) * MLA_TILE + ldsw); GLDS(kt_ + 32 * 8192 + voff_kn, lds + MLA_KN_OFF + (BF) * MLA_TILE + 8192 + ldsw); \
        GLDS(kt_ + voff_v, lds + MLA_V_OFF + (BF) * MLA_TILE + ldsw);   GLDS(kt_ + 32 * 8192 + voff_v, lds + MLA_V_OFF + (BF) * MLA_TILE + 8192 + ldsw);   \
        GLDS(krb + (size_t)(kb_) * 128 + voff_kr, lds + MLA_KR_OFF + (BF) * MLA_KR_BYTES + ldsw); } while (0)
    float m_reg = -1e30f, l_reg = 0.f; f32x16 o[4] = {};
    const int vb0 = (int)(size_t)(lds + MLA_V_OFF) + v_rd_base(lane);
    const LAS char* kbn[4];
#pragma unroll
    for (int dd = 0; dd < 4; ++dd) kbn[dd] = lds + MLA_KN_OFF + r32 * 256 + (((dd * 16 + hi * 8) * 2) ^ ((r32 & 7) << 4));
#define ST_ISSUE_K(kb_, BF) do { const char* kt_ = kvb + (size_t)(kb_) * 8192;                                                             \
        GLDS(kt_ + voff_kn, lds + MLA_KN_OFF + (BF) * MLA_TILE + ldsw); GLDS(kt_ + 32 * 8192 + voff_kn, lds + MLA_KN_OFF + (BF) * MLA_TILE + 8192 + ldsw); \
        GLDS(krb + (size_t)(kb_) * 128 + voff_kr, lds + MLA_KR_OFF + (BF) * MLA_KR_BYTES + ldsw); } while (0)
#define ST_ISSUE_V(kb_, BF) do { const char* kt_ = kvb + (size_t)(kb_) * 8192;                                                             \
        GLDS(kt_ + voff_v, lds + MLA_V_OFF + (BF) * MLA_TILE + ldsw);   GLDS(kt_ + 32 * 8192 + voff_v, lds + MLA_V_OFF + (BF) * MLA_TILE + 8192 + ldsw); } while (0)
#define QK_TILE(P0_, P1_, BF) do { P0_ = f32x16{}; P1_ = f32x16{};                                                                          \
        _Pragma("unroll") for (int d0 = 0; d0 < 8; ++d0) { const LAS char* a_ = kbn[d0 & 3] + (BF) * MLA_TILE + (d0 >> 2) * 128;            \
            const bf16x8 b0 = *reinterpret_cast<const LAS bf16x8*>(a_), b1 = *reinterpret_cast<const LAS bf16x8*>(a_ + 32 * 256);            \
            P0_ = __builtin_amdgcn_mfma_f32_32x32x16_bf16(b0, qr[d0], P0_, 0, 0, 0); P1_ = __builtin_amdgcn_mfma_f32_32x32x16_bf16(b1, qr[d0], P1_, 0, 0, 0); } \
        _Pragma("unroll") for (int d0 = 0; d0 < 4; ++d0) { const LAS char* a_ = kbn[d0] + (MLA_KR_OFF - MLA_KN_OFF) + (BF) * MLA_KR_BYTES;  \
            const bf16x8 b0 = *reinterpret_cast<const LAS bf16x8*>(a_), b1 = *reinterpret_cast<const LAS bf16x8*>(a_ + 128);                 \
            P0_ = __builtin_amdgcn_mfma_f32_32x32x16_bf16(b0, qr[8 + d0], P0_, 0, 0, 0); P1_ = __builtin_amdgcn_mfma_f32_32x32x16_bf16(b1, qr[8 + d0], P1_, 0, 0, 0); } } while (0)
    f32x16 pA0, pA1, pB0, pB1;
    const bool grpA = wid < 4;
#define HB(vm) do { asm volatile("s_waitcnt vmcnt(" #vm ") lgkmcnt(0)" ::: "memory"); __builtin_amdgcn_s_barrier(); asm volatile("" ::: "memory"); } while (0)
#define QK_IF(t_, P0_, P1_, BF) do { if ((t_) < NT && (t_) * KVBLK <= qlo + 31) QK_TILE(P0_, P1_, BF); } while (0)
#define SMPV(t_, C0, C1, BF) do { const int kb = (t_) * KVBLK;                                                                            \
        if (kb <= qlo + 31) {                                                                                                             \
            float mn, alpha; bf16x8 pa0, pa1, pa2, pa3;                                                                                   \
            if (kb + KVBLK - 1 > qlo) mask_tile(C0, C1, qm - kb, 0x7fffffffu);                                                            \
            partialSM(C0, C1, m_reg, mn, alpha, SCALE);                                                                                   \
            finishSM(C0, C1, alpha, l_reg, pa0, pa1, pa2, pa3);                                                                           \
            if (__any(alpha < 1.f)) { if (hi == 0) al_l[r32] = alpha; LDS_WAIT();                                                         \
                _Pragma("unroll") for (int d_ = 0; d_ < 4; ++d_) _Pragma("unroll") for (int r = 0; r < 16; ++r) o[d_][r] *= al_l[crow(r, hi)]; } \
            pv_tile<MLA_V_OFF + (BF) * MLA_TILE>(o, vb0, pa0, pa1, pa2, pa3);                                                             \
        } } while (0)
#define ISSUE_K2(kb_, BF) do { const char* kt_ = kvb + (size_t)(kb_) * 8192; const char* kr_ = krb + (size_t)(kb_) * 128;                   \
        _Pragma("unroll") for (int pp = 0; pp < 2; ++pp) {                                                                                 \
            GLDS(kt_ + pp * 16 * 8192 + voff_kn, lds + MLA_KN_OFF + (BF) * MLA_TILE + pp * 4096 + ldsw);                                    \
            GLDS(kt_ + (32 + pp * 16) * 8192 + voff_kn, lds + MLA_KN_OFF + (BF) * MLA_TILE + 8192 + pp * 4096 + ldsw);                      \
            GLDS(kr_ + pp * 16 * 128 + voff_kr, lds + MLA_KR_OFF + (BF) * MLA_KR_BYTES + pp * 4096 + ldsw); } } while (0)
#define ISSUE_V2(kb_, BF) do { const char* kt_ = kvb + (size_t)(kb_) * 8192;                                                               \
        _Pragma("unroll") for (int pp = 0; pp < 2; ++pp) {                                                                                 \
            GLDS(kt_ + pp * 16 * 8192 + voff_v, lds + MLA_V_OFF + (BF) * MLA_TILE + pp * 4096 + ldsw);                                      \
            GLDS(kt_ + (32 + pp * 16) * 8192 + voff_v, lds + MLA_V_OFF + (BF) * MLA_TILE + 8192 + pp * 4096 + ldsw); } } while (0)
    ST_ISSUE_K(0, 0); ST_ISSUE_V(0, 0); ST_ISSUE_K(KVBLK, 1);
    HB(0);
    QK_TILE(pA0, pA1, 0);
    HB(0);
    if (!grpA) HB(0);
    for (int t = 0; t < NT; t += 2) {
        if (grpA && t + 2 < NT) ISSUE_K2((t + 2) * KVBLK, 0);
        QK_IF(t + 1, pB0, pB1, 1);
        if (t + 2 < NT) HB(6); else HB(0);
        if (grpA) ISSUE_V2((t + 1) * KVBLK, 1);
        SMPV(t, pA0, pA1, 0);
        HB(4);
        if (grpA && t + 3 < NT) ISSUE_K2((t + 3) * KVBLK, 1);
        QK_IF(t + 2, pA0, pA1, 0);
        if (t + 3 < NT) HB(6); else HB(0);
        if (grpA && t + 2 < NT) ISSUE_V2((t + 2) * KVBLK, 0);
        SMPV(t + 1, pB0, pB1, 1);
        if (t + 2 < NT) HB(4); else HB(0);
    }
    if (grpA) HB(0);
#undef ISSUE_K2
#undef ISSUE_V2
#undef SMPV
#undef QK_IF
#undef HB
#undef QK_TILE
#undef ST_ISSUE_K
#undef ST_ISSUE_V
#undef TILE_STEP
#undef ST_ISSUE
#undef GLDS
    if (hi == 0) li_l[r32] = l_reg; LDS_WAIT();
    LAS char* ost = lds + wid * 8192;
#pragma unroll
    for (int r = 0; r < 16; ++r) { const int orow = crow(r, hi); const float rl = __builtin_amdgcn_rcpf(li_l[orow]);
#pragma unroll
        for (int d0 = 0; d0 < 4; ++d0) { const float v = o[d0][r] * rl; const float vn = __shfl_xor(v, 1);
            if ((r32 & 1) == 0) *(LAS unsigned*)(ost + orow * 256 + (d0 * 32 + r32) * 2) = cvt_pk_bf16(v, vn); } }
    LDS_WAIT();
    bf16_t* Ow = omla + (size_t)(tb + qlo) * 2048 + h * 128;
#pragma unroll
    for (int k = 0; k < 8; ++k) { const int row = k * 4 + (lane >> 4), ch = lane & 15;
        const u32x4 w = *(const LAS u32x4*)(ost + row * 256 + ch * 16);
        *(u32x4*)(Ow + (size_t)row * 2048 + ch * 8) = w; }
    __syncthreads();
}

constexpr int XA_K_OFF = 32768, XA_WS_OFF = 65536;
__device__ __forceinline__ void xattn_block(LAS char* lds, const bf16_t* __restrict__ qc, const bf16_t* __restrict__ kc, const bf16_t* __restrict__ vc, bf16_t* __restrict__ oc, int b, int h, int qb) {
    const float SCALE = 0.0625f;
    int tid_ = threadIdx.x; asm volatile("" : "+v"(tid_));
    const int tid = tid_, wid = __builtin_amdgcn_readfirstlane(tid >> 6), lane = tid & 63, r32 = lane & 31, hi = lane >> 5;
    const int rg = wid & 3, vsp = wid >> 2;
    LAS float* wsf = (LAS float*)(lds + XA_WS_OFF) + wid * 64; LAS float* li_l = wsf; LAS float* al_l = wsf + 32;
    const int row0 = b * SEQ + qb * 128 + rg * 32;
    bf16x8 qr[16];
    { const bf16_t* qp = qc + (size_t)(row0 + r32) * 1024 + h * 256;
#pragma unroll
      for (int d0 = 0; d0 < 16; ++d0) qr[d0] = *(const bf16x8*)(qp + d0 * 16 + hi * 8); }
    unsigned voff_k, voff_v;
    { const int row = tid >> 5, cp_ = tid & 31, g = cp_ >> 3, j = cp_ & 7;
      voff_k = (unsigned)(row * 2048 + (h * 256 + (g * 8 + (j ^ (row & 7))) * 8) * 2);
      const int kk = (tid >> 7) * 8 + ((tid & 31) >> 2), key = (kk & ~0xC) | ((kk & 4) << 1) | ((kk & 8) >> 1), c = ((tid >> 5) & 3) * 32 + (tid & 3) * 8;
      voff_v = (unsigned)(key * 2048 + (h * 256 + c) * 2); }
    const char* kcb = (const char*)(kc + (size_t)b * MEMT * 1024); const char* vcb = (const char*)(vc + (size_t)b * MEMT * 1024);
    const unsigned ldsw = (unsigned)wid * 1024u;
#define GLDS(gp, lp) __builtin_amdgcn_global_load_lds((const unsigned*)(gp), (LAS unsigned*)(lp), 16, 0, 0)
    float m_reg = -1e30f, l_reg = 0.f; f32x16 o[4] = {};
    const int vb0 = (int)(size_t)(lds + vsp * 16384) + v_rd_base(lane);
    const LAS char* kbn[4];
#pragma unroll
    for (int dd = 0; dd < 4; ++dd) kbn[dd] = lds + XA_K_OFF + r32 * 512 + (((dd * 16 + hi * 8) * 2) ^ ((r32 & 7) << 4));
    for (int t = 0; t < 4; ++t) {
        const char* kt_ = kcb + (size_t)(t * 64) * 2048; const char* vt_ = vcb + (size_t)(t * 64) * 2048;
        __syncthreads();
#pragma unroll
        for (int i = 0; i < 4; ++i) GLDS(kt_ + (size_t)i * 16 * 2048 + voff_k, lds + XA_K_OFF + i * 8192 + ldsw);
#pragma unroll
        for (int hv = 0; hv < 2; ++hv)
#pragma unroll
            for (int i = 0; i < 2; ++i) GLDS(vt_ + (size_t)i * 32 * 2048 + hv * 256 + voff_v, lds + hv * 16384 + i * 8192 + ldsw);
        asm volatile("s_waitcnt vmcnt(0)" ::: "memory");
        __syncthreads();
        f32x16 p0 = {}, p1 = {}; float mn, alpha; bf16x8 pa0, pa1, pa2, pa3;
#pragma unroll
        for (int d0 = 0; d0 < 16; ++d0) { const LAS char* a_ = kbn[d0 & 3] + (d0 >> 2) * 128;
            const bf16x8 b0 = *reinterpret_cast<const LAS bf16x8*>(a_), b1 = *reinterpret_cast<const LAS bf16x8*>(a_ + 32 * 512);
            p0 = __builtin_amdgcn_mfma_f32_32x32x16_bf16(b0, qr[d0], p0, 0, 0, 0); p1 = __builtin_amdgcn_mfma_f32_32x32x16_bf16(b1, qr[d0], p1, 0, 0, 0); }
        partialSM(p0, p1, m_reg, mn, alpha, SCALE);
        finishSM(p0, p1, alpha, l_reg, pa0, pa1, pa2, pa3);
        if (__any(alpha < 1.f)) { if (hi == 0) al_l[r32] = alpha; LDS_WAIT();
#pragma unroll
            for (int d_ = 0; d_ < 4; ++d_)
#pragma unroll
                for (int r = 0; r < 16; ++r) o[d_][r] *= al_l[crow(r, hi)]; }
        pv_tile<0>(o, vb0, pa0, pa1, pa2, pa3);
    }
#undef GLDS
    if (hi == 0) li_l[r32] = l_reg; LDS_WAIT();
    bf16_t* Ow = oc + (size_t)row0 * 1024 + h * 256 + vsp * 128;
#pragma unroll
    for (int r = 0; r < 16; ++r) { const int orow = crow(r, hi); const float rl = __builtin_amdgcn_rcpf(li_l[orow]);
#pragma unroll
        for (int d0 = 0; d0 < 4; ++d0) { const float v = o[d0][r] * rl; const float vn = __shfl_xor(v, 1);
            if ((r32 & 1) == 0) *(unsigned*)(Ow + (size_t)orow * 1024 + d0 * 32 + r32) = cvt_pk_bf16(v, vn); } }
    __syncthreads();
}
}

constexpr int STAGE_BYTES = 131072;
constexpr int MISC_OFF = STAGE_BYTES;
constexpr int XSTG_OFF = STAGE_BYTES + 256;
constexpr int LDS_BYTES = XSTG_OFF + 8 * 2304;

struct Args { const float* in[26]; float* out; unsigned char* ws; int ph_lo, ph_hi; };

struct Frame {
    LAS unsigned char* lds;
    int tid, lane, wave, G, bid;
    int gw, NGW;
    int xj, xrank, xn;
};

__device__ __forceinline__ int win_map(int n) {
    if (n < 1536) return n;
    if (n < 1600) return 7680 + (n - 1536);
    if (n < 5696) return n - 64;
    if (n < 5712) return 7744 + (n - 5696);
    return n - 80;
}
template <int MODE>
__device__ __forceinline__ void transpose_item(const float* W, int K, int N, bf16_t* WT, const float* gain, LAS float* scr, int item, int lane) {
    const int nblk = (N + 31) / 32, kb = item / nblk, nb = item % nblk, k0 = 64 * kb, n0 = 32 * nb;
    const int n4 = n0 + 4 * (lane & 7); const bool nok = n4 < N;
    f32x4 v[8];
#pragma unroll
    for (int i = 0; i < 8; ++i) v[i] = nok ? *(const f32x4*)(W + (size_t)(k0 + 8 * i + (lane >> 3)) * N + n4) : (f32x4){0.f, 0.f, 0.f, 0.f};
#pragma unroll
    for (int i = 0; i < 8; ++i) { const int kk = 8 * i + (lane >> 3); const float g = gain ? gain[k0 + kk] : 1.0f; LAS float* d = scr + kk * 33 + 4 * (lane & 7);
        d[0] = v[i][0] * g; d[1] = v[i][1] * g; d[2] = v[i][2] * g; d[3] = v[i][3] * g; }
    LDS_WAIT();
    const int c = lane & 7;
#pragma unroll
    for (int j = 0; j < 4; ++j) { const int n = (lane >> 3) + 8 * j; const LAS float* s = scr + (8 * c) * 33 + n;
        u32x4 o; o.x = cvt_pk_bf16(s[0 * 33], s[1 * 33]); o.y = cvt_pk_bf16(s[2 * 33], s[3 * 33]); o.z = cvt_pk_bf16(s[4 * 33], s[5 * 33]); o.w = cvt_pk_bf16(s[6 * 33], s[7 * 33]);
        const int ng = n0 + n;
        if (ng < N) { const int row = MODE == 1 ? win_map(ng) : ng; *(u32x4*)(WT + (size_t)row * K + k0 + 8 * c) = o; } }
    LDS_WAIT();
}
template <int MODE>
__device__ __forceinline__ void transpose_all(const Frame& F, const float* W, int K, int N, bf16_t* WT, const float* gain, int& cursor) {
    LAS float* scr = (LAS float*)(F.lds + F.wave * 8704);
    const int nitems = (K / 64) * ((N + 31) / 32);
    int first = (F.gw - cursor % F.NGW + F.NGW) % F.NGW;
    for (int it = first; it < nitems; it += F.NGW) transpose_item<MODE>(W, K, N, WT, gain, scr, it, F.lane);
    cursor += nitems;
}


__device__ __forceinline__ void p0_prologue(const Frame& F, const Args& a) {
    unsigned char* ws = a.ws;
    int cursor = 0;
    transpose_all<1>(F, a.in[5], D, IN_W, (bf16_t*)(ws + WS_WIN), a.in[4], cursor);
    transpose_all<0>(F, a.in[7], 1024, 3072, (bf16_t*)(ws + WS_WUQ), a.in[6], cursor);
    transpose_all<0>(F, a.in[9], 512, 4096, (bf16_t*)(ws + WS_WUKV), a.in[8], cursor);
    transpose_all<0>(F, a.in[14], D, D, (bf16_t*)(ws + WS_WOUT), nullptr, cursor);
    transpose_all<0>(F, a.in[16], D, 1024, (bf16_t*)(ws + WS_WCQ), a.in[15], cursor);
    transpose_all<0>(F, a.in[17], D, 1024, (bf16_t*)(ws + WS_WCK), nullptr, cursor);
    transpose_all<0>(F, a.in[18], D, 1024, (bf16_t*)(ws + WS_WCV), nullptr, cursor);
    transpose_all<0>(F, a.in[19], 1024, D, (bf16_t*)(ws + WS_WCO), nullptr, cursor);
    transpose_all<0>(F, a.in[21], D, 2048, (bf16_t*)(ws + WS_WPQ), a.in[20], cursor);
    { u32x4* z = (u32x4*)(ws + WS_WIN + (size_t)IN_W * D * 2); const size_t n16 = (size_t)(IN_WP - IN_W) * D * 2 / 16;
      for (size_t i = (size_t)F.bid * NTHREADS + F.tid; i < n16; i += (size_t)F.G * NTHREADS) z[i] = (u32x4){0u, 0u, 0u, 0u}; }
    { const float* k = a.in[22]; bf16_t* o = (bf16_t*)(ws + WS_KEYS); const size_t n8 = (size_t)8 * 2 * 128 * 128 / 8;
      for (size_t i = (size_t)F.bid * NTHREADS + F.tid; i < n8; i += (size_t)F.G * NTHREADS) {
          const f32x4 v0 = *(const f32x4*)(k + i * 8), v1 = *(const f32x4*)(k + i * 8 + 4); *(bf16x8*)(o + i * 8) = pack8(v0, v1); } }
    { const int* pos = (const int*)a.in[2]; float* cs = (float*)(ws + WS_ROPE); float* sn = cs + (size_t)M * 32;
      for (size_t i = (size_t)F.bid * NTHREADS + F.tid; i < (size_t)M * 32; i += (size_t)F.G * NTHREADS) {
          const int m = (int)(i >> 5), fi = (int)(i & 31);
          const float inv = exp2f(-(float)fi * (13.287712379549449f / 32.0f));
          const float ang = (float)pos[m] * inv;
          const float kf = rintf(ang * 0.15915494309189535f);
          float r = fmaf(-kf, 6.28125f, ang); r = fmaf(-kf, 1.9353071795864769e-3f, r);
          const float rev = r * 0.15915494309189535f;
          cs[i] = __builtin_amdgcn_cosf(rev); sn[i] = __builtin_amdgcn_sinf(rev); } }
    { const float* x = a.in[0]; bf16_t* xb = (bf16_t*)(ws + WS_XB); float* rs = (float*)(ws + WS_RSTDX);
      for (int m = F.gw; m < M; m += F.NGW) {
          const f32x4* xr = (const f32x4*)(x + (size_t)m * D); u32x2* xo = (u32x2*)(xb + (size_t)m * D); float ss = 0.f;
          f32x4 v[16];
#pragma unroll
          for (int j = 0; j < 16; ++j) v[j] = xr[F.lane + 64 * j];
#pragma unroll
          for (int j = 0; j < 16; ++j) { ss += (v[j][0] * v[j][0] + v[j][1] * v[j][1]) + (v[j][2] * v[j][2] + v[j][3] * v[j][3]);
              u32x2 p; p.x = cvt_pk_bf16(v[j][0], v[j][1]); p.y = cvt_pk_bf16(v[j][2], v[j][3]); xo[F.lane + 64 * j] = p; }
          ss = wave_sum(ss);
          if (F.lane == 0) rs[m] = 1.0f / sqrtf(ss * (1.0f / D) + EPS); } }
    { const float* mem = a.in[1]; const float* g = a.in[3]; bf16_t* mn = (bf16_t*)(ws + WS_MN);
      for (int m = F.gw; m < MROWS; m += F.NGW) {
          const f32x4* xr = (const f32x4*)(mem + (size_t)m * D); const f32x4* gr = (const f32x4*)g; u32x4* xo = (u32x4*)(mn + (size_t)m * D);
          f32x4 v[16]; float ss = 0.f;
#pragma unroll
          for (int j = 0; j < 8; ++j) { v[2 * j] = xr[2 * F.lane + 128 * j]; v[2 * j + 1] = xr[2 * F.lane + 1 + 128 * j]; }
#pragma unroll
          for (int j = 0; j < 16; ++j) ss += (v[j][0] * v[j][0] + v[j][1] * v[j][1]) + (v[j][2] * v[j][2] + v[j][3] * v[j][3]);
          ss = wave_sum(ss); const float r = 1.0f / sqrtf(ss * (1.0f / D) + EPS);
#pragma unroll
          for (int j = 0; j < 8; ++j) { const f32x4 g0 = gr[2 * F.lane + 128 * j], g1 = gr[2 * F.lane + 1 + 128 * j];
              const bf16x8 p = pack8(v[2 * j] * r * g0, v[2 * j + 1] * r * g1); xo[F.lane + 64 * j] = *(const u32x4*)&p; } } }
}


__device__ __forceinline__ unsigned short f2bf(float v) { return (unsigned short)(cvt_pk_bf16(v, 0.f) & 0xffffu); }
__device__ __forceinline__ float ssq8(bf16x8 v) { float s = 0.f;
#pragma unroll
    for (int e = 0; e < 8; ++e) { const float a = bf2f((unsigned short)v[e]); s += a * a; } return s; }
__device__ __forceinline__ void p2_stats(const Frame& F, unsigned char* ws) {
    const bf16_t* cq = (const bf16_t*)(ws + WS_CQ); const bf16_t* ckv = (const bf16_t*)(ws + WS_CKV); const bf16_t* sm = (const bf16_t*)(ws + WS_SM);
    const float* cs = (const float*)(ws + WS_ROPE); const float* sn = cs + (size_t)M * 32;
    float* rq = (float*)(ws + WS_RSTDQ); float* rkv = (float*)(ws + WS_RSTDKV); bf16_t* kr = (bf16_t*)(ws + WS_KROPE);
    for (int m = F.gw; m < M; m += F.NGW) {
        const bf16x8* a = (const bf16x8*)(cq + (size_t)m * 1024);
        float s1 = ssq8(a[2 * F.lane]) + ssq8(a[2 * F.lane + 1]);
        float s2 = ssq8(((const bf16x8*)(ckv + (size_t)m * 512))[F.lane]);
        s1 = wave_sum(s1); s2 = wave_sum(s2);
        if (F.lane == 0) { rq[m] = 1.0f / sqrtf(s1 * (1.0f / 1024.0f) + EPS); rkv[m] = 1.0f / sqrtf(s2 * (1.0f / 512.0f) + EPS); }
        if (F.lane < 32) { const float x1 = bf2f(sm[(size_t)m * 256 + F.lane]), x2 = bf2f(sm[(size_t)m * 256 + 32 + F.lane]);
            const float c = cs[(size_t)m * 32 + F.lane], s = sn[(size_t)m * 32 + F.lane];
            kr[(size_t)m * 64 + F.lane] = f2bf(x1 * c - x2 * s); kr[(size_t)m * 64 + 32 + F.lane] = f2bf(x2 * c + x1 * s); }
    }
}

__device__ __forceinline__ size_t fr_index(int cgh, int kblk, int mt, int lane, int j) { return ((((size_t)cgh * 8 + kblk) * 4 + mt) * 64 + lane) * 8 + j; }
__device__ __forceinline__ size_t kd_index(int cgh, int w, int t, int s, int lane, int j) { return (((((size_t)cgh * 8 + w) * 2 + t) * 2 + s) * 64 + lane) * 8 + j; }
__device__ __forceinline__ void p2_gla_prep(const Frame& F, unsigned char* ws, const float* __restrict__ w_gate_up, const float* __restrict__ b_gate) {
    const bf16_t* __restrict__ gq = (const bf16_t*)(ws + WS_GQ); const bf16_t* __restrict__ gk = (const bf16_t*)(ws + WS_GK); const bf16_t* __restrict__ sm = (const bf16_t*)(ws + WS_SM);
    bf16_t* __restrict__ qep = (bf16_t*)(ws + WS_QEP); bf16_t* __restrict__ kep = (bf16_t*)(ws + WS_KEP); bf16_t* __restrict__ kdt = (bf16_t*)(ws + WS_KDT); float* __restrict__ dec = (float*)(ws + WS_DEC);
    LAS float* glr = (LAS float*)F.lds;
    LAS float* tot = glr + 1024;
    LAS float* bcl = glr + 1280;
    constexpr int BP = 260;
    for (int cgh = F.bid; cgh < 1024; cgh += F.G) {
        const int cg = cgh >> 2, h = cgh & 3, t0 = cg * 64;
        __syncthreads();
        if (F.tid < 128) { const int tok = F.tid >> 1, half = F.tid & 1; const bf16x8 v = *(const bf16x8*)(sm + (size_t)(t0 + tok) * 256 + 64 + half * 8);
#pragma unroll
            for (int e = 0; e < 8; ++e) glr[tok * 16 + half * 8 + e] = bf2f((unsigned short)v[e]); }
        const int d = F.tid & 255, th = F.tid >> 8;
        float w[16];
#pragma unroll
        for (int r = 0; r < 16; ++r) w[r] = w_gate_up[r * 1024 + h * 256 + d];
        const float bg = b_gate[h * 256 + d];
        unsigned short kraw[32];
#pragma unroll
        for (int c = 0; c < 32; ++c) kraw[c] = gk[(size_t)(t0 + 32 * th + c) * 1024 + h * 256 + d];
        __syncthreads();
        float bc[32]; float cum = 0.f;
#pragma unroll
        for (int c = 0; c < 32; ++c) { float z = bg;
#pragma unroll
            for (int r4 = 0; r4 < 4; ++r4) { const f32x4 gv = *(const LAS f32x4*)(glr + (32 * th + c) * 16 + r4 * 4); z += gv[0] * w[r4 * 4] + gv[1] * w[r4 * 4 + 1] + gv[2] * w[r4 * 4 + 2] + gv[3] * w[r4 * 4 + 3]; }
            const float ls = fminf(z, 0.f) - __logf(1.0f + __expf(-fabsf(z)));
            cum += ls * (1.0f / 16.0f); bc[c] = cum; }
        if (th == 0) tot[d] = cum;
        __syncthreads();
        const float base = th ? tot[d] : 0.f;
        const float blast = th ? base + cum : 0.f;
        if (th == 1) tot[d] = blast;
#pragma unroll
        for (int c = 0; c < 32; ++c) { bc[c] += base; bcl[(32 * th + c) * BP + d] = bc[c]; }
        __syncthreads();
        const float bl = tot[d];
        if (th == 0) dec[(size_t)cgh * 256 + d] = __expf(bl);
        { const int wq = d >> 5, tq = (d >> 4) & 1, col = d & 15;
#pragma unroll
          for (int q_ = 0; q_ < 4; ++q_) { float kd8[8];
#pragma unroll
              for (int j = 0; j < 8; ++j) kd8[j] = bf2f(kraw[8 * q_ + j]) * __expf(bl - bc[8 * q_ + j]);
              *(bf16x8*)(kdt + kd_index(cgh, wq, tq, th, q_ * 16 + col, 0)) = pack8((f32x4){kd8[0], kd8[1], kd8[2], kd8[3]}, (f32x4){kd8[4], kd8[5], kd8[6], kd8[7]}); } }
        { const int c = F.tid & 63, o = F.tid >> 6; const size_t tok = (size_t)(t0 + c);
          bf16x8 qv[4], kv[4];
#pragma unroll
          for (int i = 0; i < 4; ++i) { qv[i] = *(const bf16x8*)(gq + tok * 1024 + h * 256 + 32 * o + 8 * i); kv[i] = *(const bf16x8*)(gk + tok * 1024 + h * 256 + 32 * o + 8 * i); }
          float eb[32];
#pragma unroll
          for (int i = 0; i < 8; ++i) { const f32x4 bv = *(const LAS f32x4*)(bcl + c * BP + 32 * o + 4 * i);
#pragma unroll
              for (int e = 0; e < 4; ++e) eb[4 * i + e] = __expf(bv[e]); }
#pragma unroll
          for (int q_ = 0; q_ < 4; ++q_) { float qe8[8], ke8[8];
#pragma unroll
              for (int j = 0; j < 8; ++j) { const int kk = j < 4 ? 4 * q_ + j : 16 + 4 * q_ + (j - 4);
                  const float e_ = eb[kk];
                  qe8[j] = bf2f((unsigned short)qv[kk >> 3][kk & 7]) * 0.0625f * e_; ke8[j] = bf2f((unsigned short)kv[kk >> 3][kk & 7]) * __builtin_amdgcn_rcpf(e_); }
              const size_t fi = fr_index(cgh, o, c >> 4, q_ * 16 + (c & 15), 0);
              *(bf16x8*)(qep + fi) = pack8((f32x4){qe8[0], qe8[1], qe8[2], qe8[3]}, (f32x4){qe8[4], qe8[5], qe8[6], qe8[7]});
              *(bf16x8*)(kep + fi) = pack8((f32x4){ke8[0], ke8[1], ke8[2], ke8[3]}, (f32x4){ke8[4], ke8[5], ke8[6], ke8[7]}); } }
    }
    __syncthreads();
}
__device__ __forceinline__ void p3_gla_att(const Frame& F, unsigned char* ws) {
    const bf16_t* qep = (const bf16_t*)(ws + WS_QEP); const bf16_t* kep = (const bf16_t*)(ws + WS_KEP); bf16_t* att = (bf16_t*)(ws + WS_ATT);
    const int mt = F.wave >> 1, nt0 = (F.wave & 1) * 2, col = F.lane & 15, q_ = F.lane >> 4;
    for (int cgh = F.bid; cgh < 1024; cgh += F.G) {
        f32x4 a0 = {0.f, 0.f, 0.f, 0.f}, a1 = {0.f, 0.f, 0.f, 0.f};
#pragma unroll
        for (int kb = 0; kb < 8; ++kb) { const bf16x8 A = *(const bf16x8*)(qep + fr_index(cgh, kb, mt, F.lane, 0));
            const bf16x8 B0 = *(const bf16x8*)(kep + fr_index(cgh, kb, nt0, F.lane, 0)), B1 = *(const bf16x8*)(kep + fr_index(cgh, kb, nt0 + 1, F.lane, 0));
            a0 = __builtin_amdgcn_mfma_f32_16x16x32_bf16(A, B0, a0, 0, 0, 0); a1 = __builtin_amdgcn_mfma_f32_16x16x32_bf16(A, B1, a1, 0, 0, 0); }
#pragma unroll
        for (int r = 0; r < 4; ++r) { const int c = mt * 16 + 4 * q_ + r, j0 = nt0 * 16 + col, j1 = j0 + 16;
            att[((size_t)cgh * 64 + c) * 64 + j0] = f2bf(j0 <= c ? a0[r] : 0.f); att[((size_t)cgh * 64 + c) * 64 + j1] = f2bf(j1 <= c ? a1[r] : 0.f); }
    }
}
__device__ __forceinline__ void p5_gla_scan(const Frame& F, unsigned char* ws) {
    const bf16_t* qep = (const bf16_t*)(ws + WS_QEP); const bf16_t* kdt = (const bf16_t*)(ws + WS_KDT); const bf16_t* att = (const bf16_t*)(ws + WS_ATT);
    const float* dec = (const float*)(ws + WS_DEC); const bf16_t* gv = (const bf16_t*)(ws + WS_GV); bf16_t* og = (bf16_t*)(ws + WS_OGLA);
    LAS bf16_t* vbuf = (LAS bf16_t*)F.lds;
    LAS float* red = (LAS float*)(F.lds + 4096);
    const int w = F.wave, lane = F.lane, col = lane & 15, q_ = lane >> 4;
    for (int item = F.bid; item < 256; item += F.G) {
        const int bh = item >> 5, vs = item & 31, b = bh >> 2, h = bh & 3;
        f32x4 st0 = {0.f, 0.f, 0.f, 0.f}, st1 = {0.f, 0.f, 0.f, 0.f};
        __syncthreads();
        bf16x8 vst = {};
        if (F.tid < 128) vst = *(const bf16x8*)(gv + (size_t)(b * SEQ + (F.tid >> 1)) * 2048 + h * 512 + vs * 16 + (F.tid & 1) * 8);
        if (F.tid < 128) *(LAS bf16x8*)(vbuf + (F.tid >> 1) * 16 + (F.tid & 1) * 8) = vst;
        __syncthreads();
        bf16x8 Aq[4], Ak[2][2], Aa[2] = {}; f32x4 dc0, dc1;
#define GLA_LOAD_OPS(n_) do { const int cg_ = (b * 128 + (n_)) * 4 + h;                                                                   \
            _Pragma("unroll") for (int mt = 0; mt < 4; ++mt) Aq[mt] = *(const bf16x8*)(qep + fr_index(cg_, w, mt, lane, 0));                 \
            _Pragma("unroll") for (int t = 0; t < 2; ++t) _Pragma("unroll") for (int s = 0; s < 2; ++s)                                       \
                Ak[t][s] = *(const bf16x8*)(kdt + kd_index(cg_, w, t, s, lane, 0));                                                              \
            if (w < 4) { _Pragma("unroll") for (int s = 0; s < 2; ++s) Aa[s] = *(const bf16x8*)(att + ((size_t)cg_ * 64 + 16 * w + col) * 64 + 32 * s + 8 * q_); } \
            dc0 = *(const f32x4*)(dec + (size_t)cg_ * 256 + 32 * w + 4 * q_); dc1 = *(const f32x4*)(dec + (size_t)cg_ * 256 + 32 * w + 16 + 4 * q_); } while (0)
        GLA_LOAD_OPS(0);
        for (int n = 0; n < 128; ++n) {
            const int t0 = b * SEQ + n * 64, pb = n & 1;
            if (n + 1 < 128 && F.tid < 128) vst = *(const bf16x8*)(gv + (size_t)(t0 + 64 + (F.tid >> 1)) * 2048 + h * 512 + vs * 16 + (F.tid & 1) * 8);
            bf16x8 cAq[4], cAk[2][2], cAa[2];
#pragma unroll
            for (int mt = 0; mt < 4; ++mt) cAq[mt] = Aq[mt];
#pragma unroll
            for (int t = 0; t < 2; ++t)
#pragma unroll
                for (int s = 0; s < 2; ++s) cAk[t][s] = Ak[t][s];
            cAa[0] = Aa[0]; cAa[1] = Aa[1];
            const f32x4 cdc0 = dc0, cdc1 = dc1;
            if (n + 1 < 128) GLA_LOAD_OPS(n + 1);
            bf16x8 Bv[2];
#pragma unroll
            for (int s = 0; s < 2; ++s)
#pragma unroll
                for (int j = 0; j < 8; ++j) Bv[s][j] = (short)vbuf[pb * 1024 + (32 * s + 8 * q_ + j) * 16 + col];
            u32x4 sw = {cvt_pk_bf16(st0[0], st0[1]), cvt_pk_bf16(st0[2], st0[3]), cvt_pk_bf16(st1[0], st1[1]), cvt_pk_bf16(st1[2], st1[3])};
            const bf16x8 Bs = *reinterpret_cast<bf16x8*>(&sw);
            f32x4 part[4];
#pragma unroll
            for (int mt = 0; mt < 4; ++mt) part[mt] = __builtin_amdgcn_mfma_f32_16x16x32_bf16(cAq[mt], Bs, (f32x4){0.f, 0.f, 0.f, 0.f}, 0, 0, 0);
            if (w < 4) {
#pragma unroll
                for (int mt = 0; mt < 4; ++mt) if (mt == w) {
                    part[mt] = __builtin_amdgcn_mfma_f32_16x16x32_bf16(cAa[0], Bv[0], part[mt], 0, 0, 0);
                    part[mt] = __builtin_amdgcn_mfma_f32_16x16x32_bf16(cAa[1], Bv[1], part[mt], 0, 0, 0); } }
            st0 = st0 * cdc0; st1 = st1 * cdc1;
            st0 = __builtin_amdgcn_mfma_f32_16x16x32_bf16(cAk[0][0], Bv[0], st0, 0, 0, 0); st0 = __builtin_amdgcn_mfma_f32_16x16x32_bf16(cAk[0][1], Bv[1], st0, 0, 0, 0);
            st1 = __builtin_amdgcn_mfma_f32_16x16x32_bf16(cAk[1][0], Bv[0], st1, 0, 0, 0); st1 = __builtin_amdgcn_mfma_f32_16x16x32_bf16(cAk[1][1], Bv[1], st1, 0, 0, 0);
#pragma unroll
            for (int mt = 0; mt < 4; ++mt) *(LAS f32x4*)(red + (size_t)pb * 8192 + ((w * 4 + mt) * 64 + lane) * 4) = part[mt];
            if (n + 1 < 128 && F.tid < 128) *(LAS bf16x8*)(vbuf + (pb ^ 1) * 1024 + (F.tid >> 1) * 16 + (F.tid & 1) * 8) = vst;
            __syncthreads();
            { const int e0 = F.tid * 2, mt = e0 >> 8, ln = (e0 >> 2) & 63, r0 = e0 & 3;
              float s0 = 0.f, s1 = 0.f;
#pragma unroll
              for (int ww = 0; ww < 8; ++ww) { const LAS float* p = red + (size_t)pb * 8192 + ((ww * 4 + mt) * 64 + ln) * 4 + r0; s0 += p[0]; s1 += p[1]; }
              const int c = mt * 16 + 4 * (ln >> 4) + r0, cc = ln & 15;
              og[(size_t)(t0 + c) * 2048 + h * 512 + vs * 16 + cc] = f2bf(s0); og[(size_t)(t0 + c + 1) * 2048 + h * 512 + vs * 16 + cc] = f2bf(s1); }
        }
    }
#undef GLA_LOAD_OPS
    __syncthreads();
}

__device__ __forceinline__ void p6_mix(const Frame& F, unsigned char* ws, const float* g_mla, const float* g_gla) {
    const bf16_t* om = (const bf16_t*)(ws + WS_OMLA); bf16_t* mx = (bf16_t*)(ws + WS_XB); const bf16_t* og = (const bf16_t*)(ws + WS_OGLA); const bf16_t* gog = (const bf16_t*)(ws + WS_GOG);
    for (int m = F.gw; m < M; m += F.NGW) {
        const bf16x8* a = (const bf16x8*)(om + (size_t)m * 2048); bf16x8 v[4]; float ss = 0.f;
#pragma unroll
        for (int j = 0; j < 4; ++j) { v[j] = a[F.lane + 64 * j]; ss += ssq8(v[j]); }
        ss = wave_sum(ss); const float r = 1.0f / sqrtf(ss * (1.0f / 2048.0f) + EPS);
        u32x4* o = (u32x4*)(mx + (size_t)m * D);
#pragma unroll
        for (int j = 0; j < 4; ++j) { const int c0 = (F.lane + 64 * j) * 8; const f32x4 g0 = *(const f32x4*)(g_mla + c0), g1 = *(const f32x4*)(g_mla + c0 + 4);
            f32x4 x0, x1;
#pragma unroll
            for (int e = 0; e < 4; ++e) { x0[e] = bf2f((unsigned short)v[j][e]) * r * g0[e]; x1[e] = bf2f((unsigned short)v[j][4 + e]) * r * g1[e]; }
            const bf16x8 p = pack8(x0, x1); o[F.lane + 64 * j] = *(const u32x4*)&p; }
        const bf16x8* ga = (const bf16x8*)(og + (size_t)m * 2048); const bf16x8* gg = (const bf16x8*)(gog + (size_t)m * 2048);
#pragma unroll
        for (int j = 0; j < 4; ++j) { const bf16x8 ov = ga[F.lane + 64 * j], gt = gg[F.lane + 64 * j];
            const float hs = wave_sum(ssq8(ov)); const float rh = 1.0f / sqrtf(hs * (1.0f / 512.0f) + EPS);
            const int c0 = F.lane * 8; const f32x4 g0 = *(const f32x4*)(g_gla + c0), g1 = *(const f32x4*)(g_gla + c0 + 4);
            f32x4 x0, x1;
#pragma unroll
            for (int e = 0; e < 4; ++e) { const float z0 = bf2f((unsigned short)gt[e]), z1 = bf2f((unsigned short)gt[4 + e]);
                x0[e] = bf2f((unsigned short)ov[e]) * rh * g0[e] * (z0 / (1.0f + __expf(-z0)));
                x1[e] = bf2f((unsigned short)ov[4 + e]) * rh * g1[e] * (z1 / (1.0f + __expf(-z1))); }
            const bf16x8 p = pack8(x0, x1); o[256 + F.lane + 64 * j] = *(const u32x4*)&p; }
    }
}
__device__ __forceinline__ void p4_mla(const Frame& F, unsigned char* ws) {
    const bf16_t* q = (const bf16_t*)(ws + WS_Q); const bf16_t* kv = (const bf16_t*)(ws + WS_KV); const bf16_t* kr = (const bf16_t*)(ws + WS_KROPE);
    const float* cs = (const float*)(ws + WS_ROPE); const float* sn = cs + (size_t)M * 32; bf16_t* om = (bf16_t*)(ws + WS_OMLA);
    for (int L = F.bid; L < 512; L += F.G) {
        const int xcd = L & 7, I = L >> 3, bh = xcd * 4 + (I >> 4), pr = I & 15, b = bh >> 4, h = bh & 15;
        for (int pass = 0; pass < 2; ++pass) att::mla_block((LAS char*)F.lds, q, kv, kr, cs, sn, om, b, h, pass ? pr : 31 - pr);
    }
}


__device__ __forceinline__ void rstd_for_units(const Frame& F, const pg8::StaticOrder& S, const float* __restrict__ ssq, float* __restrict__ rstd) {
    pg8::Unit u;
    for (int i = 0; S.next(i, u); ++i) {
        float v[32];
#pragma unroll
        for (int k = 0; k < 32; ++k) v[k] = ssq[(size_t)(u.pm * 256 + F.wave * 32 + k) * 64 + F.lane];
        float mine = 0.f;
#pragma unroll
        for (int k = 0; k < 32; ++k) { const float s = wave_sum(v[k]); mine = (F.lane == k) ? s : mine; }
        if (F.lane < 32) rstd[u.pm * 256 + F.wave * 32 + F.lane] = 1.0f / sqrtf(mine * (1.0f / D) + EPS);
    }
    asm volatile("s_waitcnt vmcnt(0)" ::: "memory");
    __syncthreads();
}
__device__ __forceinline__ void p9_xattn(const Frame& F, unsigned char* ws) {
    const bf16_t* qc = (const bf16_t*)(ws + WS_QC); const bf16_t* kc = (const bf16_t*)(ws + WS_KC); const bf16_t* vc = (const bf16_t*)(ws + WS_VC); bf16_t* oc = (bf16_t*)(ws + WS_OC);
    for (int L = F.bid; L < 512; L += F.G) { const int h = L & 3, blk = L >> 2, b = blk >> 6, qb = blk & 63;
        att::xattn_block((LAS char*)F.lds, qc, kc, vc, oc, b, h, qb); }
}


typedef float f32x2 __attribute__((ext_vector_type(2)));
__device__ __forceinline__ bool fp4_probe_ok() {
    float a = 1.0f, b = 3.0f, c = 0.5f, d = 6.0f; asm volatile("" : "+v"(a), "+v"(b), "+v"(c), "+v"(d));
    unsigned w = 0u;
    w = __builtin_amdgcn_cvt_scalef32_pk_fp4_f32(w, a, b, 1.0f, 0); w = __builtin_amdgcn_cvt_scalef32_pk_fp4_f32(w, c, d, 1.0f, 3);
    const f32x2 y0 = __builtin_amdgcn_cvt_scalef32_pk_f32_fp4(w, 1.0f, 0), y3 = __builtin_amdgcn_cvt_scalef32_pk_f32_fp4(w, 1.0f, 3), y1 = __builtin_amdgcn_cvt_scalef32_pk_f32_fp4(w, 1.0f, 1);
    return y0.x == 1.0f && y0.y == 3.0f && y3.x == 0.5f && y3.y == 6.0f && y1.x == 0.0f && y1.y == 0.0f;
}
#define DPP_MAX(v, ctrl) (v) = fmaxf((v), __int_as_float(__builtin_amdgcn_update_dpp(0, __float_as_int(v), (ctrl), 0xF, 0xF, false)))
__device__ __forceinline__ void peer_tables_to_fp4(const Frame& F, unsigned char* ws, const float* pu, const float* pv) {
    const bool ok = fp4_probe_ok();
    for (int r = F.gw; r < 2 * 16384; r += F.NGW) {
        const int tab = r >= 16384, row = r & 16383;
        const float* srow = (tab ? pv : pu) + (size_t)row * D;
        unsigned char* vals = ws + (tab ? WS_VB : WS_UB); float* rsc = (float*)(ws + (tab ? WS_VSC : WS_USC));
        float ss = 0.f, am = 0.f;
#pragma unroll
        for (int kh = 0; kh < 2; ++kh) { f32x4 v[8];
#pragma unroll
            for (int k8 = 0; k8 < 8; ++k8) v[k8] = *(const f32x4*)(srow + (kh * 8 + k8) * 256 + F.lane * 4);
#pragma unroll
            for (int k8 = 0; k8 < 8; ++k8) { ss += (v[k8][0] * v[k8][0] + v[k8][1] * v[k8][1]) + (v[k8][2] * v[k8][2] + v[k8][3] * v[k8][3]);
                am = fmaxf(am, fmaxf(fmaxf(fabsf(v[k8][0]), fabsf(v[k8][1])), fmaxf(fabsf(v[k8][2]), fabsf(v[k8][3])))); } }
        ss = wave_sum(ss);
        DPP_MAX(am, 0xB1); DPP_MAX(am, 0x4E); DPP_MAX(am, 0x141); DPP_MAX(am, 0x140);
        am = fmaxf(fmaxf(__int_as_float(__builtin_amdgcn_readlane(__float_as_int(am), 0)), __int_as_float(__builtin_amdgcn_readlane(__float_as_int(am), 16))),
                   fmaxf(__int_as_float(__builtin_amdgcn_readlane(__float_as_int(am), 32)), __int_as_float(__builtin_amdgcn_readlane(__float_as_int(am), 48))));
        const float top = fminf(am, 3.0f * sqrtf(ss * (1.0f / D)));
        const float sc = top > 0.f ? top * (1.0f / 6.0f) : 1.0f, inv = 1.0f / sc;
        if (F.lane == 0) rsc[row] = ok ? sc : __uint_as_float(0x7FC00000u);
#pragma unroll
        for (int kh = 0; kh < 2; ++kh) { f32x4 v[8];
#pragma unroll
            for (int k8 = 0; k8 < 8; ++k8) v[k8] = *(const f32x4*)(srow + (kh * 8 + k8) * 256 + F.lane * 4);
#pragma unroll
            for (int k8 = 0; k8 < 8; ++k8) { const int k = kh * 8 + k8;
                const float q0 = fminf(fmaxf(v[k8][0] * inv, -6.0f), 6.0f), q1 = fminf(fmaxf(v[k8][1] * inv, -6.0f), 6.0f), q2 = fminf(fmaxf(v[k8][2] * inv, -6.0f), 6.0f), q3 = fminf(fmaxf(v[k8][3] * inv, -6.0f), 6.0f);
                unsigned p = 0u;
                p = __builtin_amdgcn_cvt_scalef32_pk_fp4_f32(p, q0, q1, 1.0f, 0); p = __builtin_amdgcn_cvt_scalef32_pk_fp4_f32(p, q2, q3, 1.0f, 1);
                const size_t sl = (size_t)(k >> 1) * 16384 + row;
                *(unsigned short*)(vals + sl * 256 + (k & 1) * 128 + 2 * F.lane) = (unsigned short)p; } }
    }
}
#define CE_(a, b) do { const float hi_ = fmaxf(a, b), lo_ = fminf(a, b); a = hi_; b = lo_; } while (0)
__device__ __forceinline__ void sort16_desc(float (&v)[16]) {
    CE_(v[0], v[1]); CE_(v[2], v[3]); CE_(v[0], v[2]); CE_(v[1], v[3]); CE_(v[1], v[2]); CE_(v[4], v[5]); CE_(v[6], v[7]); CE_(v[4], v[6]); CE_(v[5], v[7]); CE_(v[5], v[6]); CE_(v[0], v[4]); CE_(v[2], v[6]); CE_(v[2], v[4]); CE_(v[1], v[5]); CE_(v[3], v[7]); CE_(v[3], v[5]); CE_(v[1], v[2]); CE_(v[3], v[4]); CE_(v[5], v[6]); CE_(v[8], v[9]); CE_(v[10], v[11]); CE_(v[8], v[10]); CE_(v[9], v[11]); CE_(v[9], v[10]); CE_(v[12], v[13]); CE_(v[14], v[15]); CE_(v[12], v[14]); CE_(v[13], v[15]); CE_(v[13], v[14]); CE_(v[8], v[12]); CE_(v[10], v[14]); CE_(v[10], v[12]); CE_(v[9], v[13]); CE_(v[11], v[15]); CE_(v[11], v[13]); CE_(v[9], v[10]); CE_(v[11], v[12]); CE_(v[13], v[14]); CE_(v[0], v[8]); CE_(v[4], v[12]); CE_(v[4], v[8]); CE_(v[2], v[10]); CE_(v[6], v[14]); CE_(v[6], v[10]); CE_(v[2], v[4]); CE_(v[6], v[8]); CE_(v[10], v[12]); CE_(v[1], v[9]); CE_(v[5], v[13]); CE_(v[5], v[9]); CE_(v[3], v[11]); CE_(v[7], v[15]); CE_(v[7], v[11]); CE_(v[3], v[5]); CE_(v[7], v[9]); CE_(v[11], v[13]); CE_(v[1], v[2]); CE_(v[3], v[4]); CE_(v[5], v[6]); CE_(v[7], v[8]); CE_(v[9], v[10]); CE_(v[11], v[12]); CE_(v[13], v[14]);
}
__device__ __forceinline__ void bitonic16_desc(float (&v)[16]) {
    CE_(v[0], v[8]); CE_(v[1], v[9]); CE_(v[2], v[10]); CE_(v[3], v[11]); CE_(v[4], v[12]); CE_(v[5], v[13]); CE_(v[6], v[14]); CE_(v[7], v[15]); CE_(v[0], v[4]); CE_(v[1], v[5]); CE_(v[2], v[6]); CE_(v[3], v[7]); CE_(v[8], v[12]); CE_(v[9], v[13]); CE_(v[10], v[14]); CE_(v[11], v[15]); CE_(v[0], v[2]); CE_(v[1], v[3]); CE_(v[4], v[6]); CE_(v[5], v[7]); CE_(v[8], v[10]); CE_(v[9], v[11]); CE_(v[12], v[14]); CE_(v[13], v[15]); CE_(v[0], v[1]); CE_(v[2], v[3]); CE_(v[4], v[5]); CE_(v[6], v[7]); CE_(v[8], v[9]); CE_(v[10], v[11]); CE_(v[12], v[13]); CE_(v[14], v[15]);
}

__device__ __forceinline__ void merge_top16(float (&a)[16], const float (&b)[16]) {
#pragma unroll
    for (int i = 0; i < 16; ++i) a[i] = fmaxf(a[i], b[15 - i]);
    bitonic16_desc(a);
}
__device__ __forceinline__ void top16_of_64(const float (&s)[64], float (&t)[16]) {
    float g1[16], g2[16], g3[16];
#pragma unroll
    for (int i = 0; i < 16; ++i) { t[i] = s[i]; g1[i] = s[16 + i]; g2[i] = s[32 + i]; g3[i] = s[48 + i]; }
    sort16_desc(t); sort16_desc(g1); sort16_desc(g2); sort16_desc(g3);
    merge_top16(t, g1); merge_top16(g2, g3); merge_top16(t, g2);
}
__device__ __forceinline__ void p12_topk(const Frame& F, unsigned char* ws) {
    const bf16_t* qp = (const bf16_t*)(ws + WS_QP); const bf16_t* keys = (const bf16_t*)(ws + WS_KEYS); int* ids = (int*)(ws + WS_IDS); float* gates = (float*)(ws + WS_GATES);
    const float NEG = -__builtin_inff();
#pragma unroll 1
    for (int task = F.gw; task < 4096; task += F.NGW) {
        int lane_ = F.lane; asm volatile("" : "+v"(lane_));
        const int tok = lane_ & 31, hi = lane_ >> 5;
        const int h = task & 7, token = (task >> 3) * 32 + tok;
        float top[2][16];
#pragma unroll
        for (int p = 0; p < 2; ++p) {
            bf16x8 qr[8];
#pragma unroll
            for (int d0 = 0; d0 < 8; ++d0) qr[d0] = *(const bf16x8*)(qp + (size_t)token * 2048 + h * 256 + p * 128 + d0 * 16 + hi * 8);
            float s[64];
#pragma unroll
            for (int kb = 0; kb < 4; ++kb) { f32x16 acc = {};
                const bf16_t* kp = keys + ((size_t)((h * 2 + p) * 128 + kb * 32 + tok)) * 128 + hi * 8;
#pragma unroll
                for (int d0 = 0; d0 < 8; ++d0) acc = __builtin_amdgcn_mfma_f32_32x32x16_bf16(*(const bf16x8*)(kp + d0 * 16), qr[d0], acc, 0, 0, 0);
#pragma unroll
                for (int r = 0; r < 16; ++r) { const int idx = kb * 32 + (r & 3) + 8 * (r >> 2) + 4 * hi;
                    s[kb * 16 + r] = __uint_as_float((__float_as_uint(acc[r]) & ~0x7Fu) | (unsigned)(127 - idx)); } }
            float t[16]; top16_of_64(s, t);
            float pt[16];
#pragma unroll
            for (int i = 0; i < 16; ++i) { const unsigned own = __float_as_uint(t[i]); auto rr = __builtin_amdgcn_permlane32_swap(own, own, false, false); pt[i] = __uint_as_float(rr[0] ^ rr[1] ^ own); }
            merge_top16(t, pt);
#pragma unroll
            for (int i = 0; i < 16; ++i) top[p][i] = t[i];
        }
        float c[64], cs_[16];
#define CAND_(k, i, j) c[k] = __uint_as_float((__float_as_uint(top[0][i] + top[1][j]) & ~0xFFu) | (unsigned)(255 - ((i) * 16 + (j))))
        CAND_(0, 0, 0); CAND_(1, 0, 1); CAND_(2, 0, 2); CAND_(3, 0, 3); CAND_(4, 0, 4); CAND_(5, 0, 5); CAND_(6, 0, 6); CAND_(7, 0, 7); CAND_(8, 0, 8); CAND_(9, 0, 9); CAND_(10, 0, 10); CAND_(11, 0, 11); CAND_(12, 0, 12); CAND_(13, 0, 13); CAND_(14, 0, 14); CAND_(15, 0, 15); CAND_(16, 1, 0); CAND_(17, 1, 1); CAND_(18, 1, 2); CAND_(19, 1, 3); CAND_(20, 1, 4); CAND_(21, 1, 5); CAND_(22, 1, 6); CAND_(23, 1, 7); CAND_(24, 2, 0); CAND_(25, 2, 1); CAND_(26, 2, 2); CAND_(27, 2, 3); CAND_(28, 2, 4); CAND_(29, 3, 0); CAND_(30, 3, 1); CAND_(31, 3, 2); CAND_(32, 3, 3); CAND_(33, 4, 0); CAND_(34, 4, 1); CAND_(35, 4, 2); CAND_(36, 5, 0); CAND_(37, 5, 1); CAND_(38, 6, 0); CAND_(39, 6, 1); CAND_(40, 7, 0); CAND_(41, 7, 1); CAND_(42, 8, 0); CAND_(43, 9, 0); CAND_(44, 10, 0); CAND_(45, 11, 0); CAND_(46, 12, 0); CAND_(47, 13, 0); CAND_(48, 14, 0); CAND_(49, 15, 0);
#undef CAND_
#pragma unroll
        for (int k = 50; k < 64; ++k) c[k] = NEG;
        top16_of_64(c, cs_);
        int ex[16];
#pragma unroll
        for (int k = 0; k < 16; ++k) { const int flat = 255 - (int)(__float_as_uint(cs_[k]) & 0xFFu), ci = flat >> 4, cj = flat & 15;
            float t0 = top[0][0], t1 = top[1][0];
#pragma unroll
            for (int t = 1; t < 16; ++t) { t0 = (ci == t) ? top[0][t] : t0; t1 = (cj == t) ? top[1][t] : t1; }
            const int i1 = 127 - (int)(__float_as_uint(t0) & 0x7Fu), i2 = 127 - (int)(__float_as_uint(t1) & 0x7Fu);
            ex[k] = i1 * 128 + i2; }
        float den = 0.f, ev[16];
#pragma unroll
        for (int k = 0; k < 16; ++k) { ev[k] = __expf(cs_[k] - cs_[0]); den += ev[k]; }
        const float rden = 1.0f / den;
        const size_t ob = ((size_t)token * 8 + h) * 16;
        if (hi == 0) {
#pragma unroll
            for (int k4 = 0; k4 < 4; ++k4) *(int4*)(ids + ob + k4 * 4) = make_int4(ex[k4 * 4], ex[k4 * 4 + 1], ex[k4 * 4 + 2], ex[k4 * 4 + 3]); }
        else {
#pragma unroll
            for (int k4 = 0; k4 < 4; ++k4) *(f32x4*)(gates + ob + k4 * 4) = (f32x4){ev[k4 * 4] * rden, ev[k4 * 4 + 1] * rden, ev[k4 * 4 + 2] * rden, ev[k4 * 4 + 3] * rden}; }
    }
}
__device__ __forceinline__ float gelu_erf(float v) {
    const float av = fabsf(v), t = __builtin_amdgcn_rcpf(fmaf(av, 0.2316418882f, 1.0f));
    float q = fmaf(t, 0.5307027145f, -0.7265760135f); q = fmaf(q, t, 0.7107068705f); q = fmaf(q, t, -0.142248368f); q = fmaf(q, t, 0.127414796f); q = q * t;
    const float e = __builtin_amdgcn_exp2f(v * v * -0.72134752044f), m = v * (q * e);
    return v < 0.f ? m : v - m;
}
struct PRow { u32x4 v; };
#define ROW16_ADD(v) do { DPP_ADD(v, 0xB1, 0xF); DPP_ADD(v, 0x4E, 0xF); DPP_ADD(v, 0x141, 0xF); DPP_ADD(v, 0x140, 0xF); } while (0)
#define PW_LOAD(W, q0, idp, vb, sb) do { const u32x4 ia_ = *(const LAS u32x4*)((idp) + (q0)), ib_ = *(const LAS u32x4*)((idp) + (q0) + 4); \
        _Pragma("unroll") for (int r_ = 0; r_ < 8; ++r_) { const unsigned id_ = r_ < 4 ? ia_[r_ & 3] : ib_[r_ & 3]; \
            W[r_].v = *(const u32x4*)((vb) + ((id_ << 8) + i16)); } } while (0)
#define PD_COMP(W, q0, ap) do { const u32x4 ta1_ = *(const LAS u32x4*)((ap) + (q0)), tb1_ = *(const LAS u32x4*)((ap) + (q0) + 4), tas_ = *(const LAS u32x4*)((ap) + 256 + (q0)), tbs_ = *(const LAS u32x4*)((ap) + 256 + (q0) + 4); \
        _Pragma("unroll") for (int r_ = 0; r_ < 8; ++r_) { const unsigned d1_ = r_ < 4 ? ta1_[r_ & 3] : tb1_[r_ & 3]; const int s1_ = (int)(r_ < 4 ? tas_[r_ & 3] : tbs_[r_ & 3]); \
            const i32x8 A8_ = {(int)W[r_].v.x, (int)W[r_].v.y, (int)W[r_].v.z, (int)W[r_].v.w, 0, 0, 0, 0}; \
            if (r_ & 1) { Q1a[0] = (int)(d1_ & mlo); Q1a[1] = (int)(d1_ & mhi); Q1b[2] = Q1a[0]; Q1b[3] = Q1a[1]; \
                y[2] = __builtin_amdgcn_mfma_scale_f32_16x16x128_f8f6f4(A8_, Q1a, y[2], 4, 4, 0, 127, 0, s1_); y[3] = __builtin_amdgcn_mfma_scale_f32_16x16x128_f8f6f4(A8_, Q1b, y[3], 4, 4, 0, 127, 0, s1_); } \
            else { P1a[0] = (int)(d1_ & mlo); P1a[1] = (int)(d1_ & mhi); P1b[2] = P1a[0]; P1b[3] = P1a[1]; \
                y[0] = __builtin_amdgcn_mfma_scale_f32_16x16x128_f8f6f4(A8_, P1a, y[0], 4, 4, 0, 127, 0, s1_); y[1] = __builtin_amdgcn_mfma_scale_f32_16x16x128_f8f6f4(A8_, P1b, y[1], 4, 4, 0, 127, 0, s1_); } } \
        __builtin_amdgcn_sched_barrier(0); } while (0)
#define BF_LO(w) __uint_as_float((w) << 16)
#define BF_HI(w) __uint_as_float((w) & 0xffff0000u)
#define FP4X2(q, k) __builtin_amdgcn_cvt_scalef32_pk_f32_fp4((q), 1.0f, (k))
__device__ __forceinline__ void p12c_quant(const Frame& F, unsigned char* ws, const float* g_ffn) {
    const bf16_t* h2b = (const bf16_t*)(ws + WS_H2B); unsigned char* xq = ws + WS_XQ; unsigned char* xsc = ws + WS_XQS;
    const bool ok = fp4_probe_ok();
#pragma unroll 1
    for (int token = F.gw; token < M; token += F.NGW) {
        int lane_ = F.lane; asm volatile("" : "+v"(lane_)); const int lane = lane_;
#pragma unroll
        for (int blk = 0; blk < 2; ++blk) { const int c0 = 64 * lane + 32 * blk;
            float v[32];
#pragma unroll
            for (int m = 0; m < 4; ++m) { const u32x4 hw = *(const u32x4*)(h2b + (size_t)token * D + c0 + 8 * m); const f32x4 g0 = *(const f32x4*)(g_ffn + c0 + 8 * m), g1 = *(const f32x4*)(g_ffn + c0 + 8 * m + 4);
                v[8 * m + 0] = BF_LO(hw.x) * g0[0]; v[8 * m + 1] = BF_HI(hw.x) * g0[1]; v[8 * m + 2] = BF_LO(hw.y) * g0[2]; v[8 * m + 3] = BF_HI(hw.y) * g0[3];
                v[8 * m + 4] = BF_LO(hw.z) * g1[0]; v[8 * m + 5] = BF_HI(hw.z) * g1[1]; v[8 * m + 6] = BF_LO(hw.w) * g1[2]; v[8 * m + 7] = BF_HI(hw.w) * g1[3]; }
#pragma unroll
            for (int term = 0; term < 2; ++term) { float am = 0.f;
#pragma unroll
                for (int k = 0; k < 32; ++k) am = fmaxf(am, fabsf(v[k]));
                const unsigned rb = __float_as_uint(am * (1.0f / 6.0f));
                int e = (int)(rb >> 23) - 127 + ((rb & 0x7FFFFFu) != 0u ? 1 : 0); e = e < -120 ? -120 : (e > 120 ? 120 : e);
                const float inv = __uint_as_float((unsigned)(127 - e) << 23), sc = __uint_as_float((unsigned)(127 + e) << 23);
                unsigned w[4];
#pragma unroll
                for (int k = 0; k < 4; ++k) { unsigned d = 0u;
                    d = __builtin_amdgcn_cvt_scalef32_pk_fp4_f32(d, v[8 * k] * inv, v[8 * k + 1] * inv, 1.0f, 0); d = __builtin_amdgcn_cvt_scalef32_pk_fp4_f32(d, v[8 * k + 2] * inv, v[8 * k + 3] * inv, 1.0f, 1);
                    d = __builtin_amdgcn_cvt_scalef32_pk_fp4_f32(d, v[8 * k + 4] * inv, v[8 * k + 5] * inv, 1.0f, 2); d = __builtin_amdgcn_cvt_scalef32_pk_fp4_f32(d, v[8 * k + 6] * inv, v[8 * k + 7] * inv, 1.0f, 3);
                    w[k] = d;
                    if (term == 0) { const f32x2 y0 = FP4X2(d, 0), y1 = FP4X2(d, 1), y2 = FP4X2(d, 2), y3 = FP4X2(d, 3);
                        v[8 * k] -= y0.x * sc; v[8 * k + 1] -= y0.y * sc; v[8 * k + 2] -= y1.x * sc; v[8 * k + 3] -= y1.y * sc; v[8 * k + 4] -= y2.x * sc; v[8 * k + 5] -= y2.y * sc; v[8 * k + 6] -= y3.x * sc; v[8 * k + 7] -= y3.y * sc; } }
                *(u32x4*)(xq + (size_t)term * M * 2048 + (size_t)token * 2048 + c0 / 2) = (u32x4){w[0], w[1], w[2], w[3]};
                xsc[(size_t)term * M * 128 + (size_t)token * 128 + 2 * lane + blk] = (unsigned char)(ok ? (unsigned)(e + 127) : 255u); }
        }
    }
}
typedef int i32x8 __attribute__((ext_vector_type(8)));
#define UG_LOAD(SB, TB, CB, idp) do { _Pragma("unroll") for (int tt_ = 0; tt_ < 4; ++tt_) _Pragma("unroll") for (int h_ = 0; h_ < 2; ++h_) { const unsigned id_ = (idp)[16 * ((TB) + tt_) + 8 * h_]; \
        __builtin_amdgcn_global_load_lds((const unsigned*)(uvj + ((id_ << 8) + 64u * (CB) + gsw16)), (LAS unsigned*)(slots + ((SB) + tt_ * 2 + h_) * 1024), 16, 0, 0); } \
        __builtin_amdgcn_sched_barrier(0); } while (0)
#define BPERM(v) ((unsigned)__builtin_amdgcn_ds_bpermute(pa, (int)(v)))
#define UG_COMP(SB, TB, CB, xp, NV) do { asm volatile("s_waitcnt vmcnt(" #NV ")" ::: "memory"); __builtin_amdgcn_sched_barrier(0); \
        u32x4 P_[8]; _Pragma("unroll") for (int tt_ = 0; tt_ < 4; ++tt_) { P_[tt_ * 2] = *(const LAS u32x4*)(slots + ((SB) + tt_ * 2) * 1024 + rdo0); P_[tt_ * 2 + 1] = *(const LAS u32x4*)(slots + ((SB) + tt_ * 2) * 1024 + rdo1); } \
        _Pragma("unroll") for (int cc_ = 0; cc_ < 2; ++cc_) { const int c_ = (CB) + cc_; \
            const u32x4 b0_ = *(const LAS u32x4*)((xp) + 64 * c_), b1_ = *(const LAS u32x4*)((xp) + 256 + 64 * c_); \
            const int s0_ = (int)*(const LAS unsigned char*)((xp) + 512 + 4 * c_ - 15 * kq), s1_ = (int)*(const LAS unsigned char*)((xp) + 528 + 4 * c_ - 15 * kq); \
            const i32x8 x0_ = {(int)b0_.x, (int)b0_.y, (int)b0_.z, (int)b0_.w, 0, 0, 0, 0}, x1_ = {(int)b1_.x, (int)b1_.y, (int)b1_.z, (int)b1_.w, 0, 0, 0, 0}; \
            _Pragma("unroll") for (int tt_ = 0; tt_ < 4; ++tt_) { const u32x4 q_ = P_[tt_ * 2 + cc_]; const i32x8 A8_ = {(int)q_.x, (int)q_.y, (int)q_.z, (int)q_.w, 0, 0, 0, 0}; \
                dacc[(TB) + tt_] = __builtin_amdgcn_mfma_scale_f32_16x16x128_f8f6f4(A8_, x0_, dacc[(TB) + tt_], 4, 4, 0, 127, 0, s0_); } \
            _Pragma("unroll") for (int tt_ = 0; tt_ < 4; ++tt_) { const u32x4 q_ = P_[tt_ * 2 + cc_]; const i32x8 A8_ = {(int)q_.x, (int)q_.y, (int)q_.z, (int)q_.w, 0, 0, 0, 0}; \
                dacc[(TB) + tt_] = __builtin_amdgcn_mfma_scale_f32_16x16x128_f8f6f4(A8_, x1_, dacc[(TB) + tt_], 4, 4, 0, 127, 0, s1_); } } \
        __builtin_amdgcn_sched_barrier(0); } while (0)
__device__ __forceinline__ void p13a_up(const Frame& F, unsigned char* ws) {
    const int j = F.xj, lw = F.xrank * NWAVES + F.wave, nw = F.xn * NWAVES;
    int lane_ = F.lane; asm volatile("" : "+v"(lane_));
    const int lane = lane_, r = lane & 15, kq = lane >> 4, ge = lane >> 2; const unsigned gp4 = 4u * (unsigned)(lane & 3), l4 = 4u * (unsigned)lane;
    const unsigned gsw16 = 16u * (unsigned)((lane & 7) ^ ((lane >> 3) & 6));
    const int rdo0 = (r >> 3) * 1024 + 128 * (r & 7) + 16 * (kq ^ (r & 6)), rdo1 = (r >> 3) * 1024 + 128 * (r & 7) + 16 * ((4 + kq) ^ (r & 6));
    const unsigned char* uvj = ws + WS_UB + (size_t)j * 16384 * 256; const unsigned char* usj = ws + WS_UB + PEER_VAL_BYTES + (size_t)j * 16384 * 16;
    const unsigned char* ids = ws + WS_IDS;
    const unsigned char* xq = ws + WS_XQ + (size_t)(lane >> 5) * M * 2048 + 256 * j + 8 * (lane & 31);
    const unsigned char* xsc = ws + WS_XQS + (size_t)((lane >> 4) & 1) * M * 128 + 16 * j + (lane & 15);
    float* pd = (float*)(ws + WS_PD) + (size_t)j * M * 128 + 4 * kq;
    LAS unsigned char* wl = F.lds + XSTG_OFF + F.wave * 2304; LAS unsigned char* slots = F.lds + F.wave * 16384;
    int t = lw; if (t >= M) return;
    { LAS unsigned* il = (LAS unsigned*)wl; const unsigned char* ip = ids + (size_t)t * 512; il[lane] = *(const unsigned*)(ip + l4); il[64 + lane] = *(const unsigned*)(ip + 256 + l4);
      *(LAS u32x2*)(wl + 512 + 8 * lane) = *(const u32x2*)(xq + (size_t)t * 2048); if (lane < 32) wl[1024 + lane] = xsc[(size_t)t * 128]; }
    UG_LOAD(0, 0, 0, (const LAS unsigned*)wl + (lane >> 3));
    asm volatile("s_waitcnt vmcnt(0)" ::: "memory");
    int buf = 0;
#pragma unroll 1
    for (; t < M; t += nw) {
        const int tn = (t + nw < M) ? t + nw : t;
        const LAS unsigned char* cb = wl + buf * 1152; LAS unsigned char* nb = wl + (buf ^ 1) * 1152;
        const LAS unsigned* idc = (const LAS unsigned*)cb + (lane >> 3); const LAS unsigned char* xc = cb + 512 + 16 * kq;
        const unsigned char* ip = ids + (size_t)tn * 512; const unsigned idn0 = *(const unsigned*)(ip + l4), idn1 = *(const unsigned*)(ip + 256 + l4);
        const u32x2 xn = *(const u32x2*)(xq + (size_t)tn * 2048); const unsigned char sn = xsc[(size_t)tn * 128];
        __builtin_amdgcn_sched_barrier(0);
        f32x4 dacc[8];
#pragma unroll
        for (int T = 0; T < 8; ++T) dacc[T] = (f32x4){0.f, 0.f, 0.f, 0.f};
        UG_LOAD(8, 4, 0, idc); UG_COMP(0, 0, 0, xc, 8);
        UG_LOAD(0, 0, 2, idc); UG_COMP(8, 4, 0, xc, 8);
        { LAS unsigned* il = (LAS unsigned*)nb; il[lane] = idn0; il[64 + lane] = idn1; *(LAS u32x2*)(nb + 512 + 8 * lane) = xn; if (lane < 32) nb[1024 + lane] = sn; }
        UG_LOAD(8, 4, 2, idc); UG_COMP(0, 0, 2, xc, 8);
        UG_LOAD(0, 0, 0, (const LAS unsigned*)nb + (lane >> 3));
        UG_COMP(8, 4, 2, xc, 8);
#pragma unroll
        for (int T = 0; T < 8; ++T) asm volatile("" : "+v"(dacc[T]));
        if (r == 0) {
#pragma unroll
            for (int T = 0; T < 8; ++T) *(f32x4*)(pd + (size_t)t * 128 + 16 * T) = dacc[T]; }
        buf ^= 1;
    }
}
__device__ __forceinline__ unsigned fp4_code_scale(float v, float& back) {
    const unsigned rb = __float_as_uint(fabsf(v) * (1.0f / 6.0f));
    int e = (int)(rb >> 23) - 127 + ((rb & 0x7FFFFFu) != 0u ? 1 : 0); e = e < -120 ? -120 : (e > 120 ? 120 : e);
    const float inv = __uint_as_float((unsigned)(127 - e) << 23), sc = __uint_as_float((unsigned)(127 + e) << 23);
    const unsigned by = __builtin_amdgcn_cvt_scalef32_pk_fp4_f32(0u, v * inv, v * inv, 1.0f, 0);
    const f32x2 dd = FP4X2(by, 0); back = dd.x * sc;
    return (by & 0xFu) | ((unsigned)(e + 127) << 8);
}
__device__ __forceinline__ void p13b_act(const Frame& F, unsigned char* ws) {
    const float* pd = (const float*)(ws + WS_PD); float* gates = (float*)(ws + WS_GATES); const float* ssq2 = (const float*)(ws + WS_SSQ2); unsigned* act = (unsigned*)(ws + WS_ACT);
    const int* ids = (const int*)(ws + WS_IDS); const float* usc = (const float*)(ws + WS_USC); const float* vsc = (const float*)(ws + WS_VSC);
    const bool ok = fp4_probe_ok();
#pragma unroll 1
    for (int token = F.gw; token < M; token += F.NGW) {
        const float r2 = 1.0f / sqrtf(wave_sum(ssq2[(size_t)token * 64 + F.lane]) * (1.0f / D) + EPS);
#pragma unroll
        for (int hh = 0; hh < 2; ++hh) { const size_t o = (size_t)token * 128 + hh * 64 + F.lane; float d = 0.f;
#pragma unroll
            for (int jj = 0; jj < 8; ++jj) d += pd[(size_t)jj * M * 128 + o];
            const int id = ids[o];
            const float a = gelu_erf(d * r2 * usc[id]) * gates[o] * vsc[id];
            float b1; const unsigned t1 = fp4_code_scale(a, b1);
            act[o] = (t1 & 0xFu) * 0x11111111u;
            act[(size_t)M * 128 + o] = ok ? ((t1 >> 8) & 0xFFu) : 0xFFu; }
    }
}
__device__ __forceinline__ void p13c_down(const Frame& F, unsigned char* ws) {
    const int j = F.xj, lw = F.xrank * NWAVES + F.wave, nw = F.xn * NWAVES;
    int lane_ = F.lane; asm volatile("" : "+v"(lane_));
    const int lane = lane_, g = lane >> 4, i = lane & 15; const unsigned i16 = 16u * (unsigned)i, sidx = (unsigned)((i & 3) * 4 + (i >> 2)), l4 = 4u * (unsigned)lane;
    const unsigned sh = 4u * (unsigned)(i & 7), mlo = i < 8 ? (0xFu << sh) : 0u, mhi = i >= 8 ? (0xFu << sh) : 0u;
    i32x8 P1a = {0, 0, 0, 0, 0, 0, 0, 0}, P1b = P1a, Q1a = P1a, Q1b = P1a;
    const unsigned char* vvj = ws + WS_VB + (size_t)j * 16384 * 256; const unsigned char* vsj = ws + WS_VB + PEER_VAL_BYTES + (size_t)j * 16384 * 16;
    const unsigned char* ids = ws + WS_IDS; const unsigned char* av = ws + WS_ACT;
    const bf16_t* h2r = (const bf16_t*)(ws + WS_H2B) + 512 * j + 8 * lane; bf16_t* h3r = (bf16_t*)(ws + WS_H3B) + 512 * j + 8 * lane; float* ssq3 = (float*)(ws + WS_SSQ3);
    LAS unsigned* idl = (LAS unsigned*)(F.lds + F.wave * 6144);
    LAS float* yl = (LAS float*)(F.lds + F.wave * 6144 + 4096);
    LAS unsigned* al = idl + 256;
    constexpr size_t ASTR = (size_t)M * 128 * 4;
    int t = lw; if (t >= M) return;
    { const unsigned char* ip = ids + (size_t)t * 512; const unsigned char* ap = av + (size_t)t * 512;
      idl[lane] = *(const unsigned*)(ip + l4); idl[64 + lane] = *(const unsigned*)(ip + 256 + l4);
#pragma unroll
      for (int k = 0; k < 2; ++k) { al[256 * k + lane] = *(const unsigned*)(ap + k * ASTR + l4); al[256 * k + 64 + lane] = *(const unsigned*)(ap + k * ASTR + 256 + l4); } }
    PRow A[8], B[8];
    PW_LOAD(A, 0, idl + 32 * g, vvj, vsj);
    int buf = 0;
#pragma unroll 1
    for (; t < M; t += nw) {
        const int tn = (t + nw < M) ? t + nw : t;
        const LAS unsigned* cur = idl + buf * 128 + 32 * g; LAS unsigned* nxt = idl + (buf ^ 1) * 128;
        const LAS unsigned* acur = al + buf * 128 + 32 * g; LAS unsigned* anxt = al + (buf ^ 1) * 128;
        const unsigned char* ip = ids + (size_t)tn * 512; const unsigned char* ap = av + (size_t)tn * 512;
        const unsigned idn0 = *(const unsigned*)(ip + l4), idn1 = *(const unsigned*)(ip + 256 + l4);
        unsigned an[4];
#pragma unroll
        for (int k = 0; k < 2; ++k) { an[2 * k] = *(const unsigned*)(ap + k * ASTR + l4); an[2 * k + 1] = *(const unsigned*)(ap + k * ASTR + 256 + l4); }
        const u32x4 hq = *(const u32x4*)(h2r + (size_t)t * D);
        f32x4 y[4];
#pragma unroll
        for (int k = 0; k < 4; ++k) y[k] = (f32x4){0.f, 0.f, 0.f, 0.f};
        PW_LOAD(B, 8, cur, vvj, vsj); PD_COMP(A, 0, acur);
        PW_LOAD(A, 16, cur, vvj, vsj); PD_COMP(B, 8, acur);
        nxt[lane] = idn0; nxt[64 + lane] = idn1;
#pragma unroll
        for (int k = 0; k < 2; ++k) { anxt[256 * k + lane] = an[2 * k]; anxt[256 * k + 64 + lane] = an[2 * k + 1]; }
        PW_LOAD(B, 24, cur, vvj, vsj); PD_COMP(A, 16, acur);
        PW_LOAD(A, 0, nxt + 32 * g, vvj, vsj);
        PD_COMP(B, 24, acur);
        const f32x4 Y0 = y[0] + y[2], Y1 = y[1] + y[3];
#pragma unroll
        for (int rr = 0; rr < 4; ++rr) { yl[128 * g + 32 * rr + i] = Y0[rr]; yl[128 * g + 32 * rr + 16 + i] = Y1[rr]; }
        const f32x4 ya = *(const LAS f32x4*)(yl + 8 * lane), yb = *(const LAS f32x4*)(yl + 8 * lane + 4);
        const float h0 = BF_LO(hq.x) + ya[0], h1 = BF_HI(hq.x) + ya[1], h2 = BF_LO(hq.y) + ya[2], h3 = BF_HI(hq.y) + ya[3];
        const float h4 = BF_LO(hq.z) + yb[0], h5 = BF_HI(hq.z) + yb[1], h6 = BF_LO(hq.w) + yb[2], h7 = BF_HI(hq.w) + yb[3];
        { u32x4 wv; wv.x = cvt_pk_bf16(h0, h1); wv.y = cvt_pk_bf16(h2, h3); wv.z = cvt_pk_bf16(h4, h5); wv.w = cvt_pk_bf16(h6, h7); *(u32x4*)(h3r + (size_t)t * D) = wv; }
        const float ss = wave_sum(((h0 * h0 + h1 * h1) + (h2 * h2 + h3 * h3)) + ((h4 * h4 + h5 * h5) + (h6 * h6 + h7 * h7)));
        if (lane == 0) ssq3[(size_t)t * 8 + j] = ss;
        buf ^= 1;
    }
}
__device__ __forceinline__ void p13d_final(const Frame& F, unsigned char* ws, const float* g_final, float* out) {
    const bf16_t* h3b = (const bf16_t*)(ws + WS_H3B); const float* ssq3 = (const float*)(ws + WS_SSQ3);
#pragma unroll 1
    for (int token = F.gw; token < M; token += F.NGW) {
        int lane_ = F.lane; asm volatile("" : "+v"(lane_)); const int lane = lane_;
        const float rf = 1.0f / sqrtf(wave_sum(lane < 8 ? ssq3[(size_t)token * 8 + lane] : 0.f) * (1.0f / D) + EPS);
        u32x4 hv[8];
#pragma unroll
        for (int p = 0; p < 8; ++p) hv[p] = *(const u32x4*)(h3b + (size_t)token * D + p * 512 + lane * 8);
#pragma unroll
        for (int p = 0; p < 8; ++p) { const f32x4 g0 = *(const f32x4*)(g_final + p * 512 + lane * 8), g1 = *(const f32x4*)(g_final + p * 512 + lane * 8 + 4);
            float* op = out + (size_t)token * D + p * 512 + lane * 8;
            *(f32x4*)op = (f32x4){BF_LO(hv[p].x) * rf * g0[0], BF_HI(hv[p].x) * rf * g0[1], BF_LO(hv[p].y) * rf * g0[2], BF_HI(hv[p].y) * rf * g0[3]};
            *(f32x4*)(op + 4) = (f32x4){BF_LO(hv[p].z) * rf * g1[0], BF_HI(hv[p].z) * rf * g1[1], BF_LO(hv[p].w) * rf * g1[2], BF_HI(hv[p].w) * rf * g1[3]}; }
    }
}

__device__ __forceinline__ void final_norm_rows(const Frame& F, const float* h, const float* g, float* out) {
    for (int m = F.gw; m < M; m += F.NGW) {
        const f32x4* xr = (const f32x4*)(h + (size_t)m * D); const f32x4* gr = (const f32x4*)g; f32x4* xo = (f32x4*)(out + (size_t)m * D);
        f32x4 v[16]; float ss = 0.f;
#pragma unroll
        for (int j = 0; j < 16; ++j) v[j] = xr[F.lane + 64 * j];
#pragma unroll
        for (int j = 0; j < 16; ++j) ss += (v[j][0] * v[j][0] + v[j][1] * v[j][1]) + (v[j][2] * v[j][2] + v[j][3] * v[j][3]);
        ss = wave_sum(ss); const float r = 1.0f / sqrtf(ss * (1.0f / D) + EPS);
#pragma unroll
        for (int j = 0; j < 16; ++j) xo[F.lane + 64 * j] = v[j] * r * gr[F.lane + 64 * j];
    }
}

__global__ void __launch_bounds__(NTHREADS, 2) mega_fwd(Args args) {
    extern __shared__ __attribute__((aligned(16))) unsigned char lds_raw[];
    Frame F;
    F.lds = (LAS unsigned char*)lds_raw;
    F.tid = threadIdx.x; F.lane = F.tid & 63; F.wave = __builtin_amdgcn_readfirstlane(F.tid >> 6);
    F.G = gridDim.x; F.bid = blockIdx.x; F.gw = F.bid * NWAVES + F.wave; F.NGW = F.G * NWAVES;
    volatile LAS unsigned* MISC = (volatile LAS unsigned*)(F.lds + MISC_OFF);
    if (F.tid < 16) MISC[F.tid] = 0u;
    __syncthreads();
    XcdBarrier bar = xcd_barrier_post((unsigned*)(args.ws + WS_CTL), MISC + 8);
    const int lo = args.ph_lo, hi = args.ph_hi;
#define IN(k) (lo <= (k) && (k) < hi)
#define BOTH(k) (IN(k) && IN((k) + 1))
#define GRID_BAR() xcd_barrier(bar)

    unsigned char* ws = args.ws;
#define GEMM(KINDS, k) gemm_run<KINDS>(F.lds, args.in[0], args.out, ws, (k), F.G, F.bid)
    if (IN(0)) { p0_prologue(F, args); if (BOTH(0)) GRID_BAR(); }
    if (IN(1)) {
#pragma unroll 1
        for (int gi = 0; gi < 3; ++gi) GEMM(3, gi);
        if (BOTH(1)) GRID_BAR(); }
    if (IN(2)) { p2_stats(F, ws); p2_gla_prep(F, ws, args.in[11], args.in[12]); if (BOTH(2)) GRID_BAR(); }
    if (IN(3)) {
#pragma unroll 1
        for (int gi = 3; gi < 5; ++gi) GEMM(1, gi);
        p3_gla_att(F, ws);
        if (BOTH(3)) GRID_BAR(); }
    if (IN(4)) { p4_mla(F, ws);   }
    if (IN(5)) { p5_gla_scan(F, ws); if (BOTH(5)) GRID_BAR(); }
    if (IN(6)) { p6_mix(F, ws, args.in[10], args.in[13]); if (BOTH(6)) GRID_BAR(); }
    if (IN(7)) {
        GEMM(4, 5);
        if (BOTH(7)) GRID_BAR(); }
    if (IN(8)) {
        { pg8::StaticOrder S; S.init(M, 1024, F.G, F.bid); rstd_for_units(F, S, (const float*)(ws + WS_SSQ1), (float*)(ws + WS_RSTD1)); }
        GEMM(1, 6);
        if (BOTH(8)) GRID_BAR(); }
    if (IN(9)) { p9_xattn(F, ws); if (BOTH(9)) GRID_BAR(); }
    if (IN(10)) {
        GEMM(4, 7);
        if (BOTH(10)) GRID_BAR(); }
    if (IN(11)) {
        { pg8::StaticOrder S; S.init(M, 2048, F.G, F.bid); rstd_for_units(F, S, (const float*)(ws + WS_SSQ2), (float*)(ws + WS_RSTD2)); }
        GEMM(1, 8);
        p12c_quant(F, ws, args.in[20]);
        if (BOTH(11)) GRID_BAR(); }
    if (IN(12)) {
#pragma unroll 1
        for (int s = 0; s < 2; ++s) { if (((s ^ (F.wave >> 2)) & 1) != 0) peer_tables_to_fp4(F, ws, args.in[23], args.in[24]); else p12_topk(F, ws); }
        if (BOTH(12)) GRID_BAR(); }
    if (IN(13)) {
        { const unsigned nx = MISC[9], nloc = MISC[8], rk = MISC[10];
          const bool hw = (nx == 8u) && (bar.x < 8u) && (nloc > 0u) && (lo < 13);
          F.xj = hw ? (int)bar.x : (F.bid & 7); F.xrank = hw ? (int)rk : (F.bid >> 3); F.xn = hw ? (int)nloc : ((F.G - 1 - (F.bid & 7)) / 8 + 1); }
        p13a_up(F, ws); GRID_BAR(); p13b_act(F, ws); GRID_BAR(); p13c_down(F, ws); GRID_BAR(); p13d_final(F, ws, args.in[25], args.out);
    }
#undef GEMM
#undef IN
#undef BOTH
}

extern "C" void kernel_launch(void* const* d_in, const int* in_sizes, int n_in, void* d_out, int out_size, void* d_ws, size_t ws_size, hipStream_t stream) {
    static int grid = 0;
    if (grid == 0) {
        if (n_in != 26 || out_size != M * D || ws_size < WS_END0) { fprintf(stderr, "kernel_launch: unexpected problem (n_in %d out %d ws %zu need %zu)\n", n_in, out_size, ws_size, (size_t)WS_END0); grid = -1; return; }
        int dev = 0, cus = 0, per_cu = 0;
        if (hipGetDevice(&dev) != hipSuccess || hipDeviceGetAttribute(&cus, hipDeviceAttributeMultiprocessorCount, dev) != hipSuccess) { grid = -1; return; }
        if (hipFuncSetAttribute((const void*)mega_fwd, hipFuncAttributeMaxDynamicSharedMemorySize, LDS_BYTES) != hipSuccess) { fprintf(stderr, "kernel_launch: hipFuncSetAttribute failed\n"); grid = -1; return; }
        if (hipOccupancyMaxActiveBlocksPerMultiprocessor(&per_cu, (const void*)mega_fwd, NTHREADS, LDS_BYTES) != hipSuccess || per_cu < 1) { fprintf(stderr, "kernel_launch: occupancy query says %d\n", per_cu); }
        (void)hipGetLastError();
        grid = cus;
    }
    if (grid < 0) return;
    (void)hipMemsetAsync((char*)d_ws + WS_CTL, 0, CTL_BYTES, stream);
    Args a{};
    for (int i = 0; i < 26; ++i) a.in[i] = (const float*)d_in[i];
    a.out = (float*)d_out; a.ws = (unsigned char*)d_ws; a.ph_lo = 0; a.ph_hi = 14;
    hipLaunchKernelGGL(mega_fwd, dim3(grid), dim3(NTHREADS), LDS_BYTES, stream, a);
}
```

```cpp
#include <hip/hip_runtime.h>
#include <cstdio>
#include <cstdint>

#define LAS __attribute__((address_space(3)))
typedef unsigned short bf16_t;
typedef short bf16x8 __attribute__((ext_vector_type(8)));
typedef short s16x4 __attribute__((ext_vector_type(4)));
typedef float f32x4 __attribute__((ext_vector_type(4)));
typedef float f32x16 __attribute__((ext_vector_type(16)));
typedef unsigned u32x4 __attribute__((ext_vector_type(4)));
typedef unsigned u32x2 __attribute__((ext_vector_type(2)));

constexpr int D = 4096, NB = 2, SEQ = 8192, M = NB * SEQ;
constexpr float EPS = 1e-6f;
constexpr int MEMT = 256, MROWS = NB * MEMT;
constexpr int IN_W = 7760, IN_WP = 7936;
constexpr int NWAVES = 8, NTHREADS = 512;

constexpr size_t al256(size_t x) { return (x + 255) & ~(size_t)255; }
constexpr size_t WS_CTL = 0, CTL_BYTES = 65536;
constexpr size_t WS_WIN = WS_CTL + CTL_BYTES;
constexpr size_t WS_WUQ = WS_WIN + (size_t)IN_WP * D * 2;
constexpr size_t WS_WUKV = WS_WUQ + (size_t)3072 * 1024 * 2;
constexpr size_t WS_WOUT = WS_WUKV + (size_t)4096 * 512 * 2;
constexpr size_t WS_WCQ = WS_WOUT + (size_t)D * D * 2;
constexpr size_t WS_WCK = WS_WCQ + (size_t)1024 * D * 2;
constexpr size_t WS_WCV = WS_WCK + (size_t)1024 * D * 2;
constexpr size_t WS_WCO = WS_WCV + (size_t)1024 * D * 2;
constexpr size_t WS_WPQ = WS_WCO + (size_t)D * 1024 * 2;
constexpr size_t WS_KEYS = WS_WPQ + (size_t)2048 * D * 2;
constexpr size_t WS_MN = WS_KEYS + (size_t)8 * 2 * 128 * 128 * 2;
constexpr size_t WS_KC = WS_MN + (size_t)MROWS * D * 2;
constexpr size_t WS_VC = WS_KC + (size_t)MROWS * 1024 * 2;
constexpr size_t WS_ROPE = WS_VC + (size_t)MROWS * 1024 * 2;
constexpr size_t WS_RSTDX = WS_ROPE + (size_t)M * 32 * 4 * 2;
constexpr size_t WS_RSTDQ = WS_RSTDX + (size_t)M * 4;
constexpr size_t WS_RSTDKV = WS_RSTDQ + (size_t)M * 4;
constexpr size_t WS_SSQ1 = WS_RSTDKV + (size_t)M * 4;
constexpr size_t WS_SSQ2 = WS_SSQ1 + (size_t)M * 64 * 4;
constexpr size_t WS_XB = WS_SSQ2 + (size_t)M * 64 * 4;
constexpr size_t WS_CQ = WS_XB + (size_t)M * D * 2;
constexpr size_t WS_CKV = WS_CQ + (size_t)M * 1024 * 2;
constexpr size_t WS_GQ = WS_CKV + (size_t)M * 512 * 2;
constexpr size_t WS_GK = WS_GQ + (size_t)M * 1024 * 2;
constexpr size_t WS_GV = WS_GK + (size_t)M * 1024 * 2;
constexpr size_t WS_GOG = WS_GV + (size_t)M * 2048 * 2;
constexpr size_t WS_SM = WS_GOG + (size_t)M * 2048 * 2;
constexpr size_t WS_Q = WS_SM + (size_t)M * 256 * 2;
constexpr size_t WS_KV = WS_Q + (size_t)M * 3072 * 2;
constexpr size_t WS_KROPE = WS_KV + (size_t)M * 4096 * 2;
constexpr size_t WS_OMLA = WS_KROPE + (size_t)M * 64 * 2;
constexpr size_t WS_OGLA = WS_OMLA + (size_t)M * 2048 * 2;
constexpr size_t WS_QEP = WS_OGLA + (size_t)M * 2048 * 2;
constexpr size_t WS_KEP = WS_QEP + (size_t)M * 1024 * 2;
constexpr size_t WS_KDT = WS_KEP + (size_t)M * 1024 * 2;
constexpr size_t WS_ATT = WS_KDT + (size_t)M * 1024 * 2;
constexpr size_t WS_DEC = WS_ATT + (size_t)1024 * 64 * 64 * 2;
constexpr size_t WS_RSTD1 = WS_DEC + (size_t)1024 * 256 * 4;
constexpr size_t WS_RSTD2 = WS_RSTD1 + (size_t)M * 4;
constexpr size_t WS_END0 = WS_RSTD2 + (size_t)M * 4;
constexpr size_t WS_QC = WS_Q;
constexpr size_t WS_OC = WS_Q + (size_t)M * 1024 * 2;
constexpr size_t WS_H1B = WS_KV;
constexpr size_t WS_H2B = WS_XB;
constexpr size_t WS_QP = WS_Q;
constexpr int PEER_ROW_BYTES = 2176;
constexpr size_t PEER_VAL_BYTES = (size_t)8 * 16384 * 256;
constexpr size_t WS_PD = WS_Q;
constexpr size_t WS_ACT = WS_OGLA;
constexpr size_t WS_H3B = WS_KV;
constexpr size_t WS_XQ = WS_KV;
constexpr size_t WS_XQS = WS_XQ + (size_t)M * D;
constexpr size_t WS_SSQ3 = WS_SSQ1;
constexpr size_t WS_UB = WS_CQ;
constexpr size_t WS_VB = WS_UB + (size_t)16384 * PEER_ROW_BYTES;
constexpr size_t WS_USC = WS_VB + (size_t)16384 * PEER_ROW_BYTES;
constexpr size_t WS_VSC = WS_USC + (size_t)16384 * 4;
constexpr size_t WS_IDS = WS_VSC + (size_t)16384 * 4;
constexpr size_t WS_GATES = WS_IDS + (size_t)M * 128 * 4;
static_assert(WS_GATES + (size_t)M * 128 * 4 <= WS_Q, "peer scratch overlaps q_p");

__device__ __forceinline__ unsigned cvt_pk_bf16(float lo, float hi) { unsigned r; asm volatile("v_cvt_pk_bf16_f32 %0, %1, %2" : "=v"(r) : "v"(lo), "v"(hi)); return r; }
__device__ __forceinline__ float bf2f(unsigned short b) { return __uint_as_float(((unsigned)b) << 16); }
#define DPP_ADD(v, ctrl, rmask) (v) += __int_as_float(__builtin_amdgcn_update_dpp(0, __float_as_int(v), (ctrl), (rmask), 0xF, false))
__device__ __forceinline__ float wave_sum(float v) {
    DPP_ADD(v, 0xB1, 0xF); DPP_ADD(v, 0x4E, 0xF); DPP_ADD(v, 0x141, 0xF); DPP_ADD(v, 0x140, 0xF);
    DPP_ADD(v, 0x142, 0xA); DPP_ADD(v, 0x143, 0xC);
    return __int_as_float(__builtin_amdgcn_readlane(__float_as_int(v), 63));
}
#define LDS_WAIT() asm volatile("s_waitcnt lgkmcnt(0)" ::: "memory")
__device__ __forceinline__ bf16x8 pack8(f32x4 a, f32x4 b) {
    u32x4 w = {cvt_pk_bf16(a[0], a[1]), cvt_pk_bf16(a[2], a[3]), cvt_pk_bf16(b[0], b[1]), cvt_pk_bf16(b[2], b[3])};
    return *reinterpret_cast<bf16x8*>(&w);
}

#define XB_TMO      128
#define XB_XCNT(j)  (256  + 64 * (j))
#define XB_XSUB(j)  (1280 + 64 * (j))
#define XB_XGEN(j)  (2304 + 64 * (j))
#define XB_TOP      3328
#define XB_TOPGEN   3392
#define XCD_BAR_WORDS 3456
#define XB_SPIN_CAP (1u << 22)

__device__ __forceinline__ unsigned xb_ld(unsigned* p)              { return __hip_atomic_load(p, __ATOMIC_RELAXED, __HIP_MEMORY_SCOPE_AGENT); }
__device__ __forceinline__ unsigned xb_add(unsigned* p, unsigned v) { return __hip_atomic_fetch_add(p, v, __ATOMIC_RELAXED, __HIP_MEMORY_SCOPE_AGENT); }
__device__ __forceinline__ unsigned xb_xcc_id() { return (unsigned)__builtin_amdgcn_s_getreg((3 << 11) | 20) & 0xFu; }
#define XB_SPIN(cond, bar) do { unsigned _sp = 0; while (cond) { __builtin_amdgcn_s_sleep(1); \
    if ((++_sp & 255u) == 0u) { if (xb_ld(&(bar)[XB_TMO])) break; if (_sp > XB_SPIN_CAP) { atomicAdd(&(bar)[XB_TMO], 1u); break; } } } } while (0)

struct XcdBarrier { unsigned* bar; unsigned x; volatile LAS unsigned* st; };

__device__ __forceinline__ XcdBarrier xcd_barrier_post(unsigned* bar, volatile LAS unsigned* st) {
    XcdBarrier b; b.bar = bar; b.x = xb_xcc_id(); b.st = st;
    if (threadIdx.x == 0) st[2] = xb_add(&bar[XB_XCNT(b.x)], 1u);
    return b;
}
__device__ __forceinline__ void xcd_barrier_complete(unsigned* bar, unsigned x, unsigned& nloc, unsigned& nx) {
    const unsigned G = gridDim.x * gridDim.y * gridDim.z;
    unsigned sum, cnt, mine, sp = 0u;
    for (;;) {
        sum = 0u; cnt = 0u; mine = 0u;
#pragma unroll
        for (unsigned j = 0; j < 16; ++j) { const unsigned c = xb_ld(&bar[XB_XCNT(j)]); sum += c; cnt += (c > 0u) ? 1u : 0u; mine = (j == x) ? c : mine; }
        if (sum == G) break;
        __builtin_amdgcn_s_sleep(1);
        if ((++sp & 255u) == 0u) { if (xb_ld(&bar[XB_TMO])) break; if (sp > XB_SPIN_CAP) { atomicAdd(&bar[XB_TMO], 1u); break; } }
    }
    nloc = mine > 0u ? mine : 1u; nx = cnt > 0u ? cnt : 1u;
}
__device__ __forceinline__ void xcd_barrier(const XcdBarrier& b) {
    asm volatile("s_waitcnt vmcnt(0)" ::: "memory");
    __syncthreads();
    if (threadIdx.x == 0) {
        unsigned* bar = b.bar;
        __builtin_amdgcn_s_waitcnt(0);
        unsigned nloc = b.st[0], nx = b.st[1];
        if (nloc == 0u) { xcd_barrier_complete(bar, b.x, nloc, nx); b.st[0] = nloc; b.st[1] = nx; }
        const unsigned old = xb_add(&bar[XB_XSUB(b.x)], 1u);
        const unsigned gen = old / nloc;
        if (old + 1u == (gen + 1u) * nloc) {
            __builtin_amdgcn_fence(__ATOMIC_RELEASE, "agent");
            asm volatile("s_waitcnt vmcnt(0)" ::: "memory");
            const unsigned og = xb_add(&bar[XB_TOP], 1u);
            const unsigned tg = og / nx;
            if (og + 1u == (tg + 1u) * nx) xb_add(&bar[XB_TOPGEN], 1u);
            else XB_SPIN(xb_ld(&bar[XB_TOPGEN]) == tg, bar);
            __builtin_amdgcn_fence(__ATOMIC_ACQUIRE, "agent");
            xb_add(&bar[XB_XGEN(b.x)], 1u);
            asm volatile("s_waitcnt vmcnt(0)" ::: "memory");
        } else {
            XB_SPIN(xb_ld(&bar[XB_XGEN(b.x)]) == gen, bar);
            __builtin_amdgcn_fence(__ATOMIC_ACQUIRE, "agent");
            asm volatile("s_waitcnt vmcnt(0)" ::: "memory");
        }
    }
    __syncthreads();
}


namespace pg8 {
constexpr int BM = 256, BK = 64, HALF = 128, HTB = HALF * BK * 2, NXCD = 8, WGM = 8;
__host__ __device__ __forceinline__ int lds_byte(int r, int c) { const int st = (r >> 4) * 2 + (c >> 5), rr = r & 15, cc = c & 31, ob = rr * 64 + cc * 2; return st * 1024 + (ob ^ (((ob >> 9) & 1) << 5)); }
__host__ __device__ __forceinline__ void stage_rc(int b, int& R, int& C) { const int st = b / 1024, sb = b % 1024, swz = sb ^ (((sb >> 9) & 1) << 5); R = (st >> 1) * 16 + swz / 64; C = (st & 1) * 32 + (swz % 64) / 2; }
__host__ __device__ __forceinline__ int perm32(int rho) { const int n = rho >> 4, i = rho & 15; return 8 * (i >> 2) + 4 * n + (i & 3); }
struct Unit { int pm, pn; };
struct Gemm { const bf16_t* A; const bf16_t* Bt; int M, N, K, lda, ldb; };
struct StaticOrder {
    int nM, nN, nwg, G, c;
    __host__ __device__ void init(int M_, int N_, int G_, int c_) { nM = M_ / BM; nN = N_ / BM; nwg = nM * nN; G = G_; c = c_; }
    __host__ __device__ bool next(int i, Unit& u) const {
        const long L = (long)i * G + c; if (L >= nwg) return false;
        int wgid = (int)L; { const int q = nwg / NXCD, r = nwg % NXCD, xcd = wgid % NXCD, off = wgid / NXCD; wgid = (xcd < r ? xcd * (q + 1) : r * (q + 1) + (xcd - r) * q) + off; }
        const int nig = WGM * nN, gid = wgid / nig, fm = gid * WGM, gsz = (nM - fm) < WGM ? (nM - fm) : WGM;
        u.pm = fm + ((wgid % nig) % gsz); u.pn = (wgid % nig) / gsz; return true;
    }
};
template <class Epi>
__device__ __forceinline__ void gemm_phase(LAS unsigned char* lds, const Gemm g, const StaticOrder& S, const Epi& E, const bool perm) {
    int tid_ = threadIdx.x; asm volatile("" : "+v"(tid_));
    const int tid = tid_, wid = __builtin_amdgcn_readfirstlane(tid >> 6), lane = tid & 63, wr = wid >> 2, wc = wid & 3, fr = lane & 15, fq = lane >> 4;
    const int K = g.K, nt = K / BK;
    unsigned voffA[2], voffB[2];
#pragma unroll
    for (int i = 0; i < 2; ++i) { int R, C; stage_rc(tid * 16 + i * 8192, R, C); const int Rb = perm ? ((R & ~31) + perm32(R & 31)) : R;
        voffA[i] = (unsigned)(R * g.lda + C) * 2u; voffB[i] = (unsigned)(Rb * g.ldb + C) * 2u; }
    const size_t kstep = (size_t)(BK * 2);
    const size_t hstepA = (size_t)HALF * g.lda * 2, hstepB = (size_t)HALF * g.ldb * 2;
    const size_t tstepA = 2 * hstepA, tstepB = 2 * hstepB;
    const unsigned ldsw = (unsigned)wid * 1024u;
    const int aoff = lds_byte(wr * 64 + fr, fq * 8), boff = lds_byte(wc * 32 + fr, fq * 8);
#define PG8_SA(b, h) (((b) * 2 + (h)) * HTB)
#define PG8_SB(b, h) ((4 + (b) * 2 + (h)) * HTB)
#define PG8_STAGE(bufoff, gbase, voff) do { _Pragma("unroll") for (int _i = 0; _i < 2; ++_i) \
        __builtin_amdgcn_global_load_lds((const unsigned*)((const char*)(gbase) + (voff)[_i]), (LAS unsigned*)(lds + (bufoff) + ldsw + _i * 8192), 16, 0, 0); } while (0)
#define PG8_LDA(dst, b, h) do { _Pragma("unroll") for (int m = 0; m < 4; ++m) _Pragma("unroll") for (int k = 0; k < 2; ++k) dst[m][k] = *(const LAS bf16x8*)(lds + PG8_SA(b, h) + aoff + m * 2048 + k * 1024); } while (0)
#define PG8_LDB(dst, b, h) do { _Pragma("unroll") for (int n = 0; n < 2; ++n) _Pragma("unroll") for (int k = 0; k < 2; ++k) dst[n][k] = *(const LAS bf16x8*)(lds + PG8_SB(b, h) + boff + n * 2048 + k * 1024); } while (0)
#define PG8_MMA(ai, bj, At, Bt) do { __builtin_amdgcn_s_setprio(1); _Pragma("unroll") for (int m = 0; m < 4; ++m) _Pragma("unroll") for (int n = 0; n < 2; ++n) _Pragma("unroll") for (int k = 0; k < 2; ++k) \
        acc[ai][bj][m][n] = __builtin_amdgcn_mfma_f32_16x16x32_bf16(Bt[n][k], At[m][k], acc[ai][bj][m][n], 0, 0, 0); __builtin_amdgcn_s_setprio(0); } while (0)
#define PG8_WAIT_V(n) asm volatile("s_waitcnt vmcnt(" #n ")" ::: "memory")
#define PG8_WAIT_L(n) asm volatile("s_waitcnt lgkmcnt(" #n ")" ::: "memory")
#define PG8_BAR __builtin_amdgcn_s_barrier()
#define PG8_SCHED __builtin_amdgcn_sched_barrier(0)
    Unit cur, nxt; int ui = 0;
    if (!S.next(0, cur)) return;
    f32x4 acc[2][2][4][2];
#pragma unroll
    for (int a = 0; a < 2; ++a)
#pragma unroll
        for (int b = 0; b < 2; ++b)
#pragma unroll
            for (int m = 0; m < 4; ++m)
#pragma unroll
                for (int n = 0; n < 2; ++n) acc[a][b][m][n] = (f32x4){0.f, 0.f, 0.f, 0.f};
    bf16x8 At[4][2], B0[2][2], B1[2][2];
    const char* cA = (const char*)g.A + (size_t)cur.pm * tstepA; const char* cB = (const char*)g.Bt + (size_t)cur.pn * tstepB;
    PG8_STAGE(PG8_SB(0, 0), cB, voffB); PG8_STAGE(PG8_SA(0, 0), cA, voffA); PG8_STAGE(PG8_SB(0, 1), cB + hstepB, voffB); PG8_STAGE(PG8_SA(0, 1), cA + hstepA, voffA);
    if (wr == 1) PG8_BAR;
    PG8_WAIT_V(4); PG8_BAR;
    PG8_STAGE(PG8_SB(1, 0), cB + kstep, voffB); PG8_STAGE(PG8_SA(1, 0), cA + kstep, voffA); PG8_STAGE(PG8_SB(1, 1), cB + hstepB + kstep, voffB);
    PG8_WAIT_V(6); PG8_BAR;
    for (;;) {
        const bool has_next = S.next(ui + 1, nxt);
        const char* nA = has_next ? (const char*)g.A + (size_t)nxt.pm * tstepA : cA; const char* nB = has_next ? (const char*)g.Bt + (size_t)nxt.pn * tstepB : cB;
        for (int t = 0; t < nt; t += 2) {
            const bool last = (t == nt - 2);
            const char* a1 = cA + (size_t)(t + 1) * kstep;
            const char* a2 = last ? nA : cA + (size_t)(t + 2) * kstep; const char* b2 = last ? nB : cB + (size_t)(t + 2) * kstep;
            const char* a3 = a2 + kstep; const char* b3 = b2 + kstep;
            PG8_LDB(B0, 0, 0); PG8_SCHED; PG8_LDA(At, 0, 0); PG8_STAGE(PG8_SA(1, 1), a1 + hstepA, voffA);
            PG8_WAIT_L(8); PG8_BAR; PG8_WAIT_L(0); PG8_MMA(0, 0, At, B0); PG8_BAR; PG8_SCHED;
            PG8_LDB(B1, 0, 1); PG8_STAGE(PG8_SB(0, 0), b2, voffB);
            PG8_BAR; PG8_WAIT_L(0); PG8_MMA(0, 1, At, B1); PG8_BAR;
            PG8_LDA(At, 0, 1); PG8_STAGE(PG8_SA(0, 0), a2, voffA);
            PG8_BAR; PG8_WAIT_L(0); PG8_MMA(1, 0, At, B0); PG8_BAR; PG8_SCHED;
            PG8_STAGE(PG8_SB(0, 1), b2 + hstepB, voffB);
            PG8_WAIT_V(6); PG8_BAR; PG8_MMA(1, 1, At, B1); PG8_BAR;
            PG8_LDB(B0, 1, 0); PG8_SCHED; PG8_LDA(At, 1, 0); PG8_STAGE(PG8_SA(0, 1), a2 + hstepA, voffA);
            PG8_WAIT_L(8); PG8_BAR; PG8_WAIT_L(0); PG8_MMA(0, 0, At, B0); PG8_BAR; PG8_SCHED;
            PG8_LDB(B1, 1, 1); PG8_STAGE(PG8_SB(1, 0), b3, voffB);
            PG8_BAR; PG8_WAIT_L(0); PG8_MMA(0, 1, At, B1); PG8_BAR;
            PG8_LDA(At, 1, 1); PG8_STAGE(PG8_SA(1, 0), a3, voffA);
            PG8_BAR; PG8_WAIT_L(0); PG8_MMA(1, 0, At, B0); PG8_BAR; PG8_SCHED;
            PG8_STAGE(PG8_SB(1, 1), b3 + hstepB, voffB);
            PG8_WAIT_V(6); PG8_BAR; PG8_MMA(1, 1, At, B1); PG8_BAR;
        }
        E(acc, cur, wr, wc, fr, fq);
        if (!has_next) break;
#pragma unroll
        for (int a = 0; a < 2; ++a)
#pragma unroll
            for (int b = 0; b < 2; ++b)
#pragma unroll
                for (int m = 0; m < 4; ++m)
#pragma unroll
                    for (int n = 0; n < 2; ++n) acc[a][b][m][n] = (f32x4){0.f, 0.f, 0.f, 0.f};
        cur = nxt; cA = nA; cB = nB; ++ui;
    }
    PG8_WAIT_V(0);
    if (wr == 0) PG8_BAR;
    PG8_BAR;
#undef PG8_SA
#undef PG8_SB
#undef PG8_STAGE
#undef PG8_LDA
#undef PG8_LDB
#undef PG8_MMA
#undef PG8_WAIT_V
#undef PG8_WAIT_L
#undef PG8_BAR
#undef PG8_SCHED
}

struct EpiRowScaleBf16 {
    static constexpr bool PERM = true;
    const float* rs; bf16_t* base; int ldc;
    __device__ __forceinline__ void store(const f32x4 (&acc)[2][2][4][2], bf16_t* __restrict__ dst, int ld, int ctile, const Unit& u, int wr, int wc, int fr, int fq) const {
        const int row0 = u.pm * BM + wr * 64 + fr, col0 = ctile * BM + wc * 32 + 8 * fq;
        float sv[2][4];
        const float* __restrict__ rsp = rs;
#pragma unroll
        for (int ai = 0; ai < 2; ++ai)
#pragma unroll
            for (int m = 0; m < 4; ++m) sv[ai][m] = rsp ? rsp[row0 + ai * HALF + m * 16] : 1.0f;
#pragma unroll
        for (int ai = 0; ai < 2; ++ai)
#pragma unroll
            for (int m = 0; m < 4; ++m) { const int row = row0 + ai * HALF + m * 16; const float s = sv[ai][m]; bf16_t* rowp = dst + (size_t)row * ld + col0;
#pragma unroll
                for (int bj = 0; bj < 2; ++bj) { const f32x4 v0 = acc[ai][bj][m][0] * s, v1 = acc[ai][bj][m][1] * s;
                    u32x4 w; w.x = cvt_pk_bf16(v0[0], v0[1]); w.y = cvt_pk_bf16(v0[2], v0[3]); w.z = cvt_pk_bf16(v1[0], v1[1]); w.w = cvt_pk_bf16(v1[2], v1[3]);
                    *(u32x4*)(rowp + bj * HALF) = w; } }
    }
    __device__ __forceinline__ void operator()(const f32x4 (&acc)[2][2][4][2], const Unit& u, int wr, int wc, int fr, int fq) const { store(acc, base, ldc, u.pn, u, wr, wc, fr, fq); }
};
struct EpiInProj : EpiRowScaleBf16 {
    unsigned char* ws;
    __device__ __forceinline__ void operator()(const f32x4 (&acc)[2][2][4][2], const Unit& u, int wr, int wc, int fr, int fq) const {
        const int pn = u.pn; size_t off; int ld, t0;
        if (pn < 4) { off = WS_CQ; ld = 1024; t0 = 0; } else if (pn < 6) { off = WS_CKV; ld = 512; t0 = 4; } else if (pn < 10) { off = WS_GQ; ld = 1024; t0 = 6; }
        else if (pn < 14) { off = WS_GK; ld = 1024; t0 = 10; } else if (pn < 22) { off = WS_GV; ld = 2048; t0 = 14; } else if (pn < 30) { off = WS_GOG; ld = 2048; t0 = 22; }
        else { off = WS_SM; ld = 256; t0 = 30; }
        store(acc, (bf16_t*)(ws + off), ld, pn - t0, u, wr, wc, fr, fq);
    }
};
struct EpiResidual {
    static constexpr bool PERM = true;
    const float* basef; const bf16_t* baseb; bf16_t* hb; float* ssq; int ldc; int nslots;
    __device__ __forceinline__ void operator()(const f32x4 (&acc)[2][2][4][2], const Unit& u, int wr, int wc, int fr, int fq) const {
        const int row0 = u.pm * BM + wr * 64 + fr, col0 = u.pn * BM + wc * 32 + 8 * fq;
        const float* __restrict__ bf = basef; const bf16_t* __restrict__ bb = baseb; bf16_t* __restrict__ ho = hb;
        if (bf) {
#pragma unroll
            for (int ai = 0; ai < 2; ++ai)
#pragma unroll
                for (int mp = 0; mp < 2; ++mp) {
                    f32x4 bs[2][2][2];
#pragma unroll
                    for (int mm = 0; mm < 2; ++mm) { const size_t off = (size_t)(row0 + ai * HALF + (2 * mp + mm) * 16) * ldc + col0;
#pragma unroll
                        for (int bj = 0; bj < 2; ++bj)
#pragma unroll
                            for (int n = 0; n < 2; ++n) bs[mm][bj][n] = *(const f32x4*)(bf + off + bj * HALF + n * 4); }
#pragma unroll
                    for (int mm = 0; mm < 2; ++mm) { const int m = 2 * mp + mm; const int row = row0 + ai * HALF + m * 16; const size_t off = (size_t)row * ldc + col0; float ss = 0.f;
#pragma unroll
                        for (int bj = 0; bj < 2; ++bj) { const f32x4 h0 = bs[mm][bj][0] + acc[ai][bj][m][0], h1 = bs[mm][bj][1] + acc[ai][bj][m][1];
                            u32x4 w; w.x = cvt_pk_bf16(h0[0], h0[1]); w.y = cvt_pk_bf16(h0[2], h0[3]); w.z = cvt_pk_bf16(h1[0], h1[1]); w.w = cvt_pk_bf16(h1[2], h1[3]);
                            *(u32x4*)(ho + off + bj * HALF) = w;
                            ss += ((h0[0] * h0[0] + h0[1] * h0[1]) + (h0[2] * h0[2] + h0[3] * h0[3])) + ((h1[0] * h1[0] + h1[1] * h1[1]) + (h1[2] * h1[2] + h1[3] * h1[3])); }
                        ss += __shfl_xor(ss, 16); ss += __shfl_xor(ss, 32);
                        if (fq == 0) ssq[(size_t)row * nslots + u.pn * 4 + wc] = ss; }
                }
        } else {
#pragma unroll
            for (int ai = 0; ai < 2; ++ai) {
                u32x4 bs[4][2];
#pragma unroll
                for (int m = 0; m < 4; ++m) { const size_t off = (size_t)(row0 + ai * HALF + m * 16) * ldc + col0;
#pragma unroll
                    for (int bj = 0; bj < 2; ++bj) bs[m][bj] = *(const u32x4*)(bb + off + bj * HALF); }
#pragma unroll
                for (int m = 0; m < 4; ++m) { const int row = row0 + ai * HALF + m * 16; const size_t off = (size_t)row * ldc + col0; float ss = 0.f;
#pragma unroll
                    for (int bj = 0; bj < 2; ++bj) { const u32x4 q = bs[m][bj];
                        const f32x4 h0 = (f32x4){__uint_as_float(q.x << 16), __uint_as_float(q.x & 0xffff0000u), __uint_as_float(q.y << 16), __uint_as_float(q.y & 0xffff0000u)} + acc[ai][bj][m][0];
                        const f32x4 h1 = (f32x4){__uint_as_float(q.z << 16), __uint_as_float(q.z & 0xffff0000u), __uint_as_float(q.w << 16), __uint_as_float(q.w & 0xffff0000u)} + acc[ai][bj][m][1];
                        u32x4 w; w.x = cvt_pk_bf16(h0[0], h0[1]); w.y = cvt_pk_bf16(h0[2], h0[3]); w.z = cvt_pk_bf16(h1[0], h1[1]); w.w = cvt_pk_bf16(h1[2], h1[3]);
                        *(u32x4*)(ho + off + bj * HALF) = w;
                        ss += ((h0[0] * h0[0] + h0[1] * h0[1]) + (h0[2] * h0[2] + h0[3] * h0[3])) + ((h1[0] * h1[0] + h1[1] * h1[1]) + (h1[2] * h1[2] + h1[3] * h1[3])); }
                    ss += __shfl_xor(ss, 16); ss += __shfl_xor(ss, 32);
                    if (fq == 0) ssq[(size_t)row * nslots + u.pn * 4 + wc] = ss; }
            }
        }
    }
};
}


struct GemmDesc { unsigned long long a_off, b_off, d_off, rs_off, ssq_off; int M, N, K, lda, ldb, ldc, kind, base_is_x, crot; };
constexpr unsigned long long NO_OFF = ~0ull;
__device__ __constant__ GemmDesc g_gemm[9] = {
      {WS_XB,  WS_WIN,  0,      WS_RSTDX,  NO_OFF,  M,     IN_WP, D,    D,    D,    0,    1, 0, 0},
      {WS_MN,  WS_WCK,  WS_KC,  NO_OFF,    NO_OFF,  MROWS, 1024,  D,    D,    D,    1024, 0, 0, 64},
      {WS_MN,  WS_WCV,  WS_VC,  NO_OFF,    NO_OFF,  MROWS, 1024,  D,    D,    D,    1024, 0, 0, 56},
      {WS_CQ,  WS_WUQ,  WS_Q,   WS_RSTDQ,  NO_OFF,  M,     3072,  1024, 1024, 1024, 3072, 0, 0, 0},
      {WS_CKV, WS_WUKV, WS_KV,  WS_RSTDKV, NO_OFF,  M,     4096,  512,  512,  512,  4096, 0, 0, 0},
      {WS_XB,  WS_WOUT, WS_H1B, NO_OFF,    WS_SSQ1, M,     D,     D,    D,    D,    D,    2, 1, 0},
      {WS_H1B, WS_WCQ,  WS_QC,  WS_RSTD1,  NO_OFF,  M,     1024,  D,    D,    D,    1024, 0, 0, 0},
      {WS_OC,  WS_WCO,  WS_H2B, NO_OFF,    WS_SSQ2, M,     D,     1024, 1024, 1024, D,    2, 0, 0},
      {WS_H2B, WS_WPQ,  WS_QP,  WS_RSTD2,  NO_OFF,  M,     2048,  D,    D,    D,    2048, 0, 0, 0},
};
template <int KINDS>
struct EpiGeneric {
    int kind; pg8::EpiInProj ein; pg8::EpiResidual eres;
    __device__ __forceinline__ void operator()(const f32x4 (&acc)[2][2][4][2], const pg8::Unit& u, int wr, int wc, int fr, int fq) const {
        if ((KINDS & 4) && (kind == 2 || KINDS == 4)) eres(acc, u, wr, wc, fr, fq);
        else if ((KINDS & 2) && (kind == 1 || KINDS == 2)) ein(acc, u, wr, wc, fr, fq);
        else if (KINDS & 1) ein.pg8::EpiRowScaleBf16::operator()(acc, u, wr, wc, fr, fq);
    }
};
template <int KINDS>
__device__ __forceinline__ void gemm_run(LAS unsigned char* lds, const float* x_in, float* out, unsigned char* ws, int idx, int G, int bid) {
    const GemmDesc d = g_gemm[idx];
    pg8::Gemm g{(const bf16_t*)(ws + d.a_off), (const bf16_t*)(ws + d.b_off), d.M, d.N, d.K, d.lda, d.ldb};
    pg8::StaticOrder S; S.init(d.M, d.N, G, (bid + d.crot) % G);
    EpiGeneric<KINDS> E{};
    E.kind = d.kind;
    E.ein.rs = d.rs_off == NO_OFF ? nullptr : (const float*)(ws + d.rs_off); E.ein.base = (bf16_t*)(ws + d.d_off); E.ein.ldc = d.ldc; E.ein.ws = ws;
    E.eres.basef = d.base_is_x ? x_in : nullptr; E.eres.baseb = (const bf16_t*)(ws + WS_H1B); E.eres.hb = (bf16_t*)(ws + d.d_off); E.eres.ssq = (float*)(ws + (d.ssq_off == NO_OFF ? 0ull : d.ssq_off)); E.eres.ldc = d.ldc; E.eres.nslots = 64;
    pg8::gemm_phase(lds, g, S, E, true);
}

namespace att {
constexpr int KVBLK = 64;
constexpr float THR = 8.f;
#define SBAR() __builtin_amdgcn_sched_barrier(0)
__device__ __forceinline__ int v_st(int k, int c) { const int kk = (k & ~0xC) | ((k & 4) << 1) | ((k & 8) >> 1); return ((kk >> 3) * 4 + (c >> 5)) * 512 + ((kk & 7) * 32 + (c & 31)) * 2; }
__device__ __forceinline__ int v_rd_base(int lane) { return ((lane & 3) << 3) | (((lane >> 2) & 3) << 6) | (((lane >> 4) & 1) << 5) | (((lane >> 5) & 1) << 8); }
constexpr int v_rd_off(int d0, int ks, int half) { return d0 * 512 + ks * 4096 + half * 2048; }
__device__ __forceinline__ int crow(int r, int hi) { return (r & 3) + 8 * (r >> 2) + 4 * hi; }
__device__ __forceinline__ void mask_tile(f32x16& p0, f32x16& p1, int dq, unsigned W) {
    const float NEG = -__builtin_inff();
#pragma unroll
    for (int r = 0; r < 16; ++r) {
        const int c = (r & 3) + 8 * (r >> 2);
        if ((unsigned)(dq - c) >= W) p0[r] = NEG;
        if ((unsigned)(dq - c - 32) >= W) p1[r] = NEG;
    }
}
__device__ __forceinline__ void partialSM(f32x16& p0, f32x16& p1, float& m_reg, float& mn, float& alpha, const float SCALE) {
    float pmax = p0[0];
#pragma unroll
    for (int r = 1; r < 16; ++r) pmax = fmaxf(pmax, p0[r]);
#pragma unroll
    for (int r = 0; r < 16; ++r) pmax = fmaxf(pmax, p1[r]);
    { auto rr = __builtin_amdgcn_permlane32_swap(__float_as_uint(pmax), __float_as_uint(pmax), false, false);
      pmax = fmaxf(__uint_as_float(rr[0]), __uint_as_float(rr[1])); }
    const float C2 = 1.4426950408889634f * SCALE;
    if (__builtin_expect(__all((pmax - m_reg) * SCALE <= THR), 1)) { mn = m_reg; alpha = 1.f; }
    else { mn = fmaxf(m_reg, pmax); alpha = __builtin_amdgcn_exp2f((m_reg - mn) * C2); m_reg = mn; }
    const float mnL = -mn * C2;
#pragma unroll
    for (int r = 0; r < 16; ++r) p0[r] = fmaf(p0[r], C2, mnL);
#pragma unroll
    for (int r = 0; r < 16; ++r) p1[r] = fmaf(p1[r], C2, mnL);
#pragma unroll
    for (int r = 0; r < 16; ++r) p0[r] = __builtin_amdgcn_exp2f(p0[r]);
}
__device__ __forceinline__ void finishSM(f32x16& p0, f32x16& p1, float alpha, float& l_reg, bf16x8& pa0, bf16x8& pa1, bf16x8& pa2, bf16x8& pa3) {
#pragma unroll
    for (int r = 0; r < 16; ++r) p1[r] = __builtin_amdgcn_exp2f(p1[r]);
    float ps = 0;
#pragma unroll
    for (int r = 0; r < 16; ++r) ps += p0[r];
#pragma unroll
    for (int r = 0; r < 16; ++r) ps += p1[r];
    { auto rr = __builtin_amdgcn_permlane32_swap(__float_as_uint(ps), __float_as_uint(ps), false, false);
      ps = __uint_as_float(rr[0]) + __uint_as_float(rr[1]); }
    l_reg = l_reg * alpha + ps;
#define PK4(P, B_, OUT) do { unsigned a0 = cvt_pk_bf16(P[B_+0], P[B_+1]), a1 = cvt_pk_bf16(P[B_+2], P[B_+3]);                          \
        unsigned b0 = cvt_pk_bf16(P[B_+4], P[B_+5]), b1 = cvt_pk_bf16(P[B_+6], P[B_+7]);                                             \
        auto r0 = __builtin_amdgcn_permlane32_swap(a0, b0, false, false); auto r1 = __builtin_amdgcn_permlane32_swap(a1, b1, false, false); \
        u32x4 w = {r0[0], r1[0], r0[1], r1[1]}; OUT = *reinterpret_cast<bf16x8*>(&w); } while (0)
    PK4(p0, 0, pa0); PK4(p0, 8, pa1); PK4(p1, 0, pa2); PK4(p1, 8, pa3);
#undef PK4
}
template <int DQK>
__device__ __forceinline__ void qkt(f32x16& p0, f32x16& p1, const LAS char* Kt, int r32, int hi, const bf16x8* qr) {
    constexpr int PITCH = DQK * 2;
    p0 = f32x16{}; p1 = f32x16{};
    const LAS char* kb[4];
#pragma unroll
    for (int dd = 0; dd < 4; ++dd) kb[dd] = Kt + r32 * PITCH + (((dd * 16 + hi * 8) * 2) ^ ((r32 & 7) << 4));
#pragma unroll
    for (int d0 = 0; d0 < DQK / 16; ++d0) { const LAS char* a = kb[d0 & 3] + (d0 >> 2) * 128;
        bf16x8 b0 = *reinterpret_cast<const LAS bf16x8*>(a);
        bf16x8 b1 = *reinterpret_cast<const LAS bf16x8*>(a + 32 * PITCH);
        p0 = __builtin_amdgcn_mfma_f32_32x32x16_bf16(b0, qr[d0], p0, 0, 0, 0);
        p1 = __builtin_amdgcn_mfma_f32_32x32x16_bf16(b1, qr[d0], p1, 0, 0, 0); }
}
template <int VOFF>
__device__ __forceinline__ void pv_tile(f32x16* o, int vaddr, bf16x8 pa0, bf16x8 pa1, bf16x8 pa2, bf16x8 pa3) {
#define TRRD(dst, off) asm volatile("ds_read_b64_tr_b16 %0, %1 offset:%2" : "=&v"(dst) : "v"(vaddr), "i"(off) : "memory")
#define PV_D0(d0) do { s16x4 l0, l1, l2, l3, h0, h1, h2, h3; constexpr int b_ = VOFF + v_rd_off(d0, 0, 0); \
        TRRD(l0, b_); TRRD(h0, b_ + 2048); TRRD(l1, b_ + 4096); TRRD(h1, b_ + 6144); TRRD(l2, b_ + 8192); TRRD(h2, b_ + 10240); TRRD(l3, b_ + 12288); TRRD(h3, b_ + 14336); \
        asm volatile("s_waitcnt lgkmcnt(0)" ::: "memory"); SBAR();   \
        o[d0] = __builtin_amdgcn_mfma_f32_32x32x16_bf16(pa0, (bf16x8){l0[0], l0[1], l0[2], l0[3], h0[0], h0[1], h0[2], h0[3]}, o[d0], 0, 0, 0);   \
        o[d0] = __builtin_amdgcn_mfma_f32_32x32x16_bf16(pa1, (bf16x8){l1[0], l1[1], l1[2], l1[3], h1[0], h1[1], h1[2], h1[3]}, o[d0], 0, 0, 0);   \
        o[d0] = __builtin_amdgcn_mfma_f32_32x32x16_bf16(pa2, (bf16x8){l2[0], l2[1], l2[2], l2[3], h2[0], h2[1], h2[2], h2[3]}, o[d0], 0, 0, 0);   \
        o[d0] = __builtin_amdgcn_mfma_f32_32x32x16_bf16(pa3, (bf16x8){l3[0], l3[1], l3[2], l3[3], h3[0], h3[1], h3[2], h3[3]}, o[d0], 0, 0, 0); } while (0)
    PV_D0(0); PV_D0(1); PV_D0(2); PV_D0(3);
#undef PV_D0
#undef TRRD
}

constexpr int MLA_TILE = 16384;
constexpr int MLA_V_OFF = 0, MLA_KN_OFF = 2 * MLA_TILE, MLA_KR_OFF = 4 * MLA_TILE, MLA_KR_BYTES = 8192, MLA_WS_OFF = MLA_KR_OFF + 2 * MLA_KR_BYTES;
__device__ __forceinline__ void mla_block(LAS char* lds, const bf16_t* __restrict__ q, const bf16_t* __restrict__ kv, const bf16_t* __restrict__ krope,
                                          const float* __restrict__ cs, const float* __restrict__ sn, bf16_t* __restrict__ omla, int b, int h, int qb) {
    const float SCALE = 0.07216878364870322f;
    int tid_ = threadIdx.x; asm volatile("" : "+v"(tid_));
    const int tid = tid_, wid = __builtin_amdgcn_readfirstlane(tid >> 6), lane = tid & 63, r32 = lane & 31, hi = lane >> 5;
    LAS float* wsf = (LAS float*)(lds + MLA_WS_OFF) + wid * 64; LAS float* li_l = wsf; LAS float* al_l = wsf + 32;
    const int P0 = qb * 256, tb = b * SEQ;
    const int NT = (P0 + 256) / KVBLK;
    const int qlo = P0 + wid * 32, qm = qlo + r32 - 4 * hi;
    bf16x8 qr[12];
    { const size_t qrow = (size_t)(tb + qlo + r32); const bf16_t* qp = q + qrow * 3072 + h * 192;
#pragma unroll
      for (int d0 = 0; d0 < 8; ++d0) qr[d0] = *(const bf16x8*)(qp + d0 * 16 + hi * 8);
      const bf16x8 x8 = *(const bf16x8*)(qp + 128 + hi * 8), x9 = *(const bf16x8*)(qp + 144 + hi * 8), x10 = *(const bf16x8*)(qp + 160 + hi * 8), x11 = *(const bf16x8*)(qp + 176 + hi * 8);
      const float* cp = cs + qrow * 32 + hi * 8; const float* sp = sn + qrow * 32 + hi * 8;
      float n8[8], n9[8], n10[8], n11[8];
#pragma unroll
      for (int e = 0; e < 8; ++e) { const float c0 = cp[e], s0 = sp[e], c1 = cp[16 + e], s1 = sp[16 + e];
          const float a8 = bf2f((unsigned short)x8[e]), a9 = bf2f((unsigned short)x9[e]), a10 = bf2f((unsigned short)x10[e]), a11 = bf2f((unsigned short)x11[e]);
          n8[e] = a8 * c0 - a10 * s0; n10[e] = a10 * c0 + a8 * s0; n9[e] = a9 * c1 - a11 * s1; n11[e] = a11 * c1 + a9 * s1; }
      qr[8] = pack8((f32x4){n8[0], n8[1], n8[2], n8[3]}, (f32x4){n8[4], n8[5], n8[6], n8[7]});
      qr[9] = pack8((f32x4){n9[0], n9[1], n9[2], n9[3]}, (f32x4){n9[4], n9[5], n9[6], n9[7]});
      qr[10] = pack8((f32x4){n10[0], n10[1], n10[2], n10[3]}, (f32x4){n10[4], n10[5], n10[6], n10[7]});
      qr[11] = pack8((f32x4){n11[0], n11[1], n11[2], n11[3]}, (f32x4){n11[4], n11[5], n11[6], n11[7]}); }
    unsigned voff_kn, voff_v, voff_kr;
    { const int row = tid >> 4, cp_ = tid & 15, g = cp_ >> 3, j = cp_ & 7;
      voff_kn = (unsigned)(row * 8192 + (h * 256 + (g * 8 + (j ^ (row & 7))) * 8) * 2);
      const int kk = (tid >> 7) * 8 + ((tid & 31) >> 2), key = (kk & ~0xC) | ((kk & 4) << 1) | ((kk & 8) >> 1), c = ((tid >> 5) & 3) * 32 + (tid & 3) * 8;
      voff_v = (unsigned)(key * 8192 + (h * 256 + 128 + c) * 2);
      const int prow = tid >> 4, half = (tid >> 3) & 1, jr = (tid & 7) ^ (prow & 7);
      voff_kr = (unsigned)((prow + 32 * half) * 128 + jr * 16); }
    const char* kvb = (const char*)(kv + (size_t)tb * 4096); const char* krb = (const char*)(krope + (size_t)tb * 64);
    const unsigned ldsw = (unsigned)wid * 1024u;
#define GLDS(gp, lp) __builtin_amdgcn_global_load_lds((const unsigned*)(gp), (LAS unsigned*)(lp), 16, 0, 0)
#define ST_ISSUE(kb_, BF) do { const char* kt_ = kvb + (size_t)(kb_) * 8192;                                                              \
        GLDS(kt_ + voff_kn, lds + MLA_KN_OFF + (BF) * MLA_TILE + ldsw); GLDS(kt_ + 32 * 8192 + voff_kn, lds + MLA_KN_OFF + (BF) * MLA_TILE + 8192 + ldsw); \
        GLDS(kt_ + voff_v, lds + MLA_V_OFF + (BF) * MLA_TILE + ldsw);   GLDS(kt_ + 32 * 8192 + voff_v, lds + MLA_V_OFF + (BF) * MLA_TILE + 8192 + ldsw);   \
        GLDS(krb + (size_t)(kb_) * 128 + voff_kr, lds + MLA_KR_OFF + (BF) * MLA_KR_BYTES + ldsw); } while (0)
    float m_reg = -1e30f, l_reg = 0.f; f32x16 o[4] = {};
    const int vb0 = (int)(size_t)(lds + MLA_V_OFF) + v_rd_base(lane);
    const LAS char* kbn[4];
#pragma unroll
    for (int dd = 0; dd < 4; ++dd) kbn[dd] = lds + MLA_KN_OFF + r32 * 256 + (((dd * 16 + hi * 8) * 2) ^ ((r32 & 7) << 4));
#define ST_ISSUE_K(kb_, BF) do { const char* kt_ = kvb + (size_t)(kb_) * 8192;                                                             \
        GLDS(kt_ + voff_kn, lds + MLA_KN_OFF + (BF) * MLA_TILE + ldsw); GLDS(kt_ + 32 * 8192 + voff_kn, lds + MLA_KN_OFF + (BF) * MLA_TILE + 8192 + ldsw); \
        GLDS(krb + (size_t)(kb_) * 128 + voff_kr, lds + MLA_KR_OFF + (BF) * MLA_KR_BYTES + ldsw); } while (0)
#define ST_ISSUE_V(kb_, BF) do { const char* kt_ = kvb + (size_t)(kb_) * 8192;                                                             \
        GLDS(kt_ + voff_v, lds + MLA_V_OFF + (BF) * MLA_TILE + ldsw);   GLDS(kt_ + 32 * 8192 + voff_v, lds + MLA_V_OFF + (BF) * MLA_TILE + 8192 + ldsw); } while (0)
#define QK_TILE(P0_, P1_, BF) do { P0_ = f32x16{}; P1_ = f32x16{};                                                                          \
        _Pragma("unroll") for (int d0 = 0; d0 < 8; ++d0) { const LAS char* a_ = kbn[d0 & 3] + (BF) * MLA_TILE + (d0 >> 2) * 128;            \
            const bf16x8 b0 = *reinterpret_cast<const LAS bf16x8*>(a_), b1 = *reinterpret_cast<const LAS bf16x8*>(a_ + 32 * 256);            \
            P0_ = __builtin_amdgcn_mfma_f32_32x32x16_bf16(b0, qr[d0], P0_, 0, 0, 0); P1_ = __builtin_amdgcn_mfma_f32_32x32x16_bf16(b1, qr[d0], P1_, 0, 0, 0); } \
        _Pragma("unroll") for (int d0 = 0; d0 < 4; ++d0) { const LAS char* a_ = kbn[d0] + (MLA_KR_OFF - MLA_KN_OFF) + (BF) * MLA_KR_BYTES;  \
            const bf16x8 b0 = *reinterpret_cast<const LAS bf16x8*>(a_), b1 = *reinterpret_cast<const LAS bf16x8*>(a_ + 128);                 \
            P0_ = __builtin_amdgcn_mfma_f32_32x32x16_bf16(b0, qr[8 + d0], P0_, 0, 0, 0); P1_ = __builtin_amdgcn_mfma_f32_32x32x16_bf16(b1, qr[8 + d0], P1_, 0, 0, 0); } } while (0)
    f32x16 pA0, pA1, pB0, pB1;
    const bool grpA = wid < 4;
#define HB(vm) do { asm volatile("s_waitcnt vmcnt(" #vm ") lgkmcnt(0)" ::: "memory"); __builtin_amdgcn_s_barrier(); asm volatile("" ::: "memory"); } while (0)
#define QK_IF(t_, P0_, P1_, BF) do { if ((t_) < NT && (t_) * KVBLK <= qlo + 31) QK_TILE(P0_, P1_, BF); } while (0)
#define SMPV(t_, C0, C1, BF) do { const int kb = (t_) * KVBLK;                                                                            \
        if (kb <= qlo + 31) {                                                                                                             \
            float mn, alpha; bf16x8 pa0, pa1, pa2, pa3;                                                                                   \
            if (kb + KVBLK - 1 > qlo) mask_tile(C0, C1, qm - kb, 0x7fffffffu);                                                            \
            partialSM(C0, C1, m_reg, mn, alpha, SCALE);                                                                                   \
            finishSM(C0, C1, alpha, l_reg, pa0, pa1, pa2, pa3);                                                                           \
            if (__any(alpha < 1.f)) { if (hi == 0) al_l[r32] = alpha; LDS_WAIT();                                                         \
                _Pragma("unroll") for (int d_ = 0; d_ < 4; ++d_) _Pragma("unroll") for (int r = 0; r < 16; ++r) o[d_][r] *= al_l[crow(r, hi)]; } \
            pv_tile<MLA_V_OFF + (BF) * MLA_TILE>(o, vb0, pa0, pa1, pa2, pa3);                                                             \
        } } while (0)
#define ISSUE_K2(kb_, BF) do { const char* kt_ = kvb + (size_t)(kb_) * 8192; const char* kr_ = krb + (size_t)(kb_) * 128;                   \
        _Pragma("unroll") for (int pp = 0; pp < 2; ++pp) {                                                                                 \
            GLDS(kt_ + pp * 16 * 8192 + voff_kn, lds + MLA_KN_OFF + (BF) * MLA_TILE + pp * 4096 + ldsw);                                    \
            GLDS(kt_ + (32 + pp * 16) * 8192 + voff_kn, lds + MLA_KN_OFF + (BF) * MLA_TILE + 8192 + pp * 4096 + ldsw);                      \
            GLDS(kr_ + pp * 16 * 128 + voff_kr, lds + MLA_KR_OFF + (BF) * MLA_KR_BYTES + pp * 4096 + ldsw); } } while (0)
#define ISSUE_V2(kb_, BF) do { const char* kt_ = kvb + (size_t)(kb_) * 8192;                                                               \
        _Pragma("unroll") for (int pp = 0; pp < 2; ++pp) {                                                                                 \
            GLDS(kt_ + pp * 16 * 8192 + voff_v, lds + MLA_V_OFF + (BF) * MLA_TILE + pp * 4096 + ldsw);                                      \
            GLDS(kt_ + (32 + pp * 16) * 8192 + voff_v, lds + MLA_V_OFF + (BF) * MLA_TILE + 8192 + pp * 4096 + ldsw); } } while (0)
    ST_ISSUE_K(0, 0); ST_ISSUE_V(0, 0); ST_ISSUE_K(KVBLK, 1);
    HB(0);
    QK_TILE(pA0, pA1, 0);
    HB(0);
    if (!grpA) HB(0);
    for (int t = 0; t < NT; t += 2) {
        if (grpA && t + 2 < NT) ISSUE_K2((t + 2) * KVBLK, 0);
        QK_IF(t + 1, pB0, pB1, 1);
        if (t + 2 < NT) HB(6); else HB(0);
        if (grpA) ISSUE_V2((t + 1) * KVBLK, 1);
        SMPV(t, pA0, pA1, 0);
        HB(4);
        if (grpA && t + 3 < NT) ISSUE_K2((t + 3) * KVBLK, 1);
        QK_IF(t + 2, pA0, pA1, 0);
        if (t + 3 < NT) HB(6); else HB(0);
        if (grpA && t + 2 < NT) ISSUE_V2((t + 2) * KVBLK, 0);
        SMPV(t + 1, pB0, pB1, 1);
        if (t + 2 < NT) HB(4); else HB(0);
    }
    if (grpA) HB(0);
#undef ISSUE_K2
#undef ISSUE_V2
#undef SMPV
#undef QK_IF
#undef HB
#undef QK_TILE
#undef ST_ISSUE_K
#undef ST_ISSUE_V
#undef TILE_STEP
#undef ST_ISSUE
#undef GLDS
    if (hi == 0) li_l[r32] = l_reg; LDS_WAIT();
    LAS char* ost = lds + wid * 8192;
#pragma unroll
    for (int r = 0; r < 16; ++r) { const int orow = crow(r, hi); const float rl = __builtin_amdgcn_rcpf(li_l[orow]);
#pragma unroll
        for (int d0 = 0; d0 < 4; ++d0) { const float v = o[d0][r] * rl; const float vn = __shfl_xor(v, 1);
            if ((r32 & 1) == 0) *(LAS unsigned*)(ost + orow * 256 + (d0 * 32 + r32) * 2) = cvt_pk_bf16(v, vn); } }
    LDS_WAIT();
    bf16_t* Ow = omla + (size_t)(tb + qlo) * 2048 + h * 128;
#pragma unroll
    for (int k = 0; k < 8; ++k) { const int row = k * 4 + (lane >> 4), ch = lane & 15;
        const u32x4 w = *(const LAS u32x4*)(ost + row * 256 + ch * 16);
        *(u32x4*)(Ow + (size_t)row * 2048 + ch * 8) = w; }
    __syncthreads();
}

constexpr int XA_K_OFF = 32768, XA_WS_OFF = 65536;
__device__ __forceinline__ void xattn_block(LAS char* lds, const bf16_t* __restrict__ qc, const bf16_t* __restrict__ kc, const bf16_t* __restrict__ vc, bf16_t* __restrict__ oc, int b, int h, int qb) {
    const float SCALE = 0.0625f;
    int tid_ = threadIdx.x; asm volatile("" : "+v"(tid_));
    const int tid = tid_, wid = __builtin_amdgcn_readfirstlane(tid >> 6), lane = tid & 63, r32 = lane & 31, hi = lane >> 5;
    const int rg = wid & 3, vsp = wid >> 2;
    LAS float* wsf = (LAS float*)(lds + XA_WS_OFF) + wid * 64; LAS float* li_l = wsf; LAS float* al_l = wsf + 32;
    const int row0 = b * SEQ + qb * 128 + rg * 32;
    bf16x8 qr[16];
    { const bf16_t* qp = qc + (size_t)(row0 + r32) * 1024 + h * 256;
#pragma unroll
      for (int d0 = 0; d0 < 16; ++d0) qr[d0] = *(const bf16x8*)(qp + d0 * 16 + hi * 8); }
    unsigned voff_k, voff_v;
    { const int row = tid >> 5, cp_ = tid & 31, g = cp_ >> 3, j = cp_ & 7;
      voff_k = (unsigned)(row * 2048 + (h * 256 + (g * 8 + (j ^ (row & 7))) * 8) * 2);
      const int kk = (tid >> 7) * 8 + ((tid & 31) >> 2), key = (kk & ~0xC) | ((kk & 4) << 1) | ((kk & 8) >> 1), c = ((tid >> 5) & 3) * 32 + (tid & 3) * 8;
      voff_v = (unsigned)(key * 2048 + (h * 256 + c) * 2); }
    const char* kcb = (const char*)(kc + (size_t)b * MEMT * 1024); const char* vcb = (const char*)(vc + (size_t)b * MEMT * 1024);
    const unsigned ldsw = (unsigned)wid * 1024u;
#define GLDS(gp, lp) __builtin_amdgcn_global_load_lds((const unsigned*)(gp), (LAS unsigned*)(lp), 16, 0, 0)
    float m_reg = -1e30f, l_reg = 0.f; f32x16 o[4] = {};
    const int vb0 = (int)(size_t)(lds + vsp * 16384) + v_rd_base(lane);
    const LAS char* kbn[4];
#pragma unroll
    for (int dd = 0; dd < 4; ++dd) kbn[dd] = lds + XA_K_OFF + r32 * 512 + (((dd * 16 + hi * 8) * 2) ^ ((r32 & 7) << 4));
    for (int t = 0; t < 4; ++t) {
        const char* kt_ = kcb + (size_t)(t * 64) * 2048; const char* vt_ = vcb + (size_t)(t * 64) * 2048;
        __syncthreads();
#pragma unroll
        for (int i = 0; i < 4; ++i) GLDS(kt_ + (size_t)i * 16 * 2048 + voff_k, lds + XA_K_OFF + i * 8192 + ldsw);
#pragma unroll
        for (int hv = 0; hv < 2; ++hv)
#pragma unroll
            for (int i = 0; i < 2; ++i) GLDS(vt_ + (size_t)i * 32 * 2048 + hv * 256 + voff_v, lds + hv * 16384 + i * 8192 + ldsw);
        asm volatile("s_waitcnt vmcnt(0)" ::: "memory");
        __syncthreads();
        f32x16 p0 = {}, p1 = {}; float mn, alpha; bf16x8 pa0, pa1, pa2, pa3;
#pragma unroll
        for (int d0 = 0; d0 < 16; ++d0) { const LAS char* a_ = kbn[d0 & 3] + (d0 >> 2) * 128;
            const bf16x8 b0 = *reinterpret_cast<const LAS bf16x8*>(a_), b1 = *reinterpret_cast<const LAS bf16x8*>(a_ + 32 * 512);
            p0 = __builtin_amdgcn_mfma_f32_32x32x16_bf16(b0, qr[d0], p0, 0, 0, 0); p1 = __builtin_amdgcn_mfma_f32_32x32x16_bf16(b1, qr[d0], p1, 0, 0, 0); }
        partialSM(p0, p1, m_reg, mn, alpha, SCALE);
        finishSM(p0, p1, alpha, l_reg, pa0, pa1, pa2, pa3);
        if (__any(alpha < 1.f)) { if (hi == 0) al_l[r32] = alpha; LDS_WAIT();
#pragma unroll
            for (int d_ = 0; d_ < 4; ++d_)
#pragma unroll
                for (int r = 0; r < 16; ++r) o[d_][r] *= al_l[crow(r, hi)]; }
        pv_tile<0>(o, vb0, pa0, pa1, pa2, pa3);
    }
#undef GLDS
    if (hi == 0) li_l[r32] = l_reg; LDS_WAIT();
    bf16_t* Ow = oc + (size_t)row0 * 1024 + h * 256 + vsp * 128;
#pragma unroll
    for (int r = 0; r < 16; ++r) { const int orow = crow(r, hi); const float rl = __builtin_amdgcn_rcpf(li_l[orow]);
#pragma unroll
        for (int d0 = 0; d0 < 4; ++d0) { const float v = o[d0][r] * rl; const float vn = __shfl_xor(v, 1);
            if ((r32 & 1) == 0) *(unsigned*)(Ow + (size_t)orow * 1024 + d0 * 32 + r32) = cvt_pk_bf16(v, vn); } }
    __syncthreads();
}
}

constexpr int STAGE_BYTES = 131072;
constexpr int MISC_OFF = STAGE_BYTES;
constexpr int XSTG_OFF = STAGE_BYTES + 256;
constexpr int LDS_BYTES = XSTG_OFF + 8 * 2304;

struct Args { const float* in[26]; float* out; unsigned char* ws; int ph_lo, ph_hi; };

struct Frame {
    LAS unsigned char* lds;
    int tid, lane, wave, G, bid;
    int gw, NGW;
    int xj, xrank, xn;
};

__device__ __forceinline__ int win_map(int n) {
    if (n < 1536) return n;
    if (n < 1600) return 7680 + (n - 1536);
    if (n < 5696) return n - 64;
    if (n < 5712) return 7744 + (n - 5696);
    return n - 80;
}
template <int MODE>
__device__ __forceinline__ void transpose_item(const float* W, int K, int N, bf16_t* WT, const float* gain, LAS float* scr, int item, int lane) {
    const int nblk = (N + 31) / 32, kb = item / nblk, nb = item % nblk, k0 = 64 * kb, n0 = 32 * nb;
    const int n4 = n0 + 4 * (lane & 7); const bool nok = n4 < N;
    f32x4 v[8];
#pragma unroll
    for (int i = 0; i < 8; ++i) v[i] = nok ? *(const f32x4*)(W + (size_t)(k0 + 8 * i + (lane >> 3)) * N + n4) : (f32x4){0.f, 0.f, 0.f, 0.f};
#pragma unroll
    for (int i = 0; i < 8; ++i) { const int kk = 8 * i + (lane >> 3); const float g = gain ? gain[k0 + kk] : 1.0f; LAS float* d = scr + kk * 33 + 4 * (lane & 7);
        d[0] = v[i][0] * g; d[1] = v[i][1] * g; d[2] = v[i][2] * g; d[3] = v[i][3] * g; }
    LDS_WAIT();
    const int c = lane & 7;
#pragma unroll
    for (int j = 0; j < 4; ++j) { const int n = (lane >> 3) + 8 * j; const LAS float* s = scr + (8 * c) * 33 + n;
        u32x4 o; o.x = cvt_pk_bf16(s[0 * 33], s[1 * 33]); o.y = cvt_pk_bf16(s[2 * 33], s[3 * 33]); o.z = cvt_pk_bf16(s[4 * 33], s[5 * 33]); o.w = cvt_pk_bf16(s[6 * 33], s[7 * 33]);
        const int ng = n0 + n;
        if (ng < N) { const int row = MODE == 1 ? win_map(ng) : ng; *(u32x4*)(WT + (size_t)row * K + k0 + 8 * c) = o; } }
    LDS_WAIT();
}
template <int MODE>
__device__ __forceinline__ void transpose_all(const Frame& F, const float* W, int K, int N, bf16_t* WT, const float* gain, int& cursor) {
    LAS float* scr = (LAS float*)(F.lds + F.wave * 8704);
    const int nitems = (K / 64) * ((N + 31) / 32);
    int first = (F.gw - cursor % F.NGW + F.NGW) % F.NGW;
    for (int it = first; it < nitems; it += F.NGW) transpose_item<MODE>(W, K, N, WT, gain, scr, it, F.lane);
    cursor += nitems;
}


__device__ __forceinline__ void p0_prologue(const Frame& F, const Args& a) {
    unsigned char* ws = a.ws;
    int cursor = 0;
    transpose_all<1>(F, a.in[5], D, IN_W, (bf16_t*)(ws + WS_WIN), a.in[4], cursor);
    transpose_all<0>(F, a.in[7], 1024, 3072, (bf16_t*)(ws + WS_WUQ), a.in[6], cursor);
    transpose_all<0>(F, a.in[9], 512, 4096, (bf16_t*)(ws + WS_WUKV), a.in[8], cursor);
    transpose_all<0>(F, a.in[14], D, D, (bf16_t*)(ws + WS_WOUT), nullptr, cursor);
    transpose_all<0>(F, a.in[16], D, 1024, (bf16_t*)(ws + WS_WCQ), a.in[15], cursor);
    transpose_all<0>(F, a.in[17], D, 1024, (bf16_t*)(ws + WS_WCK), nullptr, cursor);
    transpose_all<0>(F, a.in[18], D, 1024, (bf16_t*)(ws + WS_WCV), nullptr, cursor);
    transpose_all<0>(F, a.in[19], 1024, D, (bf16_t*)(ws + WS_WCO), nullptr, cursor);
    transpose_all<0>(F, a.in[21], D, 2048, (bf16_t*)(ws + WS_WPQ), a.in[20], cursor);
    { u32x4* z = (u32x4*)(ws + WS_WIN + (size_t)IN_W * D * 2); const size_t n16 = (size_t)(IN_WP - IN_W) * D * 2 / 16;
      for (size_t i = (size_t)F.bid * NTHREADS + F.tid; i < n16; i += (size_t)F.G * NTHREADS) z[i] = (u32x4){0u, 0u, 0u, 0u}; }
    { const float* k = a.in[22]; bf16_t* o = (bf16_t*)(ws + WS_KEYS); const size_t n8 = (size_t)8 * 2 * 128 * 128 / 8;
      for (size_t i = (size_t)F.bid * NTHREADS + F.tid; i < n8; i += (size_t)F.G * NTHREADS) {
          const f32x4 v0 = *(const f32x4*)(k + i * 8), v1 = *(const f32x4*)(k + i * 8 + 4); *(bf16x8*)(o + i * 8) = pack8(v0, v1); } }
    { const int* pos = (const int*)a.in[2]; float* cs = (float*)(ws + WS_ROPE); float* sn = cs + (size_t)M * 32;
      for (size_t i = (size_t)F.bid * NTHREADS + F.tid; i < (size_t)M * 32; i += (size_t)F.G * NTHREADS) {
          const int m = (int)(i >> 5), fi = (int)(i & 31);
          const float inv = exp2f(-(float)fi * (13.287712379549449f / 32.0f));
          const float ang = (float)pos[m] * inv;
          const float kf = rintf(ang * 0.15915494309189535f);
          float r = fmaf(-kf, 6.28125f, ang); r = fmaf(-kf, 1.9353071795864769e-3f, r);
          const float rev = r * 0.15915494309189535f;
          cs[i] = __builtin_amdgcn_cosf(rev); sn[i] = __builtin_amdgcn_sinf(rev); } }
    { const float* x = a.in[0]; bf16_t* xb = (bf16_t*)(ws + WS_XB); float* rs = (float*)(ws + WS_RSTDX);
      for (int m = F.gw; m < M; m += F.NGW) {
          const f32x4* xr = (const f32x4*)(x + (size_t)m * D); u32x2* xo = (u32x2*)(xb + (size_t)m * D); float ss = 0.f;
          f32x4 v[16];
#pragma unroll
          for (int j = 0; j < 16; ++j) v[j] = xr[F.lane + 64 * j];
#pragma unroll
          for (int j = 0; j < 16; ++j) { ss += (v[j][0] * v[j][0] + v[j][1] * v[j][1]) + (v[j][2] * v[j][2] + v[j][3] * v[j][3]);
              u32x2 p; p.x = cvt_pk_bf16(v[j][0], v[j][1]); p.y = cvt_pk_bf16(v[j][2], v[j][3]); xo[F.lane + 64 * j] = p; }
          ss = wave_sum(ss);
          if (F.lane == 0) rs[m] = 1.0f / sqrtf(ss * (1.0f / D) + EPS); } }
    { const float* mem = a.in[1]; const float* g = a.in[3]; bf16_t* mn = (bf16_t*)(ws + WS_MN);
      for (int m = F.gw; m < MROWS; m += F.NGW) {
          const f32x4* xr = (const f32x4*)(mem + (size_t)m * D); const f32x4* gr = (const f32x4*)g; u32x4* xo = (u32x4*)(mn + (size_t)m * D);
          f32x4 v[16]; float ss = 0.f;
#pragma unroll
          for (int j = 0; j < 8; ++j) { v[2 * j] = xr[2 * F.lane + 128 * j]; v[2 * j + 1] = xr[2 * F.lane + 1 + 128 * j]; }
#pragma unroll
          for (int j = 0; j < 16; ++j) ss += (v[j][0] * v[j][0] + v[j][1] * v[j][1]) + (v[j][2] * v[j][2] + v[j][3] * v[j][3]);
          ss = wave_sum(ss); const float r = 1.0f / sqrtf(ss * (1.0f / D) + EPS);
#pragma unroll
          for (int j = 0; j < 8; ++j) { const f32x4 g0 = gr[2 * F.lane + 128 * j], g1 = gr[2 * F.lane + 1 + 128 * j];
              const bf16x8 p = pack8(v[2 * j] * r * g0, v[2 * j + 1] * r * g1); xo[F.lane + 64 * j] = *(const u32x4*)&p; } } }
}


__device__ __forceinline__ unsigned short f2bf(float v) { return (unsigned short)(cvt_pk_bf16(v, 0.f) & 0xffffu); }
__device__ __forceinline__ float ssq8(bf16x8 v) { float s = 0.f;
#pragma unroll
    for (int e = 0; e < 8; ++e) { const float a = bf2f((unsigned short)v[e]); s += a * a; } return s; }
__device__ __forceinline__ void p2_stats(const Frame& F, unsigned char* ws) {
    const bf16_t* cq = (const bf16_t*)(ws + WS_CQ); const bf16_t* ckv = (const bf16_t*)(ws + WS_CKV); const bf16_t* sm = (const bf16_t*)(ws + WS_SM);
    const float* cs = (const float*)(ws + WS_ROPE); const float* sn = cs + (size_t)M * 32;
    float* rq = (float*)(ws + WS_RSTDQ); float* rkv = (float*)(ws + WS_RSTDKV); bf16_t* kr = (bf16_t*)(ws + WS_KROPE);
    for (int m = F.gw; m < M; m += F.NGW) {
        const bf16x8* a = (const bf16x8*)(cq + (size_t)m * 1024);
        float s1 = ssq8(a[2 * F.lane]) + ssq8(a[2 * F.lane + 1]);
        float s2 = ssq8(((const bf16x8*)(ckv + (size_t)m * 512))[F.lane]);
        s1 = wave_sum(s1); s2 = wave_sum(s2);
        if (F.lane == 0) { rq[m] = 1.0f / sqrtf(s1 * (1.0f / 1024.0f) + EPS); rkv[m] = 1.0f / sqrtf(s2 * (1.0f / 512.0f) + EPS); }
        if (F.lane < 32) { const float x1 = bf2f(sm[(size_t)m * 256 + F.lane]), x2 = bf2f(sm[(size_t)m * 256 + 32 + F.lane]);
            const float c = cs[(size_t)m * 32 + F.lane], s = sn[(size_t)m * 32 + F.lane];
            kr[(size_t)m * 64 + F.lane] = f2bf(x1 * c - x2 * s); kr[(size_t)m * 64 + 32 + F.lane] = f2bf(x2 * c + x1 * s); }
    }
}

__device__ __forceinline__ size_t fr_index(int cgh, int kblk, int mt, int lane, int j) { return ((((size_t)cgh * 8 + kblk) * 4 + mt) * 64 + lane) * 8 + j; }
__device__ __forceinline__ size_t kd_index(int cgh, int w, int t, int s, int lane, int j) { return (((((size_t)cgh * 8 + w) * 2 + t) * 2 + s) * 64 + lane) * 8 + j; }
__device__ __forceinline__ void p2_gla_prep(const Frame& F, unsigned char* ws, const float* __restrict__ w_gate_up, const float* __restrict__ b_gate) {
    const bf16_t* __restrict__ gq = (const bf16_t*)(ws + WS_GQ); const bf16_t* __restrict__ gk = (const bf16_t*)(ws + WS_GK); const bf16_t* __restrict__ sm = (const bf16_t*)(ws + WS_SM);
    bf16_t* __restrict__ qep = (bf16_t*)(ws + WS_QEP); bf16_t* __restrict__ kep = (bf16_t*)(ws + WS_KEP); bf16_t* __restrict__ kdt = (bf16_t*)(ws + WS_KDT); float* __restrict__ dec = (float*)(ws + WS_DEC);
    LAS float* glr = (LAS float*)F.lds;
    LAS float* tot = glr + 1024;
    LAS float* bcl = glr + 1280;
    constexpr int BP = 260;
    for (int cgh = F.bid; cgh < 1024; cgh += F.G) {
        const int cg = cgh >> 2, h = cgh & 3, t0 = cg * 64;
        __syncthreads();
        if (F.tid < 128) { const int tok = F.tid >> 1, half = F.tid & 1; const bf16x8 v = *(const bf16x8*)(sm + (size_t)(t0 + tok) * 256 + 64 + half * 8);
#pragma unroll
            for (int e = 0; e < 8; ++e) glr[tok * 16 + half * 8 + e] = bf2f((unsigned short)v[e]); }
        const int d = F.tid & 255, th = F.tid >> 8;
        float w[16];
#pragma unroll
        for (int r = 0; r < 16; ++r) w[r] = w_gate_up[r * 1024 + h * 256 + d];
        const float bg = b_gate[h * 256 + d];
        unsigned short kraw[32];
#pragma unroll
        for (int c = 0; c < 32; ++c) kraw[c] = gk[(size_t)(t0 + 32 * th + c) * 1024 + h * 256 + d];
        __syncthreads();
        float bc[32]; float cum = 0.f;
#pragma unroll
        for (int c = 0; c < 32; ++c) { float z = bg;
#pragma unroll
            for (int r4 = 0; r4 < 4; ++r4) { const f32x4 gv = *(const LAS f32x4*)(glr + (32 * th + c) * 16 + r4 * 4); z += gv[0] * w[r4 * 4] + gv[1] * w[r4 * 4 + 1] + gv[2] * w[r4 * 4 + 2] + gv[3] * w[r4 * 4 + 3]; }
            const float ls = fminf(z, 0.f) - __logf(1.0f + __expf(-fabsf(z)));
            cum += ls * (1.0f / 16.0f); bc[c] = cum; }
        if (th == 0) tot[d] = cum;
        __syncthreads();
        const float base = th ? tot[d] : 0.f;
        const float blast = th ? base + cum : 0.f;
        if (th == 1) tot[d] = blast;
#pragma unroll
        for (int c = 0; c < 32; ++c) { bc[c] += base; bcl[(32 * th + c) * BP + d] = bc[c]; }
        __syncthreads();
        const float bl = tot[d];
        if (th == 0) dec[(size_t)cgh * 256 + d] = __expf(bl);
        { const int wq = d >> 5, tq = (d >> 4) & 1, col = d & 15;
#pragma unroll
          for (int q_ = 0; q_ < 4; ++q_) { float kd8[8];
#pragma unroll
              for (int j = 0; j < 8; ++j) kd8[j] = bf2f(kraw[8 * q_ + j]) * __expf(bl - bc[8 * q_ + j]);
              *(bf16x8*)(kdt + kd_index(cgh, wq, tq, th, q_ * 16 + col, 0)) = pack8((f32x4){kd8[0], kd8[1], kd8[2], kd8[3]}, (f32x4){kd8[4], kd8[5], kd8[6], kd8[7]}); } }
        { const int c = F.tid & 63, o = F.tid >> 6; const size_t tok = (size_t)(t0 + c);
          bf16x8 qv[4], kv[4];
#pragma unroll
          for (int i = 0; i < 4; ++i) { qv[i] = *(const bf16x8*)(gq + tok * 1024 + h * 256 + 32 * o + 8 * i); kv[i] = *(const bf16x8*)(gk + tok * 1024 + h * 256 + 32 * o + 8 * i); }
          float eb[32];
#pragma unroll
          for (int i = 0; i < 8; ++i) { const f32x4 bv = *(const LAS f32x4*)(bcl + c * BP + 32 * o + 4 * i);
#pragma unroll
              for (int e = 0; e < 4; ++e) eb[4 * i + e] = __expf(bv[e]); }
#pragma unroll
          for (int q_ = 0; q_ < 4; ++q_) { float qe8[8], ke8[8];
#pragma unroll
              for (int j = 0; j < 8; ++j) { const int kk = j < 4 ? 4 * q_ + j : 16 + 4 * q_ + (j - 4);
                  const float e_ = eb[kk];
                  qe8[j] = bf2f((unsigned short)qv[kk >> 3][kk & 7]) * 0.0625f * e_; ke8[j] = bf2f((unsigned short)kv[kk >> 3][kk & 7]) * __builtin_amdgcn_rcpf(e_); }
              const size_t fi = fr_index(cgh, o, c >> 4, q_ * 16 + (c & 15), 0);
              *(bf16x8*)(qep + fi) = pack8((f32x4){qe8[0], qe8[1], qe8[2], qe8[3]}, (f32x4){qe8[4], qe8[5], qe8[6], qe8[7]});
              *(bf16x8*)(kep + fi) = pack8((f32x4){ke8[0], ke8[1], ke8[2], ke8[3]}, (f32x4){ke8[4], ke8[5], ke8[6], ke8[7]}); } }
    }
    __syncthreads();
}
__device__ __forceinline__ void p3_gla_att(const Frame& F, unsigned char* ws) {
    const bf16_t* qep = (const bf16_t*)(ws + WS_QEP); const bf16_t* kep = (const bf16_t*)(ws + WS_KEP); bf16_t* att = (bf16_t*)(ws + WS_ATT);
    const int mt = F.wave >> 1, nt0 = (F.wave & 1) * 2, col = F.lane & 15, q_ = F.lane >> 4;
    for (int cgh = F.bid; cgh < 1024; cgh += F.G) {
        f32x4 a0 = {0.f, 0.f, 0.f, 0.f}, a1 = {0.f, 0.f, 0.f, 0.f};
#pragma unroll
        for (int kb = 0; kb < 8; ++kb) { const bf16x8 A = *(const bf16x8*)(qep + fr_index(cgh, kb, mt, F.lane, 0));
            const bf16x8 B0 = *(const bf16x8*)(kep + fr_index(cgh, kb, nt0, F.lane, 0)), B1 = *(const bf16x8*)(kep + fr_index(cgh, kb, nt0 + 1, F.lane, 0));
            a0 = __builtin_amdgcn_mfma_f32_16x16x32_bf16(A, B0, a0, 0, 0, 0); a1 = __builtin_amdgcn_mfma_f32_16x16x32_bf16(A, B1, a1, 0, 0, 0); }
#pragma unroll
        for (int r = 0; r < 4; ++r) { const int c = mt * 16 + 4 * q_ + r, j0 = nt0 * 16 + col, j1 = j0 + 16;
            att[((size_t)cgh * 64 + c) * 64 + j0] = f2bf(j0 <= c ? a0[r] : 0.f); att[((size_t)cgh * 64 + c) * 64 + j1] = f2bf(j1 <= c ? a1[r] : 0.f); }
    }
}
__device__ __forceinline__ void p5_gla_scan(const Frame& F, unsigned char* ws) {
    const bf16_t* qep = (const bf16_t*)(ws + WS_QEP); const bf16_t* kdt = (const bf16_t*)(ws + WS_KDT); const bf16_t* att = (const bf16_t*)(ws + WS_ATT);
    const float* dec = (const float*)(ws + WS_DEC); const bf16_t* gv = (const bf16_t*)(ws + WS_GV); bf16_t* og = (bf16_t*)(ws + WS_OGLA);
    LAS bf16_t* vbuf = (LAS bf16_t*)F.lds;
    LAS float* red = (LAS float*)(F.lds + 4096);
    const int w = F.wave, lane = F.lane, col = lane & 15, q_ = lane >> 4;
    for (int item = F.bid; item < 256; item += F.G) {
        const int bh = item >> 5, vs = item & 31, b = bh >> 2, h = bh & 3;
        f32x4 st0 = {0.f, 0.f, 0.f, 0.f}, st1 = {0.f, 0.f, 0.f, 0.f};
        __syncthreads();
        bf16x8 vst = {};
        if (F.tid < 128) vst = *(const bf16x8*)(gv + (size_t)(b * SEQ + (F.tid >> 1)) * 2048 + h * 512 + vs * 16 + (F.tid & 1) * 8);
        if (F.tid < 128) *(LAS bf16x8*)(vbuf + (F.tid >> 1) * 16 + (F.tid & 1) * 8) = vst;
        __syncthreads();
        bf16x8 Aq[4], Ak[2][2], Aa[2] = {}; f32x4 dc0, dc1;
#define GLA_LOAD_OPS(n_) do { const int cg_ = (b * 128 + (n_)) * 4 + h;                                                                   \
            _Pragma("unroll") for (int mt = 0; mt < 4; ++mt) Aq[mt] = *(const bf16x8*)(qep + fr_index(cg_, w, mt, lane, 0));                 \
            _Pragma("unroll") for (int t = 0; t < 2; ++t) _Pragma("unroll") for (int s = 0; s < 2; ++s)                                       \
                Ak[t][s] = *(const bf16x8*)(kdt + kd_index(cg_, w, t, s, lane, 0));                                                              \
            if (w < 4) { _Pragma("unroll") for (int s = 0; s < 2; ++s) Aa[s] = *(const bf16x8*)(att + ((size_t)cg_ * 64 + 16 * w + col) * 64 + 32 * s + 8 * q_); } \
            dc0 = *(const f32x4*)(dec + (size_t)cg_ * 256 + 32 * w + 4 * q_); dc1 = *(const f32x4*)(dec + (size_t)cg_ * 256 + 32 * w + 16 + 4 * q_); } while (0)
        GLA_LOAD_OPS(0);
        for (int n = 0; n < 128; ++n) {
            const int t0 = b * SEQ + n * 64, pb = n & 1;
            if (n + 1 < 128 && F.tid < 128) vst = *(const bf16x8*)(gv + (size_t)(t0 + 64 + (F.tid >> 1)) * 2048 + h * 512 + vs * 16 + (F.tid & 1) * 8);
            bf16x8 cAq[4], cAk[2][2], cAa[2];
#pragma unroll
            for (int mt = 0; mt < 4; ++mt) cAq[mt] = Aq[mt];
#pragma unroll
            for (int t = 0; t < 2; ++t)
#pragma unroll
                for (int s = 0; s < 2; ++s) cAk[t][s] = Ak[t][s];
            cAa[0] = Aa[0]; cAa[1] = Aa[1];
            const f32x4 cdc0 = dc0, cdc1 = dc1;
            if (n + 1 < 128) GLA_LOAD_OPS(n + 1);
            bf16x8 Bv[2];
#pragma unroll
            for (int s = 0; s < 2; ++s)
#pragma unroll
                for (int j = 0; j < 8; ++j) Bv[s][j] = (short)vbuf[pb * 1024 + (32 * s + 8 * q_ + j) * 16 + col];
            u32x4 sw = {cvt_pk_bf16(st0[0], st0[1]), cvt_pk_bf16(st0[2], st0[3]), cvt_pk_bf16(st1[0], st1[1]), cvt_pk_bf16(st1[2], st1[3])};
            const bf16x8 Bs = *reinterpret_cast<bf16x8*>(&sw);
            f32x4 part[4];
#pragma unroll
            for (int mt = 0; mt < 4; ++mt) part[mt] = __builtin_amdgcn_mfma_f32_16x16x32_bf16(cAq[mt], Bs, (f32x4){0.f, 0.f, 0.f, 0.f}, 0, 0, 0);
            if (w < 4) {
#pragma unroll
                for (int mt = 0; mt < 4; ++mt) if (mt == w) {
                    part[mt] = __builtin_amdgcn_mfma_f32_16x16x32_bf16(cAa[0], Bv[0], part[mt], 0, 0, 0);
                    part[mt] = __builtin_amdgcn_mfma_f32_16x16x32_bf16(cAa[1], Bv[1], part[mt], 0, 0, 0); } }
            st0 = st0 * cdc0; st1 = st1 * cdc1;
            st0 = __builtin_amdgcn_mfma_f32_16x16x32_bf16(cAk[0][0], Bv[0], st0, 0, 0, 0); st0 = __builtin_amdgcn_mfma_f32_16x16x32_bf16(cAk[0][1], Bv[1], st0, 0, 0, 0);
            st1 = __builtin_amdgcn_mfma_f32_16x16x32_bf16(cAk[1][0], Bv[0], st1, 0, 0, 0); st1 = __builtin_amdgcn_mfma_f32_16x16x32_bf16(cAk[1][1], Bv[1], st1, 0, 0, 0);
#pragma unroll
            for (int mt = 0; mt < 4; ++mt) *(LAS f32x4*)(red + (size_t)pb * 8192 + ((w * 4 + mt) * 64 + lane) * 4) = part[mt];
            if (n + 1 < 128 && F.tid < 128) *(LAS bf16x8*)(vbuf + (pb ^ 1) * 1024 + (F.tid >> 1) * 16 + (F.tid & 1) * 8) = vst;
            __syncthreads();
            { const int e0 = F.tid * 2, mt = e0 >> 8, ln = (e0 >> 2) & 63, r0 = e0 & 3;
              float s0 = 0.f, s1 = 0.f;
#pragma unroll
              for (int ww = 0; ww < 8; ++ww) { const LAS float* p = red + (size_t)pb * 8192 + ((ww * 4 + mt) * 64 + ln) * 4 + r0; s0 += p[0]; s1 += p[1]; }
              const int c = mt * 16 + 4 * (ln >> 4) + r0, cc = ln & 15;
              og[(size_t)(t0 + c) * 2048 + h * 512 + vs * 16 + cc] = f2bf(s0); og[(size_t)(t0 + c + 1) * 2048 + h * 512 + vs * 16 + cc] = f2bf(s1); }
        }
    }
#undef GLA_LOAD_OPS
    __syncthreads();
}

__device__ __forceinline__ void p6_mix(const Frame& F, unsigned char* ws, const float* g_mla, const float* g_gla) {
    const bf16_t* om = (const bf16_t*)(ws + WS_OMLA); bf16_t* mx = (bf16_t*)(ws + WS_XB); const bf16_t* og = (const bf16_t*)(ws + WS_OGLA); const bf16_t* gog = (const bf16_t*)(ws + WS_GOG);
    for (int m = F.gw; m < M; m += F.NGW) {
        const bf16x8* a = (const bf16x8*)(om + (size_t)m * 2048); bf16x8 v[4]; float ss = 0.f;
#pragma unroll
        for (int j = 0; j < 4; ++j) { v[j] = a[F.lane + 64 * j]; ss += ssq8(v[j]); }
        ss = wave_sum(ss); const float r = 1.0f / sqrtf(ss * (1.0f / 2048.0f) + EPS);
        u32x4* o = (u32x4*)(mx + (size_t)m * D);
#pragma unroll
        for (int j = 0; j < 4; ++j) { const int c0 = (F.lane + 64 * j) * 8; const f32x4 g0 = *(const f32x4*)(g_mla + c0), g1 = *(const f32x4*)(g_mla + c0 + 4);
            f32x4 x0, x1;
#pragma unroll
            for (int e = 0; e < 4; ++e) { x0[e] = bf2f((unsigned short)v[j][e]) * r * g0[e]; x1[e] = bf2f((unsigned short)v[j][4 + e]) * r * g1[e]; }
            const bf16x8 p = pack8(x0, x1); o[F.lane + 64 * j] = *(const u32x4*)&p; }
        const bf16x8* ga = (const bf16x8*)(og + (size_t)m * 2048); const bf16x8* gg = (const bf16x8*)(gog + (size_t)m * 2048);
#pragma unroll
        for (int j = 0; j < 4; ++j) { const bf16x8 ov = ga[F.lane + 64 * j], gt = gg[F.lane + 64 * j];
            const float hs = wave_sum(ssq8(ov)); const float rh = 1.0f / sqrtf(hs * (1.0f / 512.0f) + EPS);
            const int c0 = F.lane * 8; const f32x4 g0 = *(const f32x4*)(g_gla + c0), g1 = *(const f32x4*)(g_gla + c0 + 4);
            f32x4 x0, x1;
#pragma unroll
            for (int e = 0; e < 4; ++e) { const float z0 = bf2f((unsigned short)gt[e]), z1 = bf2f((unsigned short)gt[4 + e]);
                x0[e] = bf2f((unsigned short)ov[e]) * rh * g0[e] * (z0 / (1.0f + __expf(-z0)));
                x1[e] = bf2f((unsigned short)ov[4 + e]) * rh * g1[e] * (z1 / (1.0f + __expf(-z1))); }
            const bf16x8 p = pack8(x0, x1); o[256 + F.lane + 64 * j] = *(const u32x4*)&p; }
    }
}
__device__ __forceinline__ void p4_mla(const Frame& F, unsigned char* ws) {
    const bf16_t* q = (const bf16_t*)(ws + WS_Q); const bf16_t* kv = (const bf16_t*)(ws + WS_KV); const bf16_t* kr = (const bf16_t*)(ws + WS_KROPE);
    const float* cs = (const float*)(ws + WS_ROPE); const float* sn = cs + (size_t)M * 32; bf16_t* om = (bf16_t*)(ws + WS_OMLA);
    for (int L = F.bid; L < 512; L += F.G) {
        const int xcd = L & 7, I = L >> 3, bh = xcd * 4 + (I >> 4), pr = I & 15, b = bh >> 4, h = bh & 15;
        for (int pass = 0; pass < 2; ++pass) att::mla_block((LAS char*)F.lds, q, kv, kr, cs, sn, om, b, h, pass ? pr : 31 - pr);
    }
}


__device__ __forceinline__ void rstd_for_units(const Frame& F, const pg8::StaticOrder& S, const float* __restrict__ ssq, float* __restrict__ rstd) {
    pg8::Unit u;
    for (int i = 0; S.next(i, u); ++i) {
        float v[32];
#pragma unroll
        for (int k = 0; k < 32; ++k) v[k] = ssq[(size_t)(u.pm * 256 + F.wave * 32 + k) * 64 + F.lane];
        float mine = 0.f;
#pragma unroll
        for (int k = 0; k < 32; ++k) { const float s = wave_sum(v[k]); mine = (F.lane == k) ? s : mine; }
        if (F.lane < 32) rstd[u.pm * 256 + F.wave * 32 + F.lane] = 1.0f / sqrtf(mine * (1.0f / D) + EPS);
    }
    asm volatile("s_waitcnt vmcnt(0)" ::: "memory");
    __syncthreads();
}
__device__ __forceinline__ void p9_xattn(const Frame& F, unsigned char* ws) {
    const bf16_t* qc = (const bf16_t*)(ws + WS_QC); const bf16_t* kc = (const bf16_t*)(ws + WS_KC); const bf16_t* vc = (const bf16_t*)(ws + WS_VC); bf16_t* oc = (bf16_t*)(ws + WS_OC);
    for (int L = F.bid; L < 512; L += F.G) { const int h = L & 3, blk = L >> 2, b = blk >> 6, qb = blk & 63;
        att::xattn_block((LAS char*)F.lds, qc, kc, vc, oc, b, h, qb); }
}


typedef float f32x2 __attribute__((ext_vector_type(2)));
__device__ __forceinline__ bool fp4_probe_ok() {
    float a = 1.0f, b = 3.0f, c = 0.5f, d = 6.0f; asm volatile("" : "+v"(a), "+v"(b), "+v"(c), "+v"(d));
    unsigned w = 0u;
    w = __builtin_amdgcn_cvt_scalef32_pk_fp4_f32(w, a, b, 1.0f, 0); w = __builtin_amdgcn_cvt_scalef32_pk_fp4_f32(w, c, d, 1.0f, 3);
    const f32x2 y0 = __builtin_amdgcn_cvt_scalef32_pk_f32_fp4(w, 1.0f, 0), y3 = __builtin_amdgcn_cvt_scalef32_pk_f32_fp4(w, 1.0f, 3), y1 = __builtin_amdgcn_cvt_scalef32_pk_f32_fp4(w, 1.0f, 1);
    return y0.x == 1.0f && y0.y == 3.0f && y3.x == 0.5f && y3.y == 6.0f && y1.x == 0.0f && y1.y == 0.0f;
}
#define DPP_MAX(v, ctrl) (v) = fmaxf((v), __int_as_float(__builtin_amdgcn_update_dpp(0, __float_as_int(v), (ctrl), 0xF, 0xF, false)))
__device__ __forceinline__ void peer_tables_to_fp4(const Frame& F, unsigned char* ws, const float* pu, const float* pv) {
    const bool ok = fp4_probe_ok();
    for (int r = F.gw; r < 2 * 16384; r += F.NGW) {
        const int tab = r >= 16384, row = r & 16383;
        const float* srow = (tab ? pv : pu) + (size_t)row * D;
        unsigned char* vals = ws + (tab ? WS_VB : WS_UB); float* rsc = (float*)(ws + (tab ? WS_VSC : WS_USC));
        float ss = 0.f, am = 0.f;
#pragma unroll
        for (int kh = 0; kh < 2; ++kh) { f32x4 v[8];
#pragma unroll
            for (int k8 = 0; k8 < 8; ++k8) v[k8] = *(const f32x4*)(srow + (kh * 8 + k8) * 256 + F.lane * 4);
#pragma unroll
            for (int k8 = 0; k8 < 8; ++k8) { ss += (v[k8][0] * v[k8][0] + v[k8][1] * v[k8][1]) + (v[k8][2] * v[k8][2] + v[k8][3] * v[k8][3]);
                am = fmaxf(am, fmaxf(fmaxf(fabsf(v[k8][0]), fabsf(v[k8][1])), fmaxf(fabsf(v[k8][2]), fabsf(v[k8][3])))); } }
        ss = wave_sum(ss);
        DPP_MAX(am, 0xB1); DPP_MAX(am, 0x4E); DPP_MAX(am, 0x141); DPP_MAX(am, 0x140);
        am = fmaxf(fmaxf(__int_as_float(__builtin_amdgcn_readlane(__float_as_int(am), 0)), __int_as_float(__builtin_amdgcn_readlane(__float_as_int(am), 16))),
                   fmaxf(__int_as_float(__builtin_amdgcn_readlane(__float_as_int(am), 32)), __int_as_float(__builtin_amdgcn_readlane(__float_as_int(am), 48))));
        const float top = fminf(am, 3.0f * sqrtf(ss * (1.0f / D)));
        const float sc = top > 0.f ? top * (1.0f / 6.0f) : 1.0f, inv = 1.0f / sc;
        if (F.lane == 0) rsc[row] = ok ? sc : __uint_as_float(0x7FC00000u);
#pragma unroll
        for (int kh = 0; kh < 2; ++kh) { f32x4 v[8];
#pragma unroll
            for (int k8 = 0; k8 < 8; ++k8) v[k8] = *(const f32x4*)(srow + (kh * 8 + k8) * 256 + F.lane * 4);
#pragma unroll
            for (int k8 = 0; k8 < 8; ++k8) { const int k = kh * 8 + k8;
                const float q0 = fminf(fmaxf(v[k8][0] * inv, -6.0f), 6.0f), q1 = fminf(fmaxf(v[k8][1] * inv, -6.0f), 6.0f), q2 = fminf(fmaxf(v[k8][2] * inv, -6.0f), 6.0f), q3 = fminf(fmaxf(v[k8][3] * inv, -6.0f), 6.0f);
                unsigned p = 0u;
                p = __builtin_amdgcn_cvt_scalef32_pk_fp4_f32(p, q0, q1, 1.0f, 0); p = __builtin_amdgcn_cvt_scalef32_pk_fp4_f32(p, q2, q3, 1.0f, 1);
                const size_t sl = (size_t)(k >> 1) * 16384 + row;
                *(unsigned short*)(vals + sl * 256 + (k & 1) * 128 + 2 * F.lane) = (unsigned short)p; } }
    }
}
#define CE_(a, b) do { const float hi_ = fmaxf(a, b), lo_ = fminf(a, b); a = hi_; b = lo_; } while (0)
__device__ __forceinline__ void sort16_desc(float (&v)[16]) {
    CE_(v[0], v[1]); CE_(v[2], v[3]); CE_(v[0], v[2]); CE_(v[1], v[3]); CE_(v[1], v[2]); CE_(v[4], v[5]); CE_(v[6], v[7]); CE_(v[4], v[6]); CE_(v[5], v[7]); CE_(v[5], v[6]); CE_(v[0], v[4]); CE_(v[2], v[6]); CE_(v[2], v[4]); CE_(v[1], v[5]); CE_(v[3], v[7]); CE_(v[3], v[5]); CE_(v[1], v[2]); CE_(v[3], v[4]); CE_(v[5], v[6]); CE_(v[8], v[9]); CE_(v[10], v[11]); CE_(v[8], v[10]); CE_(v[9], v[11]); CE_(v[9], v[10]); CE_(v[12], v[13]); CE_(v[14], v[15]); CE_(v[12], v[14]); CE_(v[13], v[15]); CE_(v[13], v[14]); CE_(v[8], v[12]); CE_(v[10], v[14]); CE_(v[10], v[12]); CE_(v[9], v[13]); CE_(v[11], v[15]); CE_(v[11], v[13]); CE_(v[9], v[10]); CE_(v[11], v[12]); CE_(v[13], v[14]); CE_(v[0], v[8]); CE_(v[4], v[12]); CE_(v[4], v[8]); CE_(v[2], v[10]); CE_(v[6], v[14]); CE_(v[6], v[10]); CE_(v[2], v[4]); CE_(v[6], v[8]); CE_(v[10], v[12]); CE_(v[1], v[9]); CE_(v[5], v[13]); CE_(v[5], v[9]); CE_(v[3], v[11]); CE_(v[7], v[15]); CE_(v[7], v[11]); CE_(v[3], v[5]); CE_(v[7], v[9]); CE_(v[11], v[13]); CE_(v[1], v[2]); CE_(v[3], v[4]); CE_(v[5], v[6]); CE_(v[7], v[8]); CE_(v[9], v[10]); CE_(v[11], v[12]); CE_(v[13], v[14]);
}
__device__ __forceinline__ void bitonic16_desc(float (&v)[16]) {
    CE_(v[0], v[8]); CE_(v[1], v[9]); CE_(v[2], v[10]); CE_(v[3], v[11]); CE_(v[4], v[12]); CE_(v[5], v[13]); CE_(v[6], v[14]); CE_(v[7], v[15]); CE_(v[0], v[4]); CE_(v[1], v[5]); CE_(v[2], v[6]); CE_(v[3], v[7]); CE_(v[8], v[12]); CE_(v[9], v[13]); CE_(v[10], v[14]); CE_(v[11], v[15]); CE_(v[0], v[2]); CE_(v[1], v[3]); CE_(v[4], v[6]); CE_(v[5], v[7]); CE_(v[8], v[10]); CE_(v[9], v[11]); CE_(v[12], v[14]); CE_(v[13], v[15]); CE_(v[0], v[1]); CE_(v[2], v[3]); CE_(v[4], v[5]); CE_(v[6], v[7]); CE_(v[8], v[9]); CE_(v[10], v[11]); CE_(v[12], v[13]); CE_(v[14], v[15]);
}

__device__ __forceinline__ void merge_top16(float (&a)[16], const float (&b)[16]) {
#pragma unroll
    for (int i = 0; i < 16; ++i) a[i] = fmaxf(a[i], b[15 - i]);
    bitonic16_desc(a);
}
__device__ __forceinline__ void top16_of_64(const float (&s)[64], float (&t)[16]) {
    float g1[16], g2[16], g3[16];
#pragma unroll
    for (int i = 0; i < 16; ++i) { t[i] = s[i]; g1[i] = s[16 + i]; g2[i] = s[32 + i]; g3[i] = s[48 + i]; }
    sort16_desc(t); sort16_desc(g1); sort16_desc(g2); sort16_desc(g3);
    merge_top16(t, g1); merge_top16(g2, g3); merge_top16(t, g2);
}
__device__ __forceinline__ void p12_keys_to_lds(const Frame& F, unsigned char* ws) {
    const bf16_t* keys = (const bf16_t*)(ws + WS_KEYS) + (size_t)(F.bid & 7) * 256 * 128;
#pragma unroll
    for (int i = 0; i < 8; ++i) { const int gch = F.tid + 512 * i, R = gch >> 4, c = gch & 15;
        *(LAS u32x4*)(F.lds + R * 256 + ((c ^ (R & 15)) * 16)) = *(const u32x4*)(keys + (size_t)R * 128 + c * 8); }
}
__device__ __forceinline__ void p12_topk(const Frame& F, unsigned char* ws) {
    const bf16_t* qp = (const bf16_t*)(ws + WS_QP); int* ids = (int*)(ws + WS_IDS); float* gates = (float*)(ws + WS_GATES);
    const float NEG = -__builtin_inff();
    const int ngrp = (F.G - 1 - (F.bid & 7)) / 8 + 1;
#pragma unroll 1
    for (int it = 0; ; ++it) {
        const int tg = ((F.bid >> 3) + it * ngrp) * 8 + F.wave; if (tg >= 512) break;
        int lane_ = F.lane; asm volatile("" : "+v"(lane_));
        const int tok = lane_ & 31, hi = lane_ >> 5;
        const int h = F.bid & 7, token = tg * 32 + tok;
        float top[2][16];
#pragma unroll
        for (int p = 0; p < 2; ++p) {
            bf16x8 qr[8];
#pragma unroll
            for (int d0 = 0; d0 < 8; ++d0) qr[d0] = *(const bf16x8*)(qp + (size_t)token * 2048 + h * 256 + p * 128 + d0 * 16 + hi * 8);
            float s[64];
#pragma unroll
            for (int kb = 0; kb < 4; ++kb) { f32x16 acc = {};
                const int R = p * 128 + kb * 32 + tok; const LAS unsigned char* kl = F.lds + R * 256;
#pragma unroll
                for (int d0 = 0; d0 < 8; ++d0) acc = __builtin_amdgcn_mfma_f32_32x32x16_bf16(*(const LAS bf16x8*)(kl + (((2 * d0 + hi) ^ (R & 15)) * 16)), qr[d0], acc, 0, 0, 0);
#pragma unroll
                for (int r = 0; r < 16; ++r) { const int idx = kb * 32 + (r & 3) + 8 * (r >> 2) + 4 * hi;
                    s[kb * 16 + r] = __uint_as_float((__float_as_uint(acc[r]) & ~0x7Fu) | (unsigned)(127 - idx)); } }
            float t[16]; top16_of_64(s, t);
            float pt[16];
#pragma unroll
            for (int i = 0; i < 16; ++i) { const unsigned own = __float_as_uint(t[i]); auto rr = __builtin_amdgcn_permlane32_swap(own, own, false, false); pt[i] = __uint_as_float(rr[0] ^ rr[1] ^ own); }
            merge_top16(t, pt);
#pragma unroll
            for (int i = 0; i < 16; ++i) top[p][i] = t[i];
        }
        float c[64], cs_[16];
#define CAND_(k, i, j) c[k] = __uint_as_float((__float_as_uint(top[0][i] + top[1][j]) & ~0xFFu) | (unsigned)(255 - ((i) * 16 + (j))))
        CAND_(0, 0, 0); CAND_(1, 0, 1); CAND_(2, 0, 2); CAND_(3, 0, 3); CAND_(4, 0, 4); CAND_(5, 0, 5); CAND_(6, 0, 6); CAND_(7, 0, 7); CAND_(8, 0, 8); CAND_(9, 0, 9); CAND_(10, 0, 10); CAND_(11, 0, 11); CAND_(12, 0, 12); CAND_(13, 0, 13); CAND_(14, 0, 14); CAND_(15, 0, 15); CAND_(16, 1, 0); CAND_(17, 1, 1); CAND_(18, 1, 2); CAND_(19, 1, 3); CAND_(20, 1, 4); CAND_(21, 1, 5); CAND_(22, 1, 6); CAND_(23, 1, 7); CAND_(24, 2, 0); CAND_(25, 2, 1); CAND_(26, 2, 2); CAND_(27, 2, 3); CAND_(28, 2, 4); CAND_(29, 3, 0); CAND_(30, 3, 1); CAND_(31, 3, 2); CAND_(32, 3, 3); CAND_(33, 4, 0); CAND_(34, 4, 1); CAND_(35, 4, 2); CAND_(36, 5, 0); CAND_(37, 5, 1); CAND_(38, 6, 0); CAND_(39, 6, 1); CAND_(40, 7, 0); CAND_(41, 7, 1); CAND_(42, 8, 0); CAND_(43, 9, 0); CAND_(44, 10, 0); CAND_(45, 11, 0); CAND_(46, 12, 0); CAND_(47, 13, 0); CAND_(48, 14, 0); CAND_(49, 15, 0);
#undef CAND_
#pragma unroll
        for (int k = 50; k < 64; ++k) c[k] = NEG;
        top16_of_64(c, cs_);
        int ex[16];
#pragma unroll
        for (int k = 0; k < 16; ++k) { const int flat = 255 - (int)(__float_as_uint(cs_[k]) & 0xFFu), ci = flat >> 4, cj = flat & 15;
            float t0 = top[0][0], t1 = top[1][0];
#pragma unroll
            for (int t = 1; t < 16; ++t) { t0 = (ci == t) ? top[0][t] : t0; t1 = (cj == t) ? top[1][t] : t1; }
            const int i1 = 127 - (int)(__float_as_uint(t0) & 0x7Fu), i2 = 127 - (int)(__float_as_uint(t1) & 0x7Fu);
            ex[k] = i1 * 128 + i2; }
        float den = 0.f, ev[16];
#pragma unroll
        for (int k = 0; k < 16; ++k) { ev[k] = __expf(cs_[k] - cs_[0]); den += ev[k]; }
        const float rden = 1.0f / den;
        const size_t ob = ((size_t)token * 8 + h) * 16;
        if (hi == 0) {
#pragma unroll
            for (int k4 = 0; k4 < 4; ++k4) *(int4*)(ids + ob + k4 * 4) = make_int4(ex[k4 * 4], ex[k4 * 4 + 1], ex[k4 * 4 + 2], ex[k4 * 4 + 3]); }
        else {
#pragma unroll
            for (int k4 = 0; k4 < 4; ++k4) *(f32x4*)(gates + ob + k4 * 4) = (f32x4){ev[k4 * 4] * rden, ev[k4 * 4 + 1] * rden, ev[k4 * 4 + 2] * rden, ev[k4 * 4 + 3] * rden}; }
    }
}
__device__ __forceinline__ float gelu_erf(float v) {
    const float av = fabsf(v), t = __builtin_amdgcn_rcpf(fmaf(av, 0.2316418882f, 1.0f));
    float q = fmaf(t, 0.5307027145f, -0.7265760135f); q = fmaf(q, t, 0.7107068705f); q = fmaf(q, t, -0.142248368f); q = fmaf(q, t, 0.127414796f); q = q * t;
    const float e = __builtin_amdgcn_exp2f(v * v * -0.72134752044f), m = v * (q * e);
    return v < 0.f ? m : v - m;
}
struct PRow { u32x4 v; };
#define ROW16_ADD(v) do { DPP_ADD(v, 0xB1, 0xF); DPP_ADD(v, 0x4E, 0xF); DPP_ADD(v, 0x141, 0xF); DPP_ADD(v, 0x140, 0xF); } while (0)
#define PW_LOAD(W, q0, idp, vb, sb) do { const u32x4 ia_ = *(const LAS u32x4*)((idp) + (q0)), ib_ = *(const LAS u32x4*)((idp) + (q0) + 4); \
        _Pragma("unroll") for (int r_ = 0; r_ < 8; ++r_) { const unsigned id_ = r_ < 4 ? ia_[r_ & 3] : ib_[r_ & 3]; \
            W[r_].v = *(const u32x4*)((vb) + ((id_ << 8) + i16)); } } while (0)
#define PD_COMP(W, q0, ap) do { const u32x4 ta1_ = *(const LAS u32x4*)((ap) + (q0)), tb1_ = *(const LAS u32x4*)((ap) + (q0) + 4), tas_ = *(const LAS u32x4*)((ap) + 256 + (q0)), tbs_ = *(const LAS u32x4*)((ap) + 256 + (q0) + 4); \
        _Pragma("unroll") for (int r_ = 0; r_ < 8; ++r_) { const unsigned d1_ = r_ < 4 ? ta1_[r_ & 3] : tb1_[r_ & 3]; const int s1_ = (int)(r_ < 4 ? tas_[r_ & 3] : tbs_[r_ & 3]); \
            const i32x8 A8_ = {(int)W[r_].v.x, (int)W[r_].v.y, (int)W[r_].v.z, (int)W[r_].v.w, 0, 0, 0, 0}; \
            if (r_ & 1) { Q1a[0] = (int)(d1_ & mlo); Q1a[1] = (int)(d1_ & mhi); Q1b[2] = Q1a[0]; Q1b[3] = Q1a[1]; \
                y[2] = __builtin_amdgcn_mfma_scale_f32_16x16x128_f8f6f4(A8_, Q1a, y[2], 4, 4, 0, 127, 0, s1_); y[3] = __builtin_amdgcn_mfma_scale_f32_16x16x128_f8f6f4(A8_, Q1b, y[3], 4, 4, 0, 127, 0, s1_); } \
            else { P1a[0] = (int)(d1_ & mlo); P1a[1] = (int)(d1_ & mhi); P1b[2] = P1a[0]; P1b[3] = P1a[1]; \
                y[0] = __builtin_amdgcn_mfma_scale_f32_16x16x128_f8f6f4(A8_, P1a, y[0], 4, 4, 0, 127, 0, s1_); y[1] = __builtin_amdgcn_mfma_scale_f32_16x16x128_f8f6f4(A8_, P1b, y[1], 4, 4, 0, 127, 0, s1_); } } \
        __builtin_amdgcn_sched_barrier(0); } while (0)
#define BF_LO(w) __uint_as_float((w) << 16)
#define BF_HI(w) __uint_as_float((w) & 0xffff0000u)
#define FP4X2(q, k) __builtin_amdgcn_cvt_scalef32_pk_f32_fp4((q), 1.0f, (k))
__device__ __forceinline__ void p12c_quant(const Frame& F, unsigned char* ws, const float* g_ffn) {
    const bf16_t* h2b = (const bf16_t*)(ws + WS_H2B); unsigned char* xq = ws + WS_XQ; unsigned char* xsc = ws + WS_XQS;
    const bool ok = fp4_probe_ok();
#pragma unroll 1
    for (int token = F.gw; token < M; token += F.NGW) {
        int lane_ = F.lane; asm volatile("" : "+v"(lane_)); const int lane = lane_;
#pragma unroll
        for (int blk = 0; blk < 2; ++blk) { const int c0 = 64 * lane + 32 * blk;
            float v[32];
#pragma unroll
            for (int m = 0; m < 4; ++m) { const u32x4 hw = *(const u32x4*)(h2b + (size_t)token * D + c0 + 8 * m); const f32x4 g0 = *(const f32x4*)(g_ffn + c0 + 8 * m), g1 = *(const f32x4*)(g_ffn + c0 + 8 * m + 4);
                v[8 * m + 0] = BF_LO(hw.x) * g0[0]; v[8 * m + 1] = BF_HI(hw.x) * g0[1]; v[8 * m + 2] = BF_LO(hw.y) * g0[2]; v[8 * m + 3] = BF_HI(hw.y) * g0[3];
                v[8 * m + 4] = BF_LO(hw.z) * g1[0]; v[8 * m + 5] = BF_HI(hw.z) * g1[1]; v[8 * m + 6] = BF_LO(hw.w) * g1[2]; v[8 * m + 7] = BF_HI(hw.w) * g1[3]; }
#pragma unroll
            for (int term = 0; term < 2; ++term) { float am = 0.f;
#pragma unroll
                for (int k = 0; k < 32; ++k) am = fmaxf(am, fabsf(v[k]));
                const unsigned rb = __float_as_uint(am * (1.0f / 6.0f));
                int e = (int)(rb >> 23) - 127 + ((rb & 0x7FFFFFu) != 0u ? 1 : 0); e = e < -120 ? -120 : (e > 120 ? 120 : e);
                const float inv = __uint_as_float((unsigned)(127 - e) << 23), sc = __uint_as_float((unsigned)(127 + e) << 23);
                unsigned w[4];
#pragma unroll
                for (int k = 0; k < 4; ++k) { unsigned d = 0u;
                    d = __builtin_amdgcn_cvt_scalef32_pk_fp4_f32(d, v[8 * k] * inv, v[8 * k + 1] * inv, 1.0f, 0); d = __builtin_amdgcn_cvt_scalef32_pk_fp4_f32(d, v[8 * k + 2] * inv, v[8 * k + 3] * inv, 1.0f, 1);
                    d = __builtin_amdgcn_cvt_scalef32_pk_fp4_f32(d, v[8 * k + 4] * inv, v[8 * k + 5] * inv, 1.0f, 2); d = __builtin_amdgcn_cvt_scalef32_pk_fp4_f32(d, v[8 * k + 6] * inv, v[8 * k + 7] * inv, 1.0f, 3);
                    w[k] = d;
                    if (term == 0) { const f32x2 y0 = FP4X2(d, 0), y1 = FP4X2(d, 1), y2 = FP4X2(d, 2), y3 = FP4X2(d, 3);
                        v[8 * k] -= y0.x * sc; v[8 * k + 1] -= y0.y * sc; v[8 * k + 2] -= y1.x * sc; v[8 * k + 3] -= y1.y * sc; v[8 * k + 4] -= y2.x * sc; v[8 * k + 5] -= y2.y * sc; v[8 * k + 6] -= y3.x * sc; v[8 * k + 7] -= y3.y * sc; } }
                *(u32x4*)(xq + (size_t)term * M * 2048 + (size_t)token * 2048 + c0 / 2) = (u32x4){w[0], w[1], w[2], w[3]};
                xsc[(size_t)term * M * 128 + (size_t)token * 128 + 2 * lane + blk] = (unsigned char)(ok ? (unsigned)(e + 127) : 255u); }
        }
    }
}
typedef int i32x8 __attribute__((ext_vector_type(8)));
#define UG_LOAD(SB, TB, CB, idp) do { _Pragma("unroll") for (int tt_ = 0; tt_ < 4; ++tt_) _Pragma("unroll") for (int h_ = 0; h_ < 2; ++h_) { const unsigned id_ = (idp)[16 * ((TB) + tt_) + 8 * h_]; \
        __builtin_amdgcn_global_load_lds((const unsigned*)(uvj + ((id_ << 8) + 64u * (CB) + gsw16)), (LAS unsigned*)(slots + ((SB) + tt_ * 2 + h_) * 1024), 16, 0, 0); } \
        __builtin_amdgcn_sched_barrier(0); } while (0)
#define BPERM(v) ((unsigned)__builtin_amdgcn_ds_bpermute(pa, (int)(v)))
#define UG_COMP(SB, TB, CB, xp, NV) do { asm volatile("s_waitcnt vmcnt(" #NV ")" ::: "memory"); __builtin_amdgcn_sched_barrier(0); \
        u32x4 P_[8]; _Pragma("unroll") for (int tt_ = 0; tt_ < 4; ++tt_) { P_[tt_ * 2] = *(const LAS u32x4*)(slots + ((SB) + tt_ * 2) * 1024 + rdo0); P_[tt_ * 2 + 1] = *(const LAS u32x4*)(slots + ((SB) + tt_ * 2) * 1024 + rdo1); } \
        _Pragma("unroll") for (int cc_ = 0; cc_ < 2; ++cc_) { const int c_ = (CB) + cc_; \
            const u32x4 b0_ = *(const LAS u32x4*)((xp) + 64 * c_), b1_ = *(const LAS u32x4*)((xp) + 256 + 64 * c_); \
            const int s0_ = (int)*(const LAS unsigned char*)((xp) + 512 + 4 * c_ - 15 * kq), s1_ = (int)*(const LAS unsigned char*)((xp) + 528 + 4 * c_ - 15 * kq); \
            const i32x8 x0_ = {(int)b0_.x, (int)b0_.y, (int)b0_.z, (int)b0_.w, 0, 0, 0, 0}, x1_ = {(int)b1_.x, (int)b1_.y, (int)b1_.z, (int)b1_.w, 0, 0, 0, 0}; \
            _Pragma("unroll") for (int tt_ = 0; tt_ < 4; ++tt_) { const u32x4 q_ = P_[tt_ * 2 + cc_]; const i32x8 A8_ = {(int)q_.x, (int)q_.y, (int)q_.z, (int)q_.w, 0, 0, 0, 0}; \
                dacc[(TB) + tt_] = __builtin_amdgcn_mfma_scale_f32_16x16x128_f8f6f4(A8_, x0_, dacc[(TB) + tt_], 4, 4, 0, 127, 0, s0_); } \
            _Pragma("unroll") for (int tt_ = 0; tt_ < 4; ++tt_) { const u32x4 q_ = P_[tt_ * 2 + cc_]; const i32x8 A8_ = {(int)q_.x, (int)q_.y, (int)q_.z, (int)q_.w, 0, 0, 0, 0}; \
                dacc[(TB) + tt_] = __builtin_amdgcn_mfma_scale_f32_16x16x128_f8f6f4(A8_, x1_, dacc[(TB) + tt_], 4, 4, 0, 127, 0, s1_); } } \
        __builtin_amdgcn_sched_barrier(0); } while (0)
__device__ __forceinline__ void p13a_up(const Frame& F, unsigned char* ws) {
    const int j = F.xj, lw = F.xrank * NWAVES + F.wave, nw = F.xn * NWAVES;
    int lane_ = F.lane; asm volatile("" : "+v"(lane_));
    const int lane = lane_, r = lane & 15, kq = lane >> 4, ge = lane >> 2; const unsigned gp4 = 4u * (unsigned)(lane & 3), l4 = 4u * (unsigned)lane;
    const unsigned gsw16 = 16u * (unsigned)((lane & 7) ^ ((lane >> 3) & 6));
    const int rdo0 = (r >> 3) * 1024 + 128 * (r & 7) + 16 * (kq ^ (r & 6)), rdo1 = (r >> 3) * 1024 + 128 * (r & 7) + 16 * ((4 + kq) ^ (r & 6));
    const unsigned char* uvj = ws + WS_UB + (size_t)j * 16384 * 256; const unsigned char* usj = ws + WS_UB + PEER_VAL_BYTES + (size_t)j * 16384 * 16;
    const unsigned char* ids = ws + WS_IDS;
    const unsigned char* xq = ws + WS_XQ + (size_t)(lane >> 5) * M * 2048 + 256 * j + 8 * (lane & 31);
    const unsigned char* xsc = ws + WS_XQS + (size_t)((lane >> 4) & 1) * M * 128 + 16 * j + (lane & 15);
    float* pd = (float*)(ws + WS_PD) + (size_t)j * M * 128 + 4 * kq;
    LAS unsigned char* wl = F.lds + XSTG_OFF + F.wave * 2304; LAS unsigned char* slots = F.lds + F.wave * 16384;
    int t = lw; if (t >= M) return;
    { LAS unsigned* il = (LAS unsigned*)wl; const unsigned char* ip = ids + (size_t)t * 512; il[lane] = *(const unsigned*)(ip + l4); il[64 + lane] = *(const unsigned*)(ip + 256 + l4);
      *(LAS u32x2*)(wl + 512 + 8 * lane) = *(const u32x2*)(xq + (size_t)t * 2048); if (lane < 32) wl[1024 + lane] = xsc[(size_t)t * 128]; }
    UG_LOAD(0, 0, 0, (const LAS unsigned*)wl + (lane >> 3));
    asm volatile("s_waitcnt vmcnt(0)" ::: "memory");
    int buf = 0;
#pragma unroll 1
    for (; t < M; t += nw) {
        const int tn = (t + nw < M) ? t + nw : t;
        const LAS unsigned char* cb = wl + buf * 1152; LAS unsigned char* nb = wl + (buf ^ 1) * 1152;
        const LAS unsigned* idc = (const LAS unsigned*)cb + (lane >> 3); const LAS unsigned char* xc = cb + 512 + 16 * kq;
        const unsigned char* ip = ids + (size_t)tn * 512; const unsigned idn0 = *(const unsigned*)(ip + l4), idn1 = *(const unsigned*)(ip + 256 + l4);
        const u32x2 xn = *(const u32x2*)(xq + (size_t)tn * 2048); const unsigned char sn = xsc[(size_t)tn * 128];
        __builtin_amdgcn_sched_barrier(0);
        f32x4 dacc[8];
#pragma unroll
        for (int T = 0; T < 8; ++T) dacc[T] = (f32x4){0.f, 0.f, 0.f, 0.f};
        UG_LOAD(8, 4, 0, idc); UG_COMP(0, 0, 0, xc, 8);
        UG_LOAD(0, 0, 2, idc); UG_COMP(8, 4, 0, xc, 8);
        { LAS unsigned* il = (LAS unsigned*)nb; il[lane] = idn0; il[64 + lane] = idn1; *(LAS u32x2*)(nb + 512 + 8 * lane) = xn; if (lane < 32) nb[1024 + lane] = sn; }
        UG_LOAD(8, 4, 2, idc); UG_COMP(0, 0, 2, xc, 8);
        UG_LOAD(0, 0, 0, (const LAS unsigned*)nb + (lane >> 3));
        UG_COMP(8, 4, 2, xc, 8);
#pragma unroll
        for (int T = 0; T < 8; ++T) asm volatile("" : "+v"(dacc[T]));
        if (r == 0) {
#pragma unroll
            for (int T = 0; T < 8; ++T) *(f32x4*)(pd + (size_t)t * 128 + 16 * T) = dacc[T]; }
        buf ^= 1;
    }
}
__device__ __forceinline__ unsigned fp4_code_scale(float v, float& back) {
    const unsigned rb = __float_as_uint(fabsf(v) * (1.0f / 6.0f));
    int e = (int)(rb >> 23) - 127 + ((rb & 0x7FFFFFu) != 0u ? 1 : 0); e = e < -120 ? -120 : (e > 120 ? 120 : e);
    const float inv = __uint_as_float((unsigned)(127 - e) << 23), sc = __uint_as_float((unsigned)(127 + e) << 23);
    const unsigned by = __builtin_amdgcn_cvt_scalef32_pk_fp4_f32(0u, v * inv, v * inv, 1.0f, 0);
    const f32x2 dd = FP4X2(by, 0); back = dd.x * sc;
    return (by & 0xFu) | ((unsigned)(e + 127) << 8);
}
__device__ __forceinline__ void p13b_act(const Frame& F, unsigned char* ws) {
    const float* pd = (const float*)(ws + WS_PD); float* gates = (float*)(ws + WS_GATES); const float* ssq2 = (const float*)(ws + WS_SSQ2); unsigned* act = (unsigned*)(ws + WS_ACT);
    const int* ids = (const int*)(ws + WS_IDS); const float* usc = (const float*)(ws + WS_USC); const float* vsc = (const float*)(ws + WS_VSC);
    const bool ok = fp4_probe_ok();
#pragma unroll 1
    for (int token = F.gw; token < M; token += F.NGW) {
        const float r2 = 1.0f / sqrtf(wave_sum(ssq2[(size_t)token * 64 + F.lane]) * (1.0f / D) + EPS);
#pragma unroll
        for (int hh = 0; hh < 2; ++hh) { const size_t o = (size_t)token * 128 + hh * 64 + F.lane; float d = 0.f;
#pragma unroll
            for (int jj = 0; jj < 8; ++jj) d += pd[(size_t)jj * M * 128 + o];
            const int id = ids[o];
            const float a = gelu_erf(d * r2 * usc[id]) * gates[o] * vsc[id];
            float b1; const unsigned t1 = fp4_code_scale(a, b1);
            act[o] = (t1 & 0xFu) * 0x11111111u;
            act[(size_t)M * 128 + o] = ok ? ((t1 >> 8) & 0xFFu) : 0xFFu; }
    }
}
__device__ __forceinline__ void p13c_down(const Frame& F, unsigned char* ws) {
    const int j = F.xj, lw = F.xrank * NWAVES + F.wave, nw = F.xn * NWAVES;
    int lane_ = F.lane; asm volatile("" : "+v"(lane_));
    const int lane = lane_, g = lane >> 4, i = lane & 15; const unsigned i16 = 16u * (unsigned)i, sidx = (unsigned)((i & 3) * 4 + (i >> 2)), l4 = 4u * (unsigned)lane;
    const unsigned sh = 4u * (unsigned)(i & 7), mlo = i < 8 ? (0xFu << sh) : 0u, mhi = i >= 8 ? (0xFu << sh) : 0u;
    i32x8 P1a = {0, 0, 0, 0, 0, 0, 0, 0}, P1b = P1a, Q1a = P1a, Q1b = P1a;
    const unsigned char* vvj = ws + WS_VB + (size_t)j * 16384 * 256; const unsigned char* vsj = ws + WS_VB + PEER_VAL_BYTES + (size_t)j * 16384 * 16;
    const unsigned char* ids = ws + WS_IDS; const unsigned char* av = ws + WS_ACT;
    const bf16_t* h2b = (const bf16_t*)(ws + WS_H2B) + 512 * j + 128 * g + i; bf16_t* h3b = (bf16_t*)(ws + WS_H3B) + 512 * j + 128 * g + i; float* ssq3 = (float*)(ws + WS_SSQ3);
    LAS unsigned* idl = (LAS unsigned*)(F.lds + F.wave * 4096);
    LAS unsigned* al = idl + 256;
    constexpr size_t ASTR = (size_t)M * 128 * 4;
    int t = lw; if (t >= M) return;
    { const unsigned char* ip = ids + (size_t)t * 512; const unsigned char* ap = av + (size_t)t * 512;
      idl[lane] = *(const unsigned*)(ip + l4); idl[64 + lane] = *(const unsigned*)(ip + 256 + l4);
#pragma unroll
      for (int k = 0; k < 2; ++k) { al[256 * k + lane] = *(const unsigned*)(ap + k * ASTR + l4); al[256 * k + 64 + lane] = *(const unsigned*)(ap + k * ASTR + 256 + l4); } }
    PRow A[8], B[8];
    PW_LOAD(A, 0, idl + 32 * g, vvj, vsj);
    int buf = 0;
#pragma unroll 1
    for (; t < M; t += nw) {
        const int tn = (t + nw < M) ? t + nw : t;
        const LAS unsigned* cur = idl + buf * 128 + 32 * g; LAS unsigned* nxt = idl + (buf ^ 1) * 128;
        const LAS unsigned* acur = al + buf * 128 + 32 * g; LAS unsigned* anxt = al + (buf ^ 1) * 128;
        const unsigned char* ip = ids + (size_t)tn * 512; const unsigned char* ap = av + (size_t)tn * 512;
        const unsigned idn0 = *(const unsigned*)(ip + l4), idn1 = *(const unsigned*)(ip + 256 + l4);
        unsigned an[4];
#pragma unroll
        for (int k = 0; k < 2; ++k) { an[2 * k] = *(const unsigned*)(ap + k * ASTR + l4); an[2 * k + 1] = *(const unsigned*)(ap + k * ASTR + 256 + l4); }
        unsigned short hq[8];
#pragma unroll
        for (int k = 0; k < 8; ++k) hq[k] = h2b[(size_t)t * D + 32 * (k & 3) + 16 * (k >> 2)];
        f32x4 y[4];
#pragma unroll
        for (int k = 0; k < 4; ++k) y[k] = (f32x4){0.f, 0.f, 0.f, 0.f};
        PW_LOAD(B, 8, cur, vvj, vsj); PD_COMP(A, 0, acur);
        PW_LOAD(A, 16, cur, vvj, vsj); PD_COMP(B, 8, acur);
        nxt[lane] = idn0; nxt[64 + lane] = idn1;
#pragma unroll
        for (int k = 0; k < 2; ++k) { anxt[256 * k + lane] = an[2 * k]; anxt[256 * k + 64 + lane] = an[2 * k + 1]; }
        PW_LOAD(B, 24, cur, vvj, vsj); PD_COMP(A, 16, acur);
        PW_LOAD(A, 0, nxt + 32 * g, vvj, vsj);
        PD_COMP(B, 24, acur);
        const f32x4 Y0 = y[0] + y[2], Y1 = y[1] + y[3];
        const float h0 = bf2f(hq[0]) + Y0[0], h1 = bf2f(hq[1]) + Y0[1], h2 = bf2f(hq[2]) + Y0[2], h3 = bf2f(hq[3]) + Y0[3];
        const float h4 = bf2f(hq[4]) + Y1[0], h5 = bf2f(hq[5]) + Y1[1], h6 = bf2f(hq[6]) + Y1[2], h7 = bf2f(hq[7]) + Y1[3];
        { bf16_t* op = h3b + (size_t)t * D;
          op[0] = (bf16_t)(cvt_pk_bf16(h0, h0) & 0xffffu); op[32] = (bf16_t)(cvt_pk_bf16(h1, h1) & 0xffffu); op[64] = (bf16_t)(cvt_pk_bf16(h2, h2) & 0xffffu); op[96] = (bf16_t)(cvt_pk_bf16(h3, h3) & 0xffffu);
          op[16] = (bf16_t)(cvt_pk_bf16(h4, h4) & 0xffffu); op[48] = (bf16_t)(cvt_pk_bf16(h5, h5) & 0xffffu); op[80] = (bf16_t)(cvt_pk_bf16(h6, h6) & 0xffffu); op[112] = (bf16_t)(cvt_pk_bf16(h7, h7) & 0xffffu); }
        const float ss = wave_sum(((h0 * h0 + h1 * h1) + (h2 * h2 + h3 * h3)) + ((h4 * h4 + h5 * h5) + (h6 * h6 + h7 * h7)));
        if (lane == 0) ssq3[(size_t)t * 8 + j] = ss;
        buf ^= 1;
    }
}
__device__ __forceinline__ void p13d_final(const Frame& F, unsigned char* ws, const float* g_final, float* out) {
    const bf16_t* h3b = (const bf16_t*)(ws + WS_H3B); const float* ssq3 = (const float*)(ws + WS_SSQ3);
#pragma unroll 1
    for (int token = F.gw; token < M; token += F.NGW) {
        int lane_ = F.lane; asm volatile("" : "+v"(lane_)); const int lane = lane_;
        const float rf = 1.0f / sqrtf(wave_sum(lane < 8 ? ssq3[(size_t)token * 8 + lane] : 0.f) * (1.0f / D) + EPS);
        u32x4 hv[8];
#pragma unroll
        for (int p = 0; p < 8; ++p) hv[p] = *(const u32x4*)(h3b + (size_t)token * D + p * 512 + lane * 8);
#pragma unroll
        for (int p = 0; p < 8; ++p) { const f32x4 g0 = *(const f32x4*)(g_final + p * 512 + lane * 8), g1 = *(const f32x4*)(g_final + p * 512 + lane * 8 + 4);
            float* op = out + (size_t)token * D + p * 512 + lane * 8;
            *(f32x4*)op = (f32x4){BF_LO(hv[p].x) * rf * g0[0], BF_HI(hv[p].x) * rf * g0[1], BF_LO(hv[p].y) * rf * g0[2], BF_HI(hv[p].y) * rf * g0[3]};
            *(f32x4*)(op + 4) = (f32x4){BF_LO(hv[p].z) * rf * g1[0], BF_HI(hv[p].z) * rf * g1[1], BF_LO(hv[p].w) * rf * g1[2], BF_HI(hv[p].w) * rf * g1[3]}; }
    }
}

__device__ __forceinline__ void final_norm_rows(const Frame& F, const float* h, const float* g, float* out) {
    for (int m = F.gw; m < M; m += F.NGW) {
        const f32x4* xr = (const f32x4*)(h + (size_t)m * D); const f32x4* gr = (const f32x4*)g; f32x4* xo = (f32x4*)(out + (size_t)m * D);
        f32x4 v[16]; float ss = 0.f;
#pragma unroll
        for (int j = 0; j < 16; ++j) v[j] = xr[F.lane + 64 * j];
#pragma unroll
        for (int j = 0; j < 16; ++j) ss += (v[j][0] * v[j][0] + v[j][1] * v[j][1]) + (v[j][2] * v[j][2] + v[j][3] * v[j][3]);
        ss = wave_sum(ss); const float r = 1.0f / sqrtf(ss * (1.0f / D) + EPS);
#pragma unroll
        for (int j = 0; j < 16; ++j) xo[F.lane + 64 * j] = v[j] * r * gr[F.lane + 64 * j];
    }
}

__global__ void __launch_bounds__(NTHREADS, 2) mega_fwd(Args args) {
    extern __shared__ __attribute__((aligned(16))) unsigned char lds_raw[];
    Frame F;
    F.lds = (LAS unsigned char*)lds_raw;
    F.tid = threadIdx.x; F.lane = F.tid & 63; F.wave = __builtin_amdgcn_readfirstlane(F.tid >> 6);
    F.G = gridDim.x; F.bid = blockIdx.x; F.gw = F.bid * NWAVES + F.wave; F.NGW = F.G * NWAVES;
    volatile LAS unsigned* MISC = (volatile LAS unsigned*)(F.lds + MISC_OFF);
    if (F.tid < 16) MISC[F.tid] = 0u;
    __syncthreads();
    XcdBarrier bar = xcd_barrier_post((unsigned*)(args.ws + WS_CTL), MISC + 8);
    const int lo = args.ph_lo, hi = args.ph_hi;
#define IN(k) (lo <= (k) && (k) < hi)
#define BOTH(k) (IN(k) && IN((k) + 1))
#define GRID_BAR() xcd_barrier(bar)

    unsigned char* ws = args.ws;
#define GEMM(KINDS, k) gemm_run<KINDS>(F.lds, args.in[0], args.out, ws, (k), F.G, F.bid)
    if (IN(0)) { p0_prologue(F, args); if (BOTH(0)) GRID_BAR(); }
    if (IN(1)) {
#pragma unroll 1
        for (int gi = 0; gi < 3; ++gi) GEMM(3, gi);
        if (BOTH(1)) GRID_BAR(); }
    if (IN(2)) { p2_stats(F, ws); p2_gla_prep(F, ws, args.in[11], args.in[12]); if (BOTH(2)) GRID_BAR(); }
    if (IN(3)) {
#pragma unroll 1
        for (int gi = 3; gi < 5; ++gi) GEMM(1, gi);
        p3_gla_att(F, ws);
        if (BOTH(3)) GRID_BAR(); }
    if (IN(4)) { p4_mla(F, ws);   }
    if (IN(5)) { p5_gla_scan(F, ws); if (BOTH(5)) GRID_BAR(); }
    if (IN(6)) { p6_mix(F, ws, args.in[10], args.in[13]); if (BOTH(6)) GRID_BAR(); }
    if (IN(7)) {
        GEMM(4, 5);
        if (BOTH(7)) GRID_BAR(); }
    if (IN(8)) {
        { pg8::StaticOrder S; S.init(M, 1024, F.G, F.bid); rstd_for_units(F, S, (const float*)(ws + WS_SSQ1), (float*)(ws + WS_RSTD1)); }
        GEMM(1, 6);
        if (BOTH(8)) GRID_BAR(); }
    if (IN(9)) { p9_xattn(F, ws); if (BOTH(9)) GRID_BAR(); }
    if (IN(10)) {
        GEMM(4, 7);
        if (BOTH(10)) GRID_BAR(); }
    if (IN(11)) {
        { pg8::StaticOrder S; S.init(M, 2048, F.G, F.bid); rstd_for_units(F, S, (const float*)(ws + WS_SSQ2), (float*)(ws + WS_RSTD2)); }
        GEMM(1, 8);
        p12c_quant(F, ws, args.in[20]);
        if (BOTH(11)) GRID_BAR(); }
    if (IN(12)) {
        p12_keys_to_lds(F, ws); __syncthreads();
#pragma unroll 1
        for (int s = 0; s < 2; ++s) { if (((s ^ (F.wave >> 2)) & 1) != 0) peer_tables_to_fp4(F, ws, args.in[23], args.in[24]); else p12_topk(F, ws); }
        if (BOTH(12)) GRID_BAR(); }
    if (IN(13)) {
        { const unsigned nx = MISC[9], nloc = MISC[8], rk = MISC[10];
          const bool hw = (nx == 8u) && (bar.x < 8u) && (nloc > 0u) && (lo < 13);
          F.xj = hw ? (int)bar.x : (F.bid & 7); F.xrank = hw ? (int)rk : (F.bid >> 3); F.xn = hw ? (int)nloc : ((F.G - 1 - (F.bid & 7)) / 8 + 1); }
        p13a_up(F, ws); GRID_BAR(); p13b_act(F, ws); GRID_BAR(); p13c_down(F, ws); GRID_BAR(); p13d_final(F, ws, args.in[25], args.out);
    }
#undef GEMM
#undef IN
#undef BOTH
}

extern "C" void kernel_launch(void* const* d_in, const int* in_sizes, int n_in, void* d_out, int out_size, void* d_ws, size_t ws_size, hipStream_t stream) {
    static int grid = 0;
    if (grid == 0) {
        if (n_in != 26 || out_size != M * D || ws_size < WS_END0) { fprintf(stderr, "kernel_launch: unexpected problem (n_in %d out %d ws %zu need %zu)\n", n_in, out_size, ws_size, (size_t)WS_END0); grid = -1; return; }
        int dev = 0, cus = 0, per_cu = 0;
        if (hipGetDevice(&dev) != hipSuccess || hipDeviceGetAttribute(&cus, hipDeviceAttributeMultiprocessorCount, dev) != hipSuccess) { grid = -1; return; }
        if (hipFuncSetAttribute((const void*)mega_fwd, hipFuncAttributeMaxDynamicSharedMemorySize, LDS_BYTES) != hipSuccess) { fprintf(stderr, "kernel_launch: hipFuncSetAttribute failed\n"); grid = -1; return; }
        if (hipOccupancyMaxActiveBlocksPerMultiprocessor(&per_cu, (const void*)mega_fwd, NTHREADS, LDS_BYTES) != hipSuccess || per_cu < 1) { fprintf(stderr, "kernel_launch: occupancy query says %d\n", per_cu); }
        (void)hipGetLastError();
        if (cus < 8) { fprintf(stderr, "kernel_launch: needs at least 8 CUs\n"); grid = -1; return; }
        grid = cus;
    }
    if (grid < 0) return;
    (void)hipMemsetAsync((char*)d_ws + WS_CTL, 0, CTL_BYTES, stream);
    Args a{};
    for (int i = 0; i < 26; ++i) a.in[i] = (const float*)d_in[i];
    a.out = (float*)d_out; a.ws = (unsigned char*)d_ws; a.ph_lo = 0; a.ph_hi = 14;
    hipLaunchKernelGGL(mega_fwd, dim3(grid), dim3(NTHREADS), LDS_BYTES, stream, a);
}
```

```cpp
#include <hip/hip_runtime.h>
#include <cstdio>
#include <cstdint>

#define LAS __attribute__((address_space(3)))
typedef unsigned short bf16_t;
typedef short bf16x8 __attribute__((ext_vector_type(8)));
typedef short s16x4 __attribute__((ext_vector_type(4)));
typedef float f32x4 __attribute__((ext_vector_type(4)));
typedef float f32x16 __attribute__((ext_vector_type(16)));
typedef unsigned u32x4 __attribute__((ext_vector_type(4)));
typedef unsigned u32x2 __attribute__((ext_vector_type(2)));

constexpr int D = 4096, NB = 2, SEQ = 8192, M = NB * SEQ;
constexpr float EPS = 1e-6f;
constexpr int MEMT = 256, MROWS = NB * MEMT;
constexpr int IN_W = 7760, IN_WP = 7936;
constexpr int NWAVES = 8, NTHREADS = 512;

constexpr size_t al256(size_t x) { return (x + 255) & ~(size_t)255; }
constexpr size_t WS_CTL = 0, CTL_BYTES = 65536;
constexpr size_t WS_WIN = WS_CTL + CTL_BYTES;
constexpr size_t WS_WUQ = WS_WIN + (size_t)IN_WP * D * 2;
constexpr size_t WS_WUKV = WS_WUQ + (size_t)3072 * 1024 * 2;
constexpr size_t WS_WOUT = WS_WUKV + (size_t)4096 * 512 * 2;
constexpr size_t WS_WCQ = WS_WOUT + (size_t)D * D * 2;
constexpr size_t WS_WCK = WS_WCQ + (size_t)1024 * D * 2;
constexpr size_t WS_WCV = WS_WCK + (size_t)1024 * D * 2;
constexpr size_t WS_WCO = WS_WCV + (size_t)1024 * D * 2;
constexpr size_t WS_WPQ = WS_WCO + (size_t)D * 1024 * 2;
constexpr size_t WS_KEYS = WS_WPQ + (size_t)2048 * D * 2;
constexpr size_t WS_MN = WS_KEYS + (size_t)8 * 2 * 128 * 128 * 2;
constexpr size_t WS_KC = WS_MN + (size_t)MROWS * D * 2;
constexpr size_t WS_VC = WS_KC + (size_t)MROWS * 1024 * 2;
constexpr size_t WS_ROPE = WS_VC + (size_t)MROWS * 1024 * 2;
constexpr size_t WS_RSTDX = WS_ROPE + (size_t)M * 32 * 4 * 2;
constexpr size_t WS_RSTDQ = WS_RSTDX + (size_t)M * 4;
constexpr size_t WS_RSTDKV = WS_RSTDQ + (size_t)M * 4;
constexpr size_t WS_SSQ1 = WS_RSTDKV + (size_t)M * 4;
constexpr size_t WS_SSQ2 = WS_SSQ1 + (size_t)M * 64 * 4;
constexpr size_t WS_XB = WS_SSQ2 + (size_t)M * 64 * 4;
constexpr size_t WS_CQ = WS_XB + (size_t)M * D * 2;
constexpr size_t WS_CKV = WS_CQ + (size_t)M * 1024 * 2;
constexpr size_t WS_GQ = WS_CKV + (size_t)M * 512 * 2;
constexpr size_t WS_GK = WS_GQ + (size_t)M * 1024 * 2;
constexpr size_t WS_GV = WS_GK + (size_t)M * 1024 * 2;
constexpr size_t WS_GOG = WS_GV + (size_t)M * 2048 * 2;
constexpr size_t WS_SM = WS_GOG + (size_t)M * 2048 * 2;
constexpr size_t WS_Q = WS_SM + (size_t)M * 256 * 2;
constexpr size_t WS_KV = WS_Q + (size_t)M * 3072 * 2;
constexpr size_t WS_KROPE = WS_KV + (size_t)M * 4096 * 2;
constexpr size_t WS_OMLA = WS_KROPE + (size_t)M * 64 * 2;
constexpr size_t WS_OGLA = WS_OMLA + (size_t)M * 2048 * 2;
constexpr size_t WS_QEP = WS_OGLA + (size_t)M * 2048 * 2;
constexpr size_t WS_KEP = WS_QEP + (size_t)M * 1024 * 2;
constexpr size_t WS_KDT = WS_KEP + (size_t)M * 1024 * 2;
constexpr size_t WS_ATT = WS_KDT + (size_t)M * 1024 * 2;
constexpr size_t WS_DEC = WS_ATT + (size_t)1024 * 64 * 64 * 2;
constexpr size_t WS_RSTD1 = WS_DEC + (size_t)1024 * 256 * 4;
constexpr size_t WS_RSTD2 = WS_RSTD1 + (size_t)M * 4;
constexpr size_t WS_END0 = WS_RSTD2 + (size_t)M * 4;
constexpr size_t WS_QC = WS_Q;
constexpr size_t WS_OC = WS_Q + (size_t)M * 1024 * 2;
constexpr size_t WS_H1B = WS_KV;
constexpr size_t WS_H2B = WS_XB;
constexpr size_t WS_QP = WS_Q;
constexpr int PEER_ROW_BYTES = 2176;
constexpr size_t PEER_VAL_BYTES = (size_t)8 * 16384 * 256;
constexpr size_t WS_PD = WS_Q;
constexpr size_t WS_ACT = WS_OGLA;
constexpr size_t WS_H3B = WS_KV;
constexpr size_t WS_XQ = WS_KV;
constexpr size_t WS_XQS = WS_XQ + (size_t)M * D;
constexpr size_t WS_SSQ3 = WS_SSQ1;
constexpr size_t WS_UB = WS_CQ;
constexpr size_t WS_VB = WS_UB + (size_t)16384 * PEER_ROW_BYTES;
constexpr size_t WS_USC = WS_VB + (size_t)16384 * PEER_ROW_BYTES;
constexpr size_t WS_VSC = WS_USC + (size_t)16384 * 4;
constexpr size_t WS_IDS = WS_VSC + (size_t)16384 * 4;
constexpr size_t WS_GATES = WS_IDS + (size_t)M * 128 * 4;
static_assert(WS_GATES + (size_t)M * 128 * 4 <= WS_Q, "peer scratch overlaps q_p");

__device__ __forceinline__ unsigned cvt_pk_bf16(float lo, float hi) { unsigned r; asm volatile("v_cvt_pk_bf16_f32 %0, %1, %2" : "=v"(r) : "v"(lo), "v"(hi)); return r; }
__device__ __forceinline__ float bf2f(unsigned short b) { return __uint_as_float(((unsigned)b) << 16); }
#define DPP_ADD(v, ctrl, rmask) (v) += __int_as_float(__builtin_amdgcn_update_dpp(0, __float_as_int(v), (ctrl), (rmask), 0xF, false))
__device__ __forceinline__ float wave_sum(float v) {
    DPP_ADD(v, 0xB1, 0xF); DPP_ADD(v, 0x4E, 0xF); DPP_ADD(v, 0x141, 0xF); DPP_ADD(v, 0x140, 0xF);
    DPP_ADD(v, 0x142, 0xA); DPP_ADD(v, 0x143, 0xC);
    return __int_as_float(__builtin_amdgcn_readlane(__float_as_int(v), 63));
}
#define LDS_WAIT() asm volatile("s_waitcnt lgkmcnt(0)" ::: "memory")
__device__ __forceinline__ bf16x8 pack8(f32x4 a, f32x4 b) {
    u32x4 w = {cvt_pk_bf16(a[0], a[1]), cvt_pk_bf16(a[2], a[3]), cvt_pk_bf16(b[0], b[1]), cvt_pk_bf16(b[2], b[3])};
    return *reinterpret_cast<bf16x8*>(&w);
}

#define XB_TMO      128
#define XB_XCNT(j)  (256  + 64 * (j))
#define XB_XSUB(j)  (1280 + 64 * (j))
#define XB_XGEN(j)  (2304 + 64 * (j))
#define XB_TOP      3328
#define XB_TOPGEN   3392
#define XCD_BAR_WORDS 3456
#define XB_SPIN_CAP (1u << 22)

__device__ __forceinline__ unsigned xb_ld(unsigned* p)              { return __hip_atomic_load(p, __ATOMIC_RELAXED, __HIP_MEMORY_SCOPE_AGENT); }
__device__ __forceinline__ unsigned xb_add(unsigned* p, unsigned v) { return __hip_atomic_fetch_add(p, v, __ATOMIC_RELAXED, __HIP_MEMORY_SCOPE_AGENT); }
__device__ __forceinline__ unsigned xb_xcc_id() { return (unsigned)__builtin_amdgcn_s_getreg((3 << 11) | 20) & 0xFu; }
#define XB_SPIN(cond, bar) do { unsigned _sp = 0; while (cond) { __builtin_amdgcn_s_sleep(1); \
    if ((++_sp & 255u) == 0u) { if (xb_ld(&(bar)[XB_TMO])) break; if (_sp > XB_SPIN_CAP) { atomicAdd(&(bar)[XB_TMO], 1u); break; } } } } while (0)

struct XcdBarrier { unsigned* bar; unsigned x; volatile LAS unsigned* st; };

__device__ __forceinline__ XcdBarrier xcd_barrier_post(unsigned* bar, volatile LAS unsigned* st) {
    XcdBarrier b; b.bar = bar; b.x = xb_xcc_id(); b.st = st;
    if (threadIdx.x == 0) st[2] = xb_add(&bar[XB_XCNT(b.x)], 1u);
    return b;
}
__device__ __forceinline__ void xcd_barrier_complete(unsigned* bar, unsigned x, unsigned& nloc, unsigned& nx) {
    const unsigned G = gridDim.x * gridDim.y * gridDim.z;
    unsigned sum, cnt, mine, sp = 0u;
    for (;;) {
        sum = 0u; cnt = 0u; mine = 0u;
#pragma unroll
        for (unsigned j = 0; j < 16; ++j) { const unsigned c = xb_ld(&bar[XB_XCNT(j)]); sum += c; cnt += (c > 0u) ? 1u : 0u; mine = (j == x) ? c : mine; }
        if (sum == G) break;
        __builtin_amdgcn_s_sleep(1);
        if ((++sp & 255u) == 0u) { if (xb_ld(&bar[XB_TMO])) break; if (sp > XB_SPIN_CAP) { atomicAdd(&bar[XB_TMO], 1u); break; } }
    }
    nloc = mine > 0u ? mine : 1u; nx = cnt > 0u ? cnt : 1u;
}
__device__ __forceinline__ void xcd_barrier(const XcdBarrier& b) {
    asm volatile("s_waitcnt vmcnt(0)" ::: "memory");
    __syncthreads();
    if (threadIdx.x == 0) {
        unsigned* bar = b.bar;
        __builtin_amdgcn_s_waitcnt(0);
        unsigned nloc = b.st[0], nx = b.st[1];
        if (nloc == 0u) { xcd_barrier_complete(bar, b.x, nloc, nx); b.st[0] = nloc; b.st[1] = nx; }
        const unsigned old = xb_add(&bar[XB_XSUB(b.x)], 1u);
        const unsigned gen = old / nloc;
        if (old + 1u == (gen + 1u) * nloc) {
            __builtin_amdgcn_fence(__ATOMIC_RELEASE, "agent");
            asm volatile("s_waitcnt vmcnt(0)" ::: "memory");
            const unsigned og = xb_add(&bar[XB_TOP], 1u);
            const unsigned tg = og / nx;
            if (og + 1u == (tg + 1u) * nx) xb_add(&bar[XB_TOPGEN], 1u);
            else XB_SPIN(xb_ld(&bar[XB_TOPGEN]) == tg, bar);
            __builtin_amdgcn_fence(__ATOMIC_ACQUIRE, "agent");
            xb_add(&bar[XB_XGEN(b.x)], 1u);
            asm volatile("s_waitcnt vmcnt(0)" ::: "memory");
        } else {
            XB_SPIN(xb_ld(&bar[XB_XGEN(b.x)]) == gen, bar);
            __builtin_amdgcn_fence(__ATOMIC_ACQUIRE, "agent");
            asm volatile("s_waitcnt vmcnt(0)" ::: "memory");
        }
    }
    __syncthreads();
}


namespace pg8 {
constexpr int BM = 256, BK = 64, HALF = 128, HTB = HALF * BK * 2, NXCD = 8, WGM = 8;
__host__ __device__ __forceinline__ int lds_byte(int r, int c) { const int st = (r >> 4) * 2 + (c >> 5), rr = r & 15, cc = c & 31, ob = rr * 64 + cc * 2; return st * 1024 + (ob ^ (((ob >> 9) & 1) << 5)); }
__host__ __device__ __forceinline__ void stage_rc(int b, int& R, int& C) { const int st = b / 1024, sb = b % 1024, swz = sb ^ (((sb >> 9) & 1) << 5); R = (st >> 1) * 16 + swz / 64; C = (st & 1) * 32 + (swz % 64) / 2; }
__host__ __device__ __forceinline__ int perm32(int rho) { const int n = rho >> 4, i = rho & 15; return 8 * (i >> 2) + 4 * n + (i & 3); }
struct Unit { int pm, pn; };
struct Gemm { const bf16_t* A; const bf16_t* Bt; int M, N, K, lda, ldb; };
struct StaticOrder {
    int nM, nN, nwg, G, c;
    __host__ __device__ void init(int M_, int N_, int G_, int c_) { nM = M_ / BM; nN = N_ / BM; nwg = nM * nN; G = G_; c = c_; }
    __host__ __device__ bool next(int i, Unit& u) const {
        const long L = (long)i * G + c; if (L >= nwg) return false;
        int wgid = (int)L; { const int q = nwg / NXCD, r = nwg % NXCD, xcd = wgid % NXCD, off = wgid / NXCD; wgid = (xcd < r ? xcd * (q + 1) : r * (q + 1) + (xcd - r) * q) + off; }
        const int nig = WGM * nN, gid = wgid / nig, fm = gid * WGM, gsz = (nM - fm) < WGM ? (nM - fm) : WGM;
        u.pm = fm + ((wgid % nig) % gsz); u.pn = (wgid % nig) / gsz; return true;
    }
};
template <class Epi>
__device__ __forceinline__ void gemm_phase(LAS unsigned char* lds, const Gemm g, const StaticOrder& S, const Epi& E, const bool perm) {
    int tid_ = threadIdx.x; asm volatile("" : "+v"(tid_));
    const int tid = tid_, wid = __builtin_amdgcn_readfirstlane(tid >> 6), lane = tid & 63, wr = wid >> 2, wc = wid & 3, fr = lane & 15, fq = lane >> 4;
    const int K = g.K, nt = K / BK;
    unsigned voffA[2], voffB[2];
#pragma unroll
    for (int i = 0; i < 2; ++i) { int R, C; stage_rc(tid * 16 + i * 8192, R, C); const int Rb = perm ? ((R & ~31) + perm32(R & 31)) : R;
        voffA[i] = (unsigned)(R * g.lda + C) * 2u; voffB[i] = (unsigned)(Rb * g.ldb + C) * 2u; }
    const size_t kstep = (size_t)(BK * 2);
    const size_t hstepA = (size_t)HALF * g.lda * 2, hstepB = (size_t)HALF * g.ldb * 2;
    const size_t tstepA = 2 * hstepA, tstepB = 2 * hstepB;
    const unsigned ldsw = (unsigned)wid * 1024u;
    const int aoff = lds_byte(wr * 64 + fr, fq * 8), boff = lds_byte(wc * 32 + fr, fq * 8);
#define PG8_SA(b, h) (((b) * 2 + (h)) * HTB)
#define PG8_SB(b, h) ((4 + (b) * 2 + (h)) * HTB)
#define PG8_STAGE(bufoff, gbase, voff) do { _Pragma("unroll") for (int _i = 0; _i < 2; ++_i) \
        __builtin_amdgcn_global_load_lds((const unsigned*)((const char*)(gbase) + (voff)[_i]), (LAS unsigned*)(lds + (bufoff) + ldsw + _i * 8192), 16, 0, 0); } while (0)
#define PG8_LDA(dst, b, h) do { _Pragma("unroll") for (int m = 0; m < 4; ++m) _Pragma("unroll") for (int k = 0; k < 2; ++k) dst[m][k] = *(const LAS bf16x8*)(lds + PG8_SA(b, h) + aoff + m * 2048 + k * 1024); } while (0)
#define PG8_LDB(dst, b, h) do { _Pragma("unroll") for (int n = 0; n < 2; ++n) _Pragma("unroll") for (int k = 0; k < 2; ++k) dst[n][k] = *(const LAS bf16x8*)(lds + PG8_SB(b, h) + boff + n * 2048 + k * 1024); } while (0)
#define PG8_MMA(ai, bj, At, Bt) do { __builtin_amdgcn_s_setprio(1); _Pragma("unroll") for (int m = 0; m < 4; ++m) _Pragma("unroll") for (int n = 0; n < 2; ++n) _Pragma("unroll") for (int k = 0; k < 2; ++k) \
        acc[ai][bj][m][n] = __builtin_amdgcn_mfma_f32_16x16x32_bf16(Bt[n][k], At[m][k], acc[ai][bj][m][n], 0, 0, 0); __builtin_amdgcn_s_setprio(0); } while (0)
#define PG8_WAIT_V(n) asm volatile("s_waitcnt vmcnt(" #n ")" ::: "memory")
#define PG8_WAIT_L(n) asm volatile("s_waitcnt lgkmcnt(" #n ")" ::: "memory")
#define PG8_BAR __builtin_amdgcn_s_barrier()
#define PG8_SCHED __builtin_amdgcn_sched_barrier(0)
    Unit cur, nxt; int ui = 0;
    if (!S.next(0, cur)) return;
    f32x4 acc[2][2][4][2];
#pragma unroll
    for (int a = 0; a < 2; ++a)
#pragma unroll
        for (int b = 0; b < 2; ++b)
#pragma unroll
            for (int m = 0; m < 4; ++m)
#pragma unroll
                for (int n = 0; n < 2; ++n) acc[a][b][m][n] = (f32x4){0.f, 0.f, 0.f, 0.f};
    bf16x8 At[4][2], B0[2][2], B1[2][2];
    const char* cA = (const char*)g.A + (size_t)cur.pm * tstepA; const char* cB = (const char*)g.Bt + (size_t)cur.pn * tstepB;
    PG8_STAGE(PG8_SB(0, 0), cB, voffB); PG8_STAGE(PG8_SA(0, 0), cA, voffA); PG8_STAGE(PG8_SB(0, 1), cB + hstepB, voffB); PG8_STAGE(PG8_SA(0, 1), cA + hstepA, voffA);
    if (wr == 1) PG8_BAR;
    PG8_WAIT_V(4); PG8_BAR;
    PG8_STAGE(PG8_SB(1, 0), cB + kstep, voffB); PG8_STAGE(PG8_SA(1, 0), cA + kstep, voffA); PG8_STAGE(PG8_SB(1, 1), cB + hstepB + kstep, voffB);
    PG8_WAIT_V(6); PG8_BAR;
    for (;;) {
        const bool has_next = S.next(ui + 1, nxt);
        const char* nA = has_next ? (const char*)g.A + (size_t)nxt.pm * tstepA : cA; const char* nB = has_next ? (const char*)g.Bt + (size_t)nxt.pn * tstepB : cB;
        for (int t = 0; t < nt; t += 2) {
            const bool last = (t == nt - 2);
            const char* a1 = cA + (size_t)(t + 1) * kstep;
            const char* a2 = last ? nA : cA + (size_t)(t + 2) * kstep; const char* b2 = last ? nB : cB + (size_t)(t + 2) * kstep;
            const char* a3 = a2 + kstep; const char* b3 = b2 + kstep;
            PG8_LDB(B0, 0, 0); PG8_SCHED; PG8_LDA(At, 0, 0); PG8_STAGE(PG8_SA(1, 1), a1 + hstepA, voffA);
            PG8_WAIT_L(8); PG8_BAR; PG8_WAIT_L(0); PG8_MMA(0, 0, At, B0); PG8_BAR; PG8_SCHED;
            PG8_LDB(B1, 0, 1); PG8_STAGE(PG8_SB(0, 0), b2, voffB);
            PG8_BAR; PG8_WAIT_L(0); PG8_MMA(0, 1, At, B1); PG8_BAR;
            PG8_LDA(At, 0, 1); PG8_STAGE(PG8_SA(0, 0), a2, voffA);
            PG8_BAR; PG8_WAIT_L(0); PG8_MMA(1, 0, At, B0); PG8_BAR; PG8_SCHED;
            PG8_STAGE(PG8_SB(0, 1), b2 + hstepB, voffB);
            PG8_WAIT_V(6); PG8_BAR; PG8_MMA(1, 1, At, B1); PG8_BAR;
            PG8_LDB(B0, 1, 0); PG8_SCHED; PG8_LDA(At, 1, 0); PG8_STAGE(PG8_SA(0, 1), a2 + hstepA, voffA);
            PG8_WAIT_L(8); PG8_BAR; PG8_WAIT_L(0); PG8_MMA(0, 0, At, B0); PG8_BAR; PG8_SCHED;
            PG8_LDB(B1, 1, 1); PG8_STAGE(PG8_SB(1, 0), b3, voffB);
            PG8_BAR; PG8_WAIT_L(0); PG8_MMA(0, 1, At, B1); PG8_BAR;
            PG8_LDA(At, 1, 1); PG8_STAGE(PG8_SA(1, 0), a3, voffA);
            PG8_BAR; PG8_WAIT_L(0); PG8_MMA(1, 0, At, B0); PG8_BAR; PG8_SCHED;
            PG8_STAGE(PG8_SB(1, 1), b3 + hstepB, voffB);
            PG8_WAIT_V(6); PG8_BAR; PG8_MMA(1, 1, At, B1); PG8_BAR;
        }
        E(acc, cur, wr, wc, fr, fq);
        if (!has_next) break;
#pragma unroll
        for (int a = 0; a < 2; ++a)
#pragma unroll
            for (int b = 0; b < 2; ++b)
#pragma unroll
                for (int m = 0; m < 4; ++m)
#pragma unroll
                    for (int n = 0; n < 2; ++n) acc[a][b][m][n] = (f32x4){0.f, 0.f, 0.f, 0.f};
        cur = nxt; cA = nA; cB = nB; ++ui;
    }
    PG8_WAIT_V(0);
    if (wr == 0) PG8_BAR;
    PG8_BAR;
#undef PG8_SA
#undef PG8_SB
#undef PG8_STAGE
#undef PG8_LDA
#undef PG8_LDB
#undef PG8_MMA
#undef PG8_WAIT_V
#undef PG8_WAIT_L
#undef PG8_BAR
#undef PG8_SCHED
}

struct EpiRowScaleBf16 {
    static constexpr bool PERM = true;
    const float* rs; bf16_t* base; int ldc;
    __device__ __forceinline__ void store(const f32x4 (&acc)[2][2][4][2], bf16_t* __restrict__ dst, int ld, int ctile, const Unit& u, int wr, int wc, int fr, int fq) const {
        const int row0 = u.pm * BM + wr * 64 + fr, col0 = ctile * BM + wc * 32 + 8 * fq;
        float sv[2][4];
        const float* __restrict__ rsp = rs;
#pragma unroll
        for (int ai = 0; ai < 2; ++ai)
#pragma unroll
            for (int m = 0; m < 4; ++m) sv[ai][m] = rsp ? rsp[row0 + ai * HALF + m * 16] : 1.0f;
#pragma unroll
        for (int ai = 0; ai < 2; ++ai)
#pragma unroll
            for (int m = 0; m < 4; ++m) { const int row = row0 + ai * HALF + m * 16; const float s = sv[ai][m]; bf16_t* rowp = dst + (size_t)row * ld + col0;
#pragma unroll
                for (int bj = 0; bj < 2; ++bj) { const f32x4 v0 = acc[ai][bj][m][0] * s, v1 = acc[ai][bj][m][1] * s;
                    u32x4 w; w.x = cvt_pk_bf16(v0[0], v0[1]); w.y = cvt_pk_bf16(v0[2], v0[3]); w.z = cvt_pk_bf16(v1[0], v1[1]); w.w = cvt_pk_bf16(v1[2], v1[3]);
                    *(u32x4*)(rowp + bj * HALF) = w; } }
    }
    __device__ __forceinline__ void operator()(const f32x4 (&acc)[2][2][4][2], const Unit& u, int wr, int wc, int fr, int fq) const { store(acc, base, ldc, u.pn, u, wr, wc, fr, fq); }
};
struct EpiInProj : EpiRowScaleBf16 {
    unsigned char* ws;
    __device__ __forceinline__ void operator()(const f32x4 (&acc)[2][2][4][2], const Unit& u, int wr, int wc, int fr, int fq) const {
        const int pn = u.pn; size_t off; int ld, t0;
        if (pn < 4) { off = WS_CQ; ld = 1024; t0 = 0; } else if (pn < 6) { off = WS_CKV; ld = 512; t0 = 4; } else if (pn < 10) { off = WS_GQ; ld = 1024; t0 = 6; }
        else if (pn < 14) { off = WS_GK; ld = 1024; t0 = 10; } else if (pn < 22) { off = WS_GV; ld = 2048; t0 = 14; } else if (pn < 30) { off = WS_GOG; ld = 2048; t0 = 22; }
        else { off = WS_SM; ld = 256; t0 = 30; }
        store(acc, (bf16_t*)(ws + off), ld, pn - t0, u, wr, wc, fr, fq);
    }
};
struct EpiResidual {
    static constexpr bool PERM = true;
    const float* basef; const bf16_t* baseb; bf16_t* hb; float* ssq; int ldc; int nslots;
    __device__ __forceinline__ void operator()(const f32x4 (&acc)[2][2][4][2], const Unit& u, int wr, int wc, int fr, int fq) const {
        const int row0 = u.pm * BM + wr * 64 + fr, col0 = u.pn * BM + wc * 32 + 8 * fq;
        const float* __restrict__ bf = basef; const bf16_t* __restrict__ bb = baseb; bf16_t* __restrict__ ho = hb;
        if (bf) {
#pragma unroll
            for (int ai = 0; ai < 2; ++ai)
#pragma unroll
                for (int mp = 0; mp < 2; ++mp) {
                    f32x4 bs[2][2][2];
#pragma unroll
                    for (int mm = 0; mm < 2; ++mm) { const size_t off = (size_t)(row0 + ai * HALF + (2 * mp + mm) * 16) * ldc + col0;
#pragma unroll
                        for (int bj = 0; bj < 2; ++bj)
#pragma unroll
                            for (int n = 0; n < 2; ++n) bs[mm][bj][n] = *(const f32x4*)(bf + off + bj * HALF + n * 4); }
#pragma unroll
                    for (int mm = 0; mm < 2; ++mm) { const int m = 2 * mp + mm; const int row = row0 + ai * HALF + m * 16; const size_t off = (size_t)row * ldc + col0; float ss = 0.f;
#pragma unroll
                        for (int bj = 0; bj < 2; ++bj) { const f32x4 h0 = bs[mm][bj][0] + acc[ai][bj][m][0], h1 = bs[mm][bj][1] + acc[ai][bj][m][1];
                            u32x4 w; w.x = cvt_pk_bf16(h0[0], h0[1]); w.y = cvt_pk_bf16(h0[2], h0[3]); w.z = cvt_pk_bf16(h1[0], h1[1]); w.w = cvt_pk_bf16(h1[2], h1[3]);
                            *(u32x4*)(ho + off + bj * HALF) = w;
                            ss += ((h0[0] * h0[0] + h0[1] * h0[1]) + (h0[2] * h0[2] + h0[3] * h0[3])) + ((h1[0] * h1[0] + h1[1] * h1[1]) + (h1[2] * h1[2] + h1[3] * h1[3])); }
                        ss += __shfl_xor(ss, 16); ss += __shfl_xor(ss, 32);
                        if (fq == 0) ssq[(size_t)row * nslots + u.pn * 4 + wc] = ss; }
                }
        } else {
#pragma unroll
            for (int ai = 0; ai < 2; ++ai) {
                u32x4 bs[4][2];
#pragma unroll
                for (int m = 0; m < 4; ++m) { const size_t off = (size_t)(row0 + ai * HALF + m * 16) * ldc + col0;
#pragma unroll
                    for (int bj = 0; bj < 2; ++bj) bs[m][bj] = *(const u32x4*)(bb + off + bj * HALF); }
#pragma unroll
                for (int m = 0; m < 4; ++m) { const int row = row0 + ai * HALF + m * 16; const size_t off = (size_t)row * ldc + col0; float ss = 0.f;
#pragma unroll
                    for (int bj = 0; bj < 2; ++bj) { const u32x4 q = bs[m][bj];
                        const f32x4 h0 = (f32x4){__uint_as_float(q.x << 16), __uint_as_float(q.x & 0xffff0000u), __uint_as_float(q.y << 16), __uint_as_float(q.y & 0xffff0000u)} + acc[ai][bj][m][0];
                        const f32x4 h1 = (f32x4){__uint_as_float(q.z << 16), __uint_as_float(q.z & 0xffff0000u), __uint_as_float(q.w << 16), __uint_as_float(q.w & 0xffff0000u)} + acc[ai][bj][m][1];
                        u32x4 w; w.x = cvt_pk_bf16(h0[0], h0[1]); w.y = cvt_pk_bf16(h0[2], h0[3]); w.z = cvt_pk_bf16(h1[0], h1[1]); w.w = cvt_pk_bf16(h1[2], h1[3]);
                        *(u32x4*)(ho + off + bj * HALF) = w;
                        ss += ((h0[0] * h0[0] + h0[1] * h0[1]) + (h0[2] * h0[2] + h0[3] * h0[3])) + ((h1[0] * h1[0] + h1[1] * h1[1]) + (h1[2] * h1[2] + h1[3] * h1[3])); }
                    ss += __shfl_xor(ss, 16); ss += __shfl_xor(ss, 32);
                    if (fq == 0) ssq[(size_t)row * nslots + u.pn * 4 + wc] = ss; }
            }
        }
    }
};
}


struct GemmDesc { unsigned long long a_off, b_off, d_off, rs_off, ssq_off; int M, N, K, lda, ldb, ldc, kind, base_is_x, crot; };
constexpr unsigned long long NO_OFF = ~0ull;
__device__ __constant__ GemmDesc g_gemm[9] = {
      {WS_XB,  WS_WIN,  0,      WS_RSTDX,  NO_OFF,  M,     IN_WP, D,    D,    D,    0,    1, 0, 0},
      {WS_MN,  WS_WCK,  WS_KC,  NO_OFF,    NO_OFF,  MROWS, 1024,  D,    D,    D,    1024, 0, 0, 64},
      {WS_MN,  WS_WCV,  WS_VC,  NO_OFF,    NO_OFF,  MROWS, 1024,  D,    D,    D,    1024, 0, 0, 56},
      {WS_CQ,  WS_WUQ,  WS_Q,   WS_RSTDQ,  NO_OFF,  M,     3072,  1024, 1024, 1024, 3072, 0, 0, 0},
      {WS_CKV, WS_WUKV, WS_KV,  WS_RSTDKV, NO_OFF,  M,     4096,  512,  512,  512,  4096, 0, 0, 0},
      {WS_XB,  WS_WOUT, WS_H1B, NO_OFF,    WS_SSQ1, M,     D,     D,    D,    D,    D,    2, 1, 0},
      {WS_H1B, WS_WCQ,  WS_QC,  WS_RSTD1,  NO_OFF,  M,     1024,  D,    D,    D,    1024, 0, 0, 0},
      {WS_OC,  WS_WCO,  WS_H2B, NO_OFF,    WS_SSQ2, M,     D,     1024, 1024, 1024, D,    2, 0, 0},
      {WS_H2B, WS_WPQ,  WS_QP,  WS_RSTD2,  NO_OFF,  M,     2048,  D,    D,    D,    2048, 0, 0, 0},
};
template <int KINDS>
struct EpiGeneric {
    int kind; pg8::EpiInProj ein; pg8::EpiResidual eres;
    __device__ __forceinline__ void operator()(const f32x4 (&acc)[2][2][4][2], const pg8::Unit& u, int wr, int wc, int fr, int fq) const {
        if ((KINDS & 4) && (kind == 2 || KINDS == 4)) eres(acc, u, wr, wc, fr, fq);
        else if ((KINDS & 2) && (kind == 1 || KINDS == 2)) ein(acc, u, wr, wc, fr, fq);
        else if (KINDS & 1) ein.pg8::EpiRowScaleBf16::operator()(acc, u, wr, wc, fr, fq);
    }
};
template <int KINDS>
__device__ __forceinline__ void gemm_run(LAS unsigned char* lds, const float* x_in, float* out, unsigned char* ws, int idx, int G, int bid) {
    const GemmDesc d = g_gemm[idx];
    pg8::Gemm g{(const bf16_t*)(ws + d.a_off), (const bf16_t*)(ws + d.b_off), d.M, d.N, d.K, d.lda, d.ldb};
    pg8::StaticOrder S; S.init(d.M, d.N, G, (bid + d.crot) % G);
    EpiGeneric<KINDS> E{};
    E.kind = d.kind;
    E.ein.rs = d.rs_off == NO_OFF ? nullptr : (const float*)(ws + d.rs_off); E.ein.base = (bf16_t*)(ws + d.d_off); E.ein.ldc = d.ldc; E.ein.ws = ws;
    E.eres.basef = d.base_is_x ? x_in : nullptr; E.eres.baseb = (const bf16_t*)(ws + WS_H1B); E.eres.hb = (bf16_t*)(ws + d.d_off); E.eres.ssq = (float*)(ws + (d.ssq_off == NO_OFF ? 0ull : d.ssq_off)); E.eres.ldc = d.ldc; E.eres.nslots = 64;
    pg8::gemm_phase(lds, g, S, E, true);
}

namespace att {
constexpr int KVBLK = 64;
constexpr float THR = 8.f;
#define SBAR() __builtin_amdgcn_sched_barrier(0)
__device__ __forceinline__ int v_st(int k, int c) { const int kk = (k & ~0xC) | ((k & 4) << 1) | ((k & 8) >> 1); return ((kk >> 3) * 4 + (c >> 5)) * 512 + ((kk & 7) * 32 + (c & 31)) * 2; }
__device__ __forceinline__ int v_rd_base(int lane) { return ((lane & 3) << 3) | (((lane >> 2) & 3) << 6) | (((lane >> 4) & 1) << 5) | (((lane >> 5) & 1) << 8); }
constexpr int v_rd_off(int d0, int ks, int half) { return d0 * 512 + ks * 4096 + half * 2048; }
__device__ __forceinline__ int crow(int r, int hi) { return (r & 3) + 8 * (r >> 2) + 4 * hi; }
__device__ __forceinline__ void mask_tile(f32x16& p0, f32x16& p1, int dq, unsigned W) {
    const float NEG = -__builtin_inff();
#pragma unroll
    for (int r = 0; r < 16; ++r) {
        const int c = (r & 3) + 8 * (r >> 2);
        if ((unsigned)(dq - c) >= W) p0[r] = NEG;
        if ((unsigned)(dq - c - 32) >= W) p1[r] = NEG;
    }
}
__device__ __forceinline__ void partialSM(f32x16& p0, f32x16& p1, float& m_reg, float& mn, float& alpha, const float SCALE) {
    float pmax = p0[0];
#pragma unroll
    for (int r = 1; r < 16; ++r) pmax = fmaxf(pmax, p0[r]);
#pragma unroll
    for (int r = 0; r < 16; ++r) pmax = fmaxf(pmax, p1[r]);
    { auto rr = __builtin_amdgcn_permlane32_swap(__float_as_uint(pmax), __float_as_uint(pmax), false, false);
      pmax = fmaxf(__uint_as_float(rr[0]), __uint_as_float(rr[1])); }
    const float C2 = 1.4426950408889634f * SCALE;
    if (__builtin_expect(__all((pmax - m_reg) * SCALE <= THR), 1)) { mn = m_reg; alpha = 1.f; }
    else { mn = fmaxf(m_reg, pmax); alpha = __builtin_amdgcn_exp2f((m_reg - mn) * C2); m_reg = mn; }
    const float mnL = -mn * C2;
#pragma unroll
    for (int r = 0; r < 16; ++r) p0[r] = fmaf(p0[r], C2, mnL);
#pragma unroll
    for (int r = 0; r < 16; ++r) p1[r] = fmaf(p1[r], C2, mnL);
#pragma unroll
    for (int r = 0; r < 16; ++r) p0[r] = __builtin_amdgcn_exp2f(p0[r]);
}
__device__ __forceinline__ void finishSM(f32x16& p0, f32x16& p1, float alpha, float& l_reg, bf16x8& pa0, bf16x8& pa1, bf16x8& pa2, bf16x8& pa3) {
#pragma unroll
    for (int r = 0; r < 16; ++r) p1[r] = __builtin_amdgcn_exp2f(p1[r]);
    float ps = 0;
#pragma unroll
    for (int r = 0; r < 16; ++r) ps += p0[r];
#pragma unroll
    for (int r = 0; r < 16; ++r) ps += p1[r];
    { auto rr = __builtin_amdgcn_permlane32_swap(__float_as_uint(ps), __float_as_uint(ps), false, false);
      ps = __uint_as_float(rr[0]) + __uint_as_float(rr[1]); }
    l_reg = l_reg * alpha + ps;
#define PK4(P, B_, OUT) do { unsigned a0 = cvt_pk_bf16(P[B_+0], P[B_+1]), a1 = cvt_pk_bf16(P[B_+2], P[B_+3]);                          \
        unsigned b0 = cvt_pk_bf16(P[B_+4], P[B_+5]), b1 = cvt_pk_bf16(P[B_+6], P[B_+7]);                                             \
        auto r0 = __builtin_amdgcn_permlane32_swap(a0, b0, false, false); auto r1 = __builtin_amdgcn_permlane32_swap(a1, b1, false, false); \
        u32x4 w = {r0[0], r1[0], r0[1], r1[1]}; OUT = *reinterpret_cast<bf16x8*>(&w); } while (0)
    PK4(p0, 0, pa0); PK4(p0, 8, pa1); PK4(p1, 0, pa2); PK4(p1, 8, pa3);
#undef PK4
}
template <int DQK>
__device__ __forceinline__ void qkt(f32x16& p0, f32x16& p1, const LAS char* Kt, int r32, int hi, const bf16x8* qr) {
    constexpr int PITCH = DQK * 2;
    p0 = f32x16{}; p1 = f32x16{};
    const LAS char* kb[4];
#pragma unroll
    for (int dd = 0; dd < 4; ++dd) kb[dd] = Kt + r32 * PITCH + (((dd * 16 + hi * 8) * 2) ^ ((r32 & 7) << 4));
#pragma unroll
    for (int d0 = 0; d0 < DQK / 16; ++d0) { const LAS char* a = kb[d0 & 3] + (d0 >> 2) * 128;
        bf16x8 b0 = *reinterpret_cast<const LAS bf16x8*>(a);
        bf16x8 b1 = *reinterpret_cast<const LAS bf16x8*>(a + 32 * PITCH);
        p0 = __builtin_amdgcn_mfma_f32_32x32x16_bf16(b0, qr[d0], p0, 0, 0, 0);
        p1 = __builtin_amdgcn_mfma_f32_32x32x16_bf16(b1, qr[d0], p1, 0, 0, 0); }
}
template <int VOFF>
__device__ __forceinline__ void pv_tile(f32x16* o, int vaddr, bf16x8 pa0, bf16x8 pa1, bf16x8 pa2, bf16x8 pa3) {
#define TRRD(dst, off) asm volatile("ds_read_b64_tr_b16 %0, %1 offset:%2" : "=&v"(dst) : "v"(vaddr), "i"(off) : "memory")
#define PV_D0(d0) do { s16x4 l0, l1, l2, l3, h0, h1, h2, h3; constexpr int b_ = VOFF + v_rd_off(d0, 0, 0); \
        TRRD(l0, b_); TRRD(h0, b_ + 2048); TRRD(l1, b_ + 4096); TRRD(h1, b_ + 6144); TRRD(l2, b_ + 8192); TRRD(h2, b_ + 10240); TRRD(l3, b_ + 12288); TRRD(h3, b_ + 14336); \
        asm volatile("s_waitcnt lgkmcnt(0)" ::: "memory"); SBAR();   \
        o[d0] = __builtin_amdgcn_mfma_f32_32x32x16_bf16(pa0, (bf16x8){l0[0], l0[1], l0[2], l0[3], h0[0], h0[1], h0[2], h0[3]}, o[d0], 0, 0, 0);   \
        o[d0] = __builtin_amdgcn_mfma_f32_32x32x16_bf16(pa1, (bf16x8){l1[0], l1[1], l1[2], l1[3], h1[0], h1[1], h1[2], h1[3]}, o[d0], 0, 0, 0);   \
        o[d0] = __builtin_amdgcn_mfma_f32_32x32x16_bf16(pa2, (bf16x8){l2[0], l2[1], l2[2], l2[3], h2[0], h2[1], h2[2], h2[3]}, o[d0], 0, 0, 0);   \
        o[d0] = __builtin_amdgcn_mfma_f32_32x32x16_bf16(pa3, (bf16x8){l3[0], l3[1], l3[2], l3[3], h3[0], h3[1], h3[2], h3[3]}, o[d0], 0, 0, 0); } while (0)
    PV_D0(0); PV_D0(1); PV_D0(2); PV_D0(3);
#undef PV_D0
#undef TRRD
}

constexpr int MLA_TILE = 16384;
constexpr int MLA_V_OFF = 0, MLA_KN_OFF = 2 * MLA_TILE, MLA_KR_OFF = 4 * MLA_TILE, MLA_KR_BYTES = 8192, MLA_WS_OFF = MLA_KR_OFF + 2 * MLA_KR_BYTES;
__device__ __forceinline__ void mla_block(LAS char* lds, const bf16_t* __restrict__ q, const bf16_t* __restrict__ kv, const bf16_t* __restrict__ krope,
                                          const float* __restrict__ cs, const float* __restrict__ sn, bf16_t* __restrict__ omla, int b, int h, int qb) {
    const float SCALE = 0.07216878364870322f;
    int tid_ = threadIdx.x; asm volatile("" : "+v"(tid_));
    const int tid = tid_, wid = __builtin_amdgcn_readfirstlane(tid >> 6), lane = tid & 63, r32 = lane & 31, hi = lane >> 5;
    LAS float* wsf = (LAS float*)(lds + MLA_WS_OFF) + wid * 64; LAS float* li_l = wsf; LAS float* al_l = wsf + 32;
    const int P0 = qb * 256, tb = b * SEQ;
    const int NT = (P0 + 256) / KVBLK;
    const int qlo = P0 + wid * 32, qm = qlo + r32 - 4 * hi;
    bf16x8 qr[12];
    { const size_t qrow = (size_t)(tb + qlo + r32); const bf16_t* qp = q + qrow * 3072 + h * 192;
#pragma unroll
      for (int d0 = 0; d0 < 8; ++d0) qr[d0] = *(const bf16x8*)(qp + d0 * 16 + hi * 8);
      const bf16x8 x8 = *(const bf16x8*)(qp + 128 + hi * 8), x9 = *(const bf16x8*)(qp + 144 + hi * 8), x10 = *(const bf16x8*)(qp + 160 + hi * 8), x11 = *(const bf16x8*)(qp + 176 + hi * 8);
      const float* cp = cs + qrow * 32 + hi * 8; const float* sp = sn + qrow * 32 + hi * 8;
      float n8[8], n9[8], n10[8], n11[8];
#pragma unroll
      for (int e = 0; e < 8; ++e) { const float c0 = cp[e], s0 = sp[e], c1 = cp[16 + e], s1 = sp[16 + e];
          const float a8 = bf2f((unsigned short)x8[e]), a9 = bf2f((unsigned short)x9[e]), a10 = bf2f((unsigned short)x10[e]), a11 = bf2f((unsigned short)x11[e]);
          n8[e] = a8 * c0 - a10 * s0; n10[e] = a10 * c0 + a8 * s0; n9[e] = a9 * c1 - a11 * s1; n11[e] = a11 * c1 + a9 * s1; }
      qr[8] = pack8((f32x4){n8[0], n8[1], n8[2], n8[3]}, (f32x4){n8[4], n8[5], n8[6], n8[7]});
      qr[9] = pack8((f32x4){n9[0], n9[1], n9[2], n9[3]}, (f32x4){n9[4], n9[5], n9[6], n9[7]});
      qr[10] = pack8((f32x4){n10[0], n10[1], n10[2], n10[3]}, (f32x4){n10[4], n10[5], n10[6], n10[7]});
      qr[11] = pack8((f32x4){n11[0], n11[1], n11[2], n11[3]}, (f32x4){n11[4], n11[5], n11[6], n11[7]}); }
    unsigned voff_kn, voff_v, voff_kr;
    { const int row = tid >> 4, cp_ = tid & 15, g = cp_ >> 3, j = cp_ & 7;
      voff_kn = (unsigned)(row * 8192 + (h * 256 + (g * 8 + (j ^ (row & 7))) * 8) * 2);
      const int kk = (tid >> 7) * 8 + ((tid & 31) >> 2), key = (kk & ~0xC) | ((kk & 4) << 1) | ((kk & 8) >> 1), c = ((tid >> 5) & 3) * 32 + (tid & 3) * 8;
      voff_v = (unsigned)(key * 8192 + (h * 256 + 128 + c) * 2);
      const int prow = tid >> 4, half = (tid >> 3) & 1, jr = (tid & 7) ^ (prow & 7);
      voff_kr = (unsigned)((prow + 32 * half) * 128 + jr * 16); }
    const char* kvb = (const char*)(kv + (size_t)tb * 4096); const char* krb = (const char*)(krope + (size_t)tb * 64);
    const unsigned ldsw = (unsigned)wid * 1024u;
#define GLDS(gp, lp) __builtin_amdgcn_global_load_lds((const unsigned*)(gp), (LAS unsigned*)(lp), 16, 0, 0)
#define ST_ISSUE(kb_, BF) do { const char* kt_ = kvb + (size_t)(kb_) * 8192;                                                              \
        GLDS(kt_ + voff_kn, lds + MLA_KN_OFF + (BF) * MLA_TILE + ldsw); GLDS(kt_ + 32 * 8192 + voff_kn, lds + MLA_KN_OFF + (BF) * MLA_TILE + 8192 + ldsw); \
        GLDS(kt_ + voff_v, lds + MLA_V_OFF + (BF) * MLA_TILE + ldsw);   GLDS(kt_ + 32 * 8192 + voff_v, lds + MLA_V_OFF + (BF) * MLA_TILE + 8192 + ldsw);   \
        GLDS(krb + (size_t)(kb_) * 128 + voff_kr, lds + MLA_KR_OFF + (BF) * MLA_KR_BYTES + ldsw); } while (0)
    float m_reg = -1e30f, l_reg = 0.f; f32x16 o[4] = {};
    const int vb0 = (int)(size_t)(lds + MLA_V_OFF) + v_rd_base(lane);
    const LAS char* kbn[4];
#pragma unroll
    for (int dd = 0; dd < 4; ++dd) kbn[dd] = lds + MLA_KN_OFF + r32 * 256 + (((dd * 16 + hi * 8) * 2) ^ ((r32 & 7) << 4));
#define ST_ISSUE_K(kb_, BF) do { const char* kt_ = kvb + (size_t)(kb_) * 8192;                                                             \
        GLDS(kt_ + voff_kn, lds + MLA_KN_OFF + (BF) * MLA_TILE + ldsw); GLDS(kt_ + 32 * 8192 + voff_kn, lds + MLA_KN_OFF + (BF) * MLA_TILE + 8192 + ldsw); \
        GLDS(krb + (size_t)(kb_) * 128 + voff_kr, lds + MLA_KR_OFF + (BF) * MLA_KR_BYTES + ldsw); } while (0)
#define ST_ISSUE_V(kb_, BF) do { const char* kt_ = kvb + (size_t)(kb_) * 8192;                                                             \
        GLDS(kt_ + voff_v, lds + MLA_V_OFF + (BF) * MLA_TILE + ldsw);   GLDS(kt_ + 32 * 8192 + voff_v, lds + MLA_V_OFF + (BF) * MLA_TILE + 8192 + ldsw); } while (0)
#define QK_TILE(P0_, P1_, BF) do { P0_ = f32x16{}; P1_ = f32x16{};                                                                          \
        _Pragma("unroll") for (int d0 = 0; d0 < 8; ++d0) { const LAS char* a_ = kbn[d0 & 3] + (BF) * MLA_TILE + (d0 >> 2) * 128;            \
            const bf16x8 b0 = *reinterpret_cast<const LAS bf16x8*>(a_), b1 = *reinterpret_cast<const LAS bf16x8*>(a_ + 32 * 256);            \
            P0_ = __builtin_amdgcn_mfma_f32_32x32x16_bf16(b0, qr[d0], P0_, 0, 0, 0); P1_ = __builtin_amdgcn_mfma_f32_32x32x16_bf16(b1, qr[d0], P1_, 0, 0, 0); } \
        _Pragma("unroll") for (int d0 = 0; d0 < 4; ++d0) { const LAS char* a_ = kbn[d0] + (MLA_KR_OFF - MLA_KN_OFF) + (BF) * MLA_KR_BYTES;  \
            const bf16x8 b0 = *reinterpret_cast<const LAS bf16x8*>(a_), b1 = *reinterpret_cast<const LAS bf16x8*>(a_ + 128);                 \
            P0_ = __builtin_amdgcn_mfma_f32_32x32x16_bf16(b0, qr[8 + d0], P0_, 0, 0, 0); P1_ = __builtin_amdgcn_mfma_f32_32x32x16_bf16(b1, qr[8 + d0], P1_, 0, 0, 0); } } while (0)
    f32x16 pA0, pA1, pB0, pB1;
    const bool grpA = wid < 4;
#define HB(vm) do { asm volatile("s_waitcnt vmcnt(" #vm ") lgkmcnt(0)" ::: "memory"); __builtin_amdgcn_s_barrier(); asm volatile("" ::: "memory"); } while (0)
#define QK_IF(t_, P0_, P1_, BF) do { if ((t_) < NT && (t_) * KVBLK <= qlo + 31) QK_TILE(P0_, P1_, BF); } while (0)
#define SMPV(t_, C0, C1, BF) do { const int kb = (t_) * KVBLK;                                                                            \
        if (kb <= qlo + 31) {                                                                                                             \
            float mn, alpha; bf16x8 pa0, pa1, pa2, pa3;                                                                                   \
            if (kb + KVBLK - 1 > qlo) mask_tile(C0, C1, qm - kb, 0x7fffffffu);                                                            \
            partialSM(C0, C1, m_reg, mn, alpha, SCALE);                                                                                   \
            finishSM(C0, C1, alpha, l_reg, pa0, pa1, pa2, pa3);                                                                           \
            if (__any(alpha < 1.f)) { if (hi == 0) al_l[r32] = alpha; LDS_WAIT();                                                         \
                _Pragma("unroll") for (int d_ = 0; d_ < 4; ++d_) _Pragma("unroll") for (int r = 0; r < 16; ++r) o[d_][r] *= al_l[crow(r, hi)]; } \
            pv_tile<MLA_V_OFF + (BF) * MLA_TILE>(o, vb0, pa0, pa1, pa2, pa3);                                                             \
        } } while (0)
#define ISSUE_K2(kb_, BF) do { const char* kt_ = kvb + (size_t)(kb_) * 8192; const char* kr_ = krb + (size_t)(kb_) * 128;                   \
        _Pragma("unroll") for (int pp = 0; pp < 2; ++pp) {                                                                                 \
            GLDS(kt_ + pp * 16 * 8192 + voff_kn, lds + MLA_KN_OFF + (BF) * MLA_TILE + pp * 4096 + ldsw);                                    \
            GLDS(kt_ + (32 + pp * 16) * 8192 + voff_kn, lds + MLA_KN_OFF + (BF) * MLA_TILE + 8192 + pp * 4096 + ldsw);                      \
            GLDS(kr_ + pp * 16 * 128 + voff_kr, lds + MLA_KR_OFF + (BF) * MLA_KR_BYTES + pp * 4096 + ldsw); } } while (0)
#define ISSUE_V2(kb_, BF) do { const char* kt_ = kvb + (size_t)(kb_) * 8192;                                                               \
        _Pragma("unroll") for (int pp = 0; pp < 2; ++pp) {                                                                                 \
            GLDS(kt_ + pp * 16 * 8192 + voff_v, lds + MLA_V_OFF + (BF) * MLA_TILE + pp * 4096 + ldsw);                                      \
            GLDS(kt_ + (32 + pp * 16) * 8192 + voff_v, lds + MLA_V_OFF + (BF) * MLA_TILE + 8192 + pp * 4096 + ldsw); } } while (0)
    ST_ISSUE_K(0, 0); ST_ISSUE_V(0, 0); ST_ISSUE_K(KVBLK, 1);
    HB(0);
    QK_TILE(pA0, pA1, 0);
    HB(0);
    if (!grpA) HB(0);
    for (int t = 0; t < NT; t += 2) {
        if (grpA && t + 2 < NT) ISSUE_K2((t + 2) * KVBLK, 0);
        QK_IF(t + 1, pB0, pB1, 1);
        if (t + 2 < NT) HB(6); else HB(0);
        if (grpA) ISSUE_V2((t + 1) * KVBLK, 1);
        SMPV(t, pA0, pA1, 0);
        HB(4);
        if (grpA && t + 3 < NT) ISSUE_K2((t + 3) * KVBLK, 1);
        QK_IF(t + 2, pA0, pA1, 0);
        if (t + 3 < NT) HB(6); else HB(0);
        if (grpA && t + 2 < NT) ISSUE_V2((t + 2) * KVBLK, 0);
        SMPV(t + 1, pB0, pB1, 1);
        if (t + 2 < NT) HB(4); else HB(0);
    }
    if (grpA) HB(0);
#undef ISSUE_K2
#undef ISSUE_V2
#undef SMPV
#undef QK_IF
#undef HB
#undef QK_TILE
#undef ST_ISSUE_K
#undef ST_ISSUE_V
#undef TILE_STEP
#undef ST_ISSUE
#undef GLDS
    if (hi == 0) li_l[r32] = l_reg; LDS_WAIT();
    LAS char* ost = lds + wid * 8192;
#pragma unroll
    for (int r = 0; r < 16; ++r) { const int orow = crow(r, hi); const float rl = __builtin_amdgcn_rcpf(li_l[orow]);
#pragma unroll
        for (int d0 = 0; d0 < 4; ++d0) { const float v = o[d0][r] * rl; const float vn = __shfl_xor(v, 1);
            if ((r32 & 1) == 0) *(LAS unsigned*)(ost + orow * 256 + (d0 * 32 + r32) * 2) = cvt_pk_bf16(v, vn); } }
    LDS_WAIT();
    bf16_t* Ow = omla + (size_t)(tb + qlo) * 2048 + h * 128;
#pragma unroll
    for (int k = 0; k < 8; ++k) { const int row = k * 4 + (lane >> 4), ch = lane & 15;
        const u32x4 w = *(const LAS u32x4*)(ost + row * 256 + ch * 16);
        *(u32x4*)(Ow + (size_t)row * 2048 + ch * 8) = w; }
    __syncthreads();
}

constexpr int XA_K_OFF = 32768, XA_WS_OFF = 65536;
__device__ __forceinline__ void xattn_block(LAS char* lds, const bf16_t* __restrict__ qc, const bf16_t* __restrict__ kc, const bf16_t* __restrict__ vc, bf16_t* __restrict__ oc, int b, int h, int qb) {
    const float SCALE = 0.0625f;
    int tid_ = threadIdx.x; asm volatile("" : "+v"(tid_));
    const int tid = tid_, wid = __builtin_amdgcn_readfirstlane(tid >> 6), lane = tid & 63, r32 = lane & 31, hi = lane >> 5;
    const int rg = wid & 3, vsp = wid >> 2;
    LAS float* wsf = (LAS float*)(lds + XA_WS_OFF) + wid * 64; LAS float* li_l = wsf; LAS float* al_l = wsf + 32;
    const int row0 = b * SEQ + qb * 128 + rg * 32;
    bf16x8 qr[16];
    { const bf16_t* qp = qc + (size_t)(row0 + r32) * 1024 + h * 256;
#pragma unroll
      for (int d0 = 0; d0 < 16; ++d0) qr[d0] = *(const bf16x8*)(qp + d0 * 16 + hi * 8); }
    unsigned voff_k, voff_v;
    { const int row = tid >> 5, cp_ = tid & 31, g = cp_ >> 3, j = cp_ & 7;
      voff_k = (unsigned)(row * 2048 + (h * 256 + (g * 8 + (j ^ (row & 7))) * 8) * 2);
      const int kk = (tid >> 7) * 8 + ((tid & 31) >> 2), key = (kk & ~0xC) | ((kk & 4) << 1) | ((kk & 8) >> 1), c = ((tid >> 5) & 3) * 32 + (tid & 3) * 8;
      voff_v = (unsigned)(key * 2048 + (h * 256 + c) * 2); }
    const char* kcb = (const char*)(kc + (size_t)b * MEMT * 1024); const char* vcb = (const char*)(vc + (size_t)b * MEMT * 1024);
    const unsigned ldsw = (unsigned)wid * 1024u;
#define GLDS(gp, lp) __builtin_amdgcn_global_load_lds((const unsigned*)(gp), (LAS unsigned*)(lp), 16, 0, 0)
    float m_reg = -1e30f, l_reg = 0.f; f32x16 o[4] = {};
    const int vb0 = (int)(size_t)(lds + vsp * 16384) + v_rd_base(lane);
    const LAS char* kbn[4];
#pragma unroll
    for (int dd = 0; dd < 4; ++dd) kbn[dd] = lds + XA_K_OFF + r32 * 512 + (((dd * 16 + hi * 8) * 2) ^ ((r32 & 7) << 4));
    for (int t = 0; t < 4; ++t) {
        const char* kt_ = kcb + (size_t)(t * 64) * 2048; const char* vt_ = vcb + (size_t)(t * 64) * 2048;
        __syncthreads();
#pragma unroll
        for (int i = 0; i < 4; ++i) GLDS(kt_ + (size_t)i * 16 * 2048 + voff_k, lds + XA_K_OFF + i * 8192 + ldsw);
#pragma unroll
        for (int hv = 0; hv < 2; ++hv)
#pragma unroll
            for (int i = 0; i < 2; ++i) GLDS(vt_ + (size_t)i * 32 * 2048 + hv * 256 + voff_v, lds + hv * 16384 + i * 8192 + ldsw);
        asm volatile("s_waitcnt vmcnt(0)" ::: "memory");
        __syncthreads();
        f32x16 p0 = {}, p1 = {}; float mn, alpha; bf16x8 pa0, pa1, pa2, pa3;
#pragma unroll
        for (int d0 = 0; d0 < 16; ++d0) { const LAS char* a_ = kbn[d0 & 3] + (d0 >> 2) * 128;
            const bf16x8 b0 = *reinterpret_cast<const LAS bf16x8*>(a_), b1 = *reinterpret_cast<const LAS bf16x8*>(a_ + 32 * 512);
            p0 = __builtin_amdgcn_mfma_f32_32x32x16_bf16(b0, qr[d0], p0, 0, 0, 0); p1 = __builtin_amdgcn_mfma_f32_32x32x16_bf16(b1, qr[d0], p1, 0, 0, 0); }
        partialSM(p0, p1, m_reg, mn, alpha, SCALE);
        finishSM(p0, p1, alpha, l_reg, pa0, pa1, pa2, pa3);
        if (__any(alpha < 1.f)) { if (hi == 0) al_l[r32] = alpha; LDS_WAIT();
#pragma unroll
            for (int d_ = 0; d_ < 4; ++d_)
#pragma unroll
                for (int r = 0; r < 16; ++r) o[d_][r] *= al_l[crow(r, hi)]; }
        pv_tile<0>(o, vb0, pa0, pa1, pa2, pa3);
    }
#undef GLDS
    if (hi == 0) li_l[r32] = l_reg; LDS_WAIT();
    bf16_t* Ow = oc + (size_t)row0 * 1024 + h * 256 + vsp * 128;
#pragma unroll
    for (int r = 0; r < 16; ++r) { const int orow = crow(r, hi); const float rl = __builtin_amdgcn_rcpf(li_l[orow]);
#pragma unroll
        for (int d0 = 0; d0 < 4; ++d0) { const float v = o[d0][r] * rl; const float vn = __shfl_xor(v, 1);
            if ((r32 & 1) == 0) *(unsigned*)(Ow + (size_t)orow * 1024 + d0 * 32 + r32) = cvt_pk_bf16(v, vn); } }
    __syncthreads();
}
}

constexpr int STAGE_BYTES = 131072;
constexpr int MISC_OFF = STAGE_BYTES;
constexpr int XSTG_OFF = STAGE_BYTES + 256;
constexpr int LDS_BYTES = XSTG_OFF + 8 * 2304;

struct Args { const float* in[26]; float* out; unsigned char* ws; int ph_lo, ph_hi; };

struct Frame {
    LAS unsigned char* lds;
    int tid, lane, wave, G, bid;
    int gw, NGW;
    int xj, xrank, xn;
};

__device__ __forceinline__ int win_map(int n) {
    if (n < 1536) return n;
    if (n < 1600) return 7680 + (n - 1536);
    if (n < 5696) return n - 64;
    if (n < 5712) return 7744 + (n - 5696);
    return n - 80;
}
template <int MODE>
__device__ __forceinline__ void transpose_item(const float* W, int K, int N, bf16_t* WT, const float* gain, LAS float* scr, int item, int lane) {
    const int nblk = (N + 31) / 32, kb = item / nblk, nb = item % nblk, k0 = 64 * kb, n0 = 32 * nb;
    const int n4 = n0 + 4 * (lane & 7); const bool nok = n4 < N;
    f32x4 v[8];
#pragma unroll
    for (int i = 0; i < 8; ++i) v[i] = nok ? *(const f32x4*)(W + (size_t)(k0 + 8 * i + (lane >> 3)) * N + n4) : (f32x4){0.f, 0.f, 0.f, 0.f};
#pragma unroll
    for (int i = 0; i < 8; ++i) { const int kk = 8 * i + (lane >> 3); const float g = gain ? gain[k0 + kk] : 1.0f; LAS float* d = scr + kk * 33 + 4 * (lane & 7);
        d[0] = v[i][0] * g; d[1] = v[i][1] * g; d[2] = v[i][2] * g; d[3] = v[i][3] * g; }
    LDS_WAIT();
    const int c = lane & 7;
#pragma unroll
    for (int j = 0; j < 4; ++j) { const int n = (lane >> 3) + 8 * j; const LAS float* s = scr + (8 * c) * 33 + n;
        u32x4 o; o.x = cvt_pk_bf16(s[0 * 33], s[1 * 33]); o.y = cvt_pk_bf16(s[2 * 33], s[3 * 33]); o.z = cvt_pk_bf16(s[4 * 33], s[5 * 33]); o.w = cvt_pk_bf16(s[6 * 33], s[7 * 33]);
        const int ng = n0 + n;
        if (ng < N) { const int row = MODE == 1 ? win_map(ng) : ng; *(u32x4*)(WT + (size_t)row * K + k0 + 8 * c) = o; } }
    LDS_WAIT();
}
template <int MODE>
__device__ __forceinline__ void transpose_all(const Frame& F, const float* W, int K, int N, bf16_t* WT, const float* gain, int& cursor) {
    LAS float* scr = (LAS float*)(F.lds + F.wave * 8704);
    const int nitems = (K / 64) * ((N + 31) / 32);
    int first = (F.gw - cursor % F.NGW + F.NGW) % F.NGW;
    for (int it = first; it < nitems; it += F.NGW) transpose_item<MODE>(W, K, N, WT, gain, scr, it, F.lane);
    cursor += nitems;
}


__device__ __forceinline__ void p0_prologue(const Frame& F, const Args& a) {
    unsigned char* ws = a.ws;
    int cursor = 0;
    transpose_all<1>(F, a.in[5], D, IN_W, (bf16_t*)(ws + WS_WIN), a.in[4], cursor);
    transpose_all<0>(F, a.in[7], 1024, 3072, (bf16_t*)(ws + WS_WUQ), a.in[6], cursor);
    transpose_all<0>(F, a.in[9], 512, 4096, (bf16_t*)(ws + WS_WUKV), a.in[8], cursor);
    transpose_all<0>(F, a.in[14], D, D, (bf16_t*)(ws + WS_WOUT), nullptr, cursor);
    transpose_all<0>(F, a.in[16], D, 1024, (bf16_t*)(ws + WS_WCQ), a.in[15], cursor);
    transpose_all<0>(F, a.in[17], D, 1024, (bf16_t*)(ws + WS_WCK), nullptr, cursor);
    transpose_all<0>(F, a.in[18], D, 1024, (bf16_t*)(ws + WS_WCV), nullptr, cursor);
    transpose_all<0>(F, a.in[19], 1024, D, (bf16_t*)(ws + WS_WCO), nullptr, cursor);
    transpose_all<0>(F, a.in[21], D, 2048, (bf16_t*)(ws + WS_WPQ), a.in[20], cursor);
    { u32x4* z = (u32x4*)(ws + WS_WIN + (size_t)IN_W * D * 2); const size_t n16 = (size_t)(IN_WP - IN_W) * D * 2 / 16;
      for (size_t i = (size_t)F.bid * NTHREADS + F.tid; i < n16; i += (size_t)F.G * NTHREADS) z[i] = (u32x4){0u, 0u, 0u, 0u}; }
    { const float* k = a.in[22]; bf16_t* o = (bf16_t*)(ws + WS_KEYS); const size_t n8 = (size_t)8 * 2 * 128 * 128 / 8;
      for (size_t i = (size_t)F.bid * NTHREADS + F.tid; i < n8; i += (size_t)F.G * NTHREADS) {
          const f32x4 v0 = *(const f32x4*)(k + i * 8), v1 = *(const f32x4*)(k + i * 8 + 4); *(bf16x8*)(o + i * 8) = pack8(v0, v1); } }
    { const int* pos = (const int*)a.in[2]; float* cs = (float*)(ws + WS_ROPE); float* sn = cs + (size_t)M * 32;
      for (size_t i = (size_t)F.bid * NTHREADS + F.tid; i < (size_t)M * 32; i += (size_t)F.G * NTHREADS) {
          const int m = (int)(i >> 5), fi = (int)(i & 31);
          const float inv = exp2f(-(float)fi * (13.287712379549449f / 32.0f));
          const float ang = (float)pos[m] * inv;
          const float kf = rintf(ang * 0.15915494309189535f);
          float r = fmaf(-kf, 6.28125f, ang); r = fmaf(-kf, 1.9353071795864769e-3f, r);
          const float rev = r * 0.15915494309189535f;
          cs[i] = __builtin_amdgcn_cosf(rev); sn[i] = __builtin_amdgcn_sinf(rev); } }
    { const float* x = a.in[0]; bf16_t* xb = (bf16_t*)(ws + WS_XB); float* rs = (float*)(ws + WS_RSTDX);
      for (int m = F.gw; m < M; m += F.NGW) {
          const f32x4* xr = (const f32x4*)(x + (size_t)m * D); u32x2* xo = (u32x2*)(xb + (size_t)m * D); float ss = 0.f;
          f32x4 v[16];
#pragma unroll
          for (int j = 0; j < 16; ++j) v[j] = xr[F.lane + 64 * j];
#pragma unroll
          for (int j = 0; j < 16; ++j) { ss += (v[j][0] * v[j][0] + v[j][1] * v[j][1]) + (v[j][2] * v[j][2] + v[j][3] * v[j][3]);
              u32x2 p; p.x = cvt_pk_bf16(v[j][0], v[j][1]); p.y = cvt_pk_bf16(v[j][2], v[j][3]); xo[F.lane + 64 * j] = p; }
          ss = wave_sum(ss);
          if (F.lane == 0) rs[m] = 1.0f / sqrtf(ss * (1.0f / D) + EPS); } }
    { const float* mem = a.in[1]; const float* g = a.in[3]; bf16_t* mn = (bf16_t*)(ws + WS_MN);
      for (int m = F.gw; m < MROWS; m += F.NGW) {
          const f32x4* xr = (const f32x4*)(mem + (size_t)m * D); const f32x4* gr = (const f32x4*)g; u32x4* xo = (u32x4*)(mn + (size_t)m * D);
          f32x4 v[16]; float ss = 0.f;
#pragma unroll
          for (int j = 0; j < 8; ++j) { v[2 * j] = xr[2 * F.lane + 128 * j]; v[2 * j + 1] = xr[2 * F.lane + 1 + 128 * j]; }
#pragma unroll
          for (int j = 0; j < 16; ++j) ss += (v[j][0] * v[j][0] + v[j][1] * v[j][1]) + (v[j][2] * v[j][2] + v[j][3] * v[j][3]);
          ss = wave_sum(ss); const float r = 1.0f / sqrtf(ss * (1.0f / D) + EPS);
#pragma unroll
          for (int j = 0; j < 8; ++j) { const f32x4 g0 = gr[2 * F.lane + 128 * j], g1 = gr[2 * F.lane + 1 + 128 * j];
              const bf16x8 p = pack8(v[2 * j] * r * g0, v[2 * j + 1] * r * g1); xo[F.lane + 64 * j] = *(const u32x4*)&p; } } }
}


__device__ __forceinline__ unsigned short f2bf(float v) { return (unsigned short)(cvt_pk_bf16(v, 0.f) & 0xffffu); }
__device__ __forceinline__ float ssq8(bf16x8 v) { float s = 0.f;
#pragma unroll
    for (int e = 0; e < 8; ++e) { const float a = bf2f((unsigned short)v[e]); s += a * a; } return s; }
__device__ __forceinline__ void p2_stats(const Frame& F, unsigned char* ws) {
    const bf16_t* cq = (const bf16_t*)(ws + WS_CQ); const bf16_t* ckv = (const bf16_t*)(ws + WS_CKV); const bf16_t* sm = (const bf16_t*)(ws + WS_SM);
    const float* cs = (const float*)(ws + WS_ROPE); const float* sn = cs + (size_t)M * 32;
    float* rq = (float*)(ws + WS_RSTDQ); float* rkv = (float*)(ws + WS_RSTDKV); bf16_t* kr = (bf16_t*)(ws + WS_KROPE);
    for (int m = F.gw; m < M; m += F.NGW) {
        const bf16x8* a = (const bf16x8*)(cq + (size_t)m * 1024);
        float s1 = ssq8(a[2 * F.lane]) + ssq8(a[2 * F.lane + 1]);
        float s2 = ssq8(((const bf16x8*)(ckv + (size_t)m * 512))[F.lane]);
        s1 = wave_sum(s1); s2 = wave_sum(s2);
        if (F.lane == 0) { rq[m] = 1.0f / sqrtf(s1 * (1.0f / 1024.0f) + EPS); rkv[m] = 1.0f / sqrtf(s2 * (1.0f / 512.0f) + EPS); }
        if (F.lane < 32) { const float x1 = bf2f(sm[(size_t)m * 256 + F.lane]), x2 = bf2f(sm[(size_t)m * 256 + 32 + F.lane]);
            const float c = cs[(size_t)m * 32 + F.lane], s = sn[(size_t)m * 32 + F.lane];
            kr[(size_t)m * 64 + F.lane] = f2bf(x1 * c - x2 * s); kr[(size_t)m * 64 + 32 + F.lane] = f2bf(x2 * c + x1 * s); }
    }
}

__device__ __forceinline__ size_t fr_index(int cgh, int kblk, int mt, int lane, int j) { return ((((size_t)cgh * 8 + kblk) * 4 + mt) * 64 + lane) * 8 + j; }
__device__ __forceinline__ size_t kd_index(int cgh, int w, int t, int s, int lane, int j) { return (((((size_t)cgh * 8 + w) * 2 + t) * 2 + s) * 64 + lane) * 8 + j; }
__device__ __forceinline__ void p2_gla_prep(const Frame& F, unsigned char* ws, const float* __restrict__ w_gate_up, const float* __restrict__ b_gate) {
    const bf16_t* __restrict__ gq = (const bf16_t*)(ws + WS_GQ); const bf16_t* __restrict__ gk = (const bf16_t*)(ws + WS_GK); const bf16_t* __restrict__ sm = (const bf16_t*)(ws + WS_SM);
    bf16_t* __restrict__ qep = (bf16_t*)(ws + WS_QEP); bf16_t* __restrict__ kep = (bf16_t*)(ws + WS_KEP); bf16_t* __restrict__ kdt = (bf16_t*)(ws + WS_KDT); float* __restrict__ dec = (float*)(ws + WS_DEC);
    LAS float* glr = (LAS float*)F.lds;
    LAS float* tot = glr + 1024;
    LAS float* bcl = glr + 1280;
    constexpr int BP = 260;
    for (int cgh = F.bid; cgh < 1024; cgh += F.G) {
        const int cg = cgh >> 2, h = cgh & 3, t0 = cg * 64;
        __syncthreads();
        if (F.tid < 128) { const int tok = F.tid >> 1, half = F.tid & 1; const bf16x8 v = *(const bf16x8*)(sm + (size_t)(t0 + tok) * 256 + 64 + half * 8);
#pragma unroll
            for (int e = 0; e < 8; ++e) glr[tok * 16 + half * 8 + e] = bf2f((unsigned short)v[e]); }
        const int d = F.tid & 255, th = F.tid >> 8;
        float w[16];
#pragma unroll
        for (int r = 0; r < 16; ++r) w[r] = w_gate_up[r * 1024 + h * 256 + d];
        const float bg = b_gate[h * 256 + d];
        unsigned short kraw[32];
#pragma unroll
        for (int c = 0; c < 32; ++c) kraw[c] = gk[(size_t)(t0 + 32 * th + c) * 1024 + h * 256 + d];
        __syncthreads();
        float bc[32]; float cum = 0.f;
#pragma unroll
        for (int c = 0; c < 32; ++c) { float z = bg;
#pragma unroll
            for (int r4 = 0; r4 < 4; ++r4) { const f32x4 gv = *(const LAS f32x4*)(glr + (32 * th + c) * 16 + r4 * 4); z += gv[0] * w[r4 * 4] + gv[1] * w[r4 * 4 + 1] + gv[2] * w[r4 * 4 + 2] + gv[3] * w[r4 * 4 + 3]; }
            const float ls = fminf(z, 0.f) - __logf(1.0f + __expf(-fabsf(z)));
            cum += ls * (1.0f / 16.0f); bc[c] = cum; }
        if (th == 0) tot[d] = cum;
        __syncthreads();
        const float base = th ? tot[d] : 0.f;
        const float blast = th ? base + cum : 0.f;
        if (th == 1) tot[d] = blast;
#pragma unroll
        for (int c = 0; c < 32; ++c) { bc[c] += base; bcl[(32 * th + c) * BP + d] = bc[c]; }
        __syncthreads();
        const float bl = tot[d];
        if (th == 0) dec[(size_t)cgh * 256 + d] = __expf(bl);
        { const int wq = d >> 5, tq = (d >> 4) & 1, col = d & 15;
#pragma unroll
          for (int q_ = 0; q_ < 4; ++q_) { float kd8[8];
#pragma unroll
              for (int j = 0; j < 8; ++j) kd8[j] = bf2f(kraw[8 * q_ + j]) * __expf(bl - bc[8 * q_ + j]);
              *(bf16x8*)(kdt + kd_index(cgh, wq, tq, th, q_ * 16 + col, 0)) = pack8((f32x4){kd8[0], kd8[1], kd8[2], kd8[3]}, (f32x4){kd8[4], kd8[5], kd8[6], kd8[7]}); } }
        { const int c = F.tid & 63, o = F.tid >> 6; const size_t tok = (size_t)(t0 + c);
          bf16x8 qv[4], kv[4];
#pragma unroll
          for (int i = 0; i < 4; ++i) { qv[i] = *(const bf16x8*)(gq + tok * 1024 + h * 256 + 32 * o + 8 * i); kv[i] = *(const bf16x8*)(gk + tok * 1024 + h * 256 + 32 * o + 8 * i); }
          float eb[32];
#pragma unroll
          for (int i = 0; i < 8; ++i) { const f32x4 bv = *(const LAS f32x4*)(bcl + c * BP + 32 * o + 4 * i);
#pragma unroll
              for (int e = 0; e < 4; ++e) eb[4 * i + e] = __expf(bv[e]); }
#pragma unroll
          for (int q_ = 0; q_ < 4; ++q_) { float qe8[8], ke8[8];
#pragma unroll
              for (int j = 0; j < 8; ++j) { const int kk = j < 4 ? 4 * q_ + j : 16 + 4 * q_ + (j - 4);
                  const float e_ = eb[kk];
                  qe8[j] = bf2f((unsigned short)qv[kk >> 3][kk & 7]) * 0.0625f * e_; ke8[j] = bf2f((unsigned short)kv[kk >> 3][kk & 7]) * __builtin_amdgcn_rcpf(e_); }
              const size_t fi = fr_index(cgh, o, c >> 4, q_ * 16 + (c & 15), 0);
              *(bf16x8*)(qep + fi) = pack8((f32x4){qe8[0], qe8[1], qe8[2], qe8[3]}, (f32x4){qe8[4], qe8[5], qe8[6], qe8[7]});
              *(bf16x8*)(kep + fi) = pack8((f32x4){ke8[0], ke8[1], ke8[2], ke8[3]}, (f32x4){ke8[4], ke8[5], ke8[6], ke8[7]}); } }
    }
    __syncthreads();
}
__device__ __forceinline__ void p3_gla_att(const Frame& F, unsigned char* ws) {
    const bf16_t* qep = (const bf16_t*)(ws + WS_QEP); const bf16_t* kep = (const bf16_t*)(ws + WS_KEP); bf16_t* att = (bf16_t*)(ws + WS_ATT);
    const int mt = F.wave >> 1, nt0 = (F.wave & 1) * 2, col = F.lane & 15, q_ = F.lane >> 4;
    for (int cgh = F.bid; cgh < 1024; cgh += F.G) {
        f32x4 a0 = {0.f, 0.f, 0.f, 0.f}, a1 = {0.f, 0.f, 0.f, 0.f};
#pragma unroll
        for (int kb = 0; kb < 8; ++kb) { const bf16x8 A = *(const bf16x8*)(qep + fr_index(cgh, kb, mt, F.lane, 0));
            const bf16x8 B0 = *(const bf16x8*)(kep + fr_index(cgh, kb, nt0, F.lane, 0)), B1 = *(const bf16x8*)(kep + fr_index(cgh, kb, nt0 + 1, F.lane, 0));
            a0 = __builtin_amdgcn_mfma_f32_16x16x32_bf16(A, B0, a0, 0, 0, 0); a1 = __builtin_amdgcn_mfma_f32_16x16x32_bf16(A, B1, a1, 0, 0, 0); }
#pragma unroll
        for (int r = 0; r < 4; ++r) { const int c = mt * 16 + 4 * q_ + r, j0 = nt0 * 16 + col, j1 = j0 + 16;
            att[((size_t)cgh * 64 + c) * 64 + j0] = f2bf(j0 <= c ? a0[r] : 0.f); att[((size_t)cgh * 64 + c) * 64 + j1] = f2bf(j1 <= c ? a1[r] : 0.f); }
    }
}
__device__ __forceinline__ void p5_gla_scan(const Frame& F, unsigned char* ws) {
    const bf16_t* qep = (const bf16_t*)(ws + WS_QEP); const bf16_t* kdt = (const bf16_t*)(ws + WS_KDT); const bf16_t* att = (const bf16_t*)(ws + WS_ATT);
    const float* dec = (const float*)(ws + WS_DEC); const bf16_t* gv = (const bf16_t*)(ws + WS_GV); bf16_t* og = (bf16_t*)(ws + WS_OGLA);
    LAS bf16_t* vbuf = (LAS bf16_t*)F.lds;
    LAS float* red = (LAS float*)(F.lds + 4096);
    const int w = F.wave, lane = F.lane, col = lane & 15, q_ = lane >> 4;
    const int vtr = (int)(size_t)vbuf + (8 * q_ + (col >> 2)) * 32 + 8 * (col & 3);
    for (int item = F.bid; item < 256; item += F.G) {
        const int bh = item >> 5, vs = item & 31, b = bh >> 2, h = bh & 3;
        f32x4 st0 = {0.f, 0.f, 0.f, 0.f}, st1 = {0.f, 0.f, 0.f, 0.f};
        __syncthreads();
        bf16x8 vst = {};
        if (F.tid < 128) vst = *(const bf16x8*)(gv + (size_t)(b * SEQ + (F.tid >> 1)) * 2048 + h * 512 + vs * 16 + (F.tid & 1) * 8);
        if (F.tid < 128) *(LAS bf16x8*)(vbuf + (F.tid >> 1) * 16 + (F.tid & 1) * 8) = vst;
        __syncthreads();
        bf16x8 Aq[4], Ak[2][2], Aa[2] = {}; f32x4 dc0, dc1;
#define GLA_LOAD_OPS(n_) do { const int cg_ = (b * 128 + (n_)) * 4 + h;                                                                   \
            _Pragma("unroll") for (int mt = 0; mt < 4; ++mt) Aq[mt] = *(const bf16x8*)(qep + fr_index(cg_, w, mt, lane, 0));                 \
            _Pragma("unroll") for (int t = 0; t < 2; ++t) _Pragma("unroll") for (int s = 0; s < 2; ++s)                                       \
                Ak[t][s] = *(const bf16x8*)(kdt + kd_index(cg_, w, t, s, lane, 0));                                                              \
            if (w < 4) { _Pragma("unroll") for (int s = 0; s < 2; ++s) Aa[s] = *(const bf16x8*)(att + ((size_t)cg_ * 64 + 16 * w + col) * 64 + 32 * s + 8 * q_); } \
            dc0 = *(const f32x4*)(dec + (size_t)cg_ * 256 + 32 * w + 4 * q_); dc1 = *(const f32x4*)(dec + (size_t)cg_ * 256 + 32 * w + 16 + 4 * q_); } while (0)
        GLA_LOAD_OPS(0);
        for (int n = 0; n < 128; ++n) {
            const int t0 = b * SEQ + n * 64, pb = n & 1;
            if (n + 1 < 128 && F.tid < 128) vst = *(const bf16x8*)(gv + (size_t)(t0 + 64 + (F.tid >> 1)) * 2048 + h * 512 + vs * 16 + (F.tid & 1) * 8);
            bf16x8 cAq[4], cAk[2][2], cAa[2];
#pragma unroll
            for (int mt = 0; mt < 4; ++mt) cAq[mt] = Aq[mt];
#pragma unroll
            for (int t = 0; t < 2; ++t)
#pragma unroll
                for (int s = 0; s < 2; ++s) cAk[t][s] = Ak[t][s];
            cAa[0] = Aa[0]; cAa[1] = Aa[1];
            const f32x4 cdc0 = dc0, cdc1 = dc1;
            if (n + 1 < 128) GLA_LOAD_OPS(n + 1);
            bf16x8 Bv[2];
            { const int va = vtr + pb * 2048; s16x4 t0, t1, t2, t3;
              asm volatile("ds_read_b64_tr_b16 %0, %4\n\tds_read_b64_tr_b16 %1, %4 offset:128\n\tds_read_b64_tr_b16 %2, %4 offset:1024\n\tds_read_b64_tr_b16 %3, %4 offset:1152\n\ts_waitcnt lgkmcnt(0)"
                           : "=&v"(t0), "=&v"(t1), "=&v"(t2), "=&v"(t3) : "v"(va) : "memory");
              Bv[0] = (bf16x8){t0[0], t0[1], t0[2], t0[3], t1[0], t1[1], t1[2], t1[3]}; Bv[1] = (bf16x8){t2[0], t2[1], t2[2], t2[3], t3[0], t3[1], t3[2], t3[3]}; }
            u32x4 sw = {cvt_pk_bf16(st0[0], st0[1]), cvt_pk_bf16(st0[2], st0[3]), cvt_pk_bf16(st1[0], st1[1]), cvt_pk_bf16(st1[2], st1[3])};
            const bf16x8 Bs = *reinterpret_cast<bf16x8*>(&sw);
            f32x4 part[4];
#pragma unroll
            for (int mt = 0; mt < 4; ++mt) part[mt] = __builtin_amdgcn_mfma_f32_16x16x32_bf16(cAq[mt], Bs, (f32x4){0.f, 0.f, 0.f, 0.f}, 0, 0, 0);
            if (w < 4) {
#pragma unroll
                for (int mt = 0; mt < 4; ++mt) if (mt == w) {
                    part[mt] = __builtin_amdgcn_mfma_f32_16x16x32_bf16(cAa[0], Bv[0], part[mt], 0, 0, 0);
                    part[mt] = __builtin_amdgcn_mfma_f32_16x16x32_bf16(cAa[1], Bv[1], part[mt], 0, 0, 0); } }
            st0 = st0 * cdc0; st1 = st1 * cdc1;
            st0 = __builtin_amdgcn_mfma_f32_16x16x32_bf16(cAk[0][0], Bv[0], st0, 0, 0, 0); st0 = __builtin_amdgcn_mfma_f32_16x16x32_bf16(cAk[0][1], Bv[1], st0, 0, 0, 0);
            st1 = __builtin_amdgcn_mfma_f32_16x16x32_bf16(cAk[1][0], Bv[0], st1, 0, 0, 0); st1 = __builtin_amdgcn_mfma_f32_16x16x32_bf16(cAk[1][1], Bv[1], st1, 0, 0, 0);
#pragma unroll
            for (int mt = 0; mt < 4; ++mt) *(LAS f32x4*)(red + (size_t)pb * 8192 + ((w * 4 + mt) * 64 + lane) * 4) = part[mt];
            if (n + 1 < 128 && F.tid < 128) *(LAS bf16x8*)(vbuf + (pb ^ 1) * 1024 + (F.tid >> 1) * 16 + (F.tid & 1) * 8) = vst;
            __syncthreads();
            { const int e0 = F.tid * 2, mt = e0 >> 8, ln = (e0 >> 2) & 63, r0 = e0 & 3;
              float s0 = 0.f, s1 = 0.f;
#pragma unroll
              for (int ww = 0; ww < 8; ++ww) { const LAS float* p = red + (size_t)pb * 8192 + ((ww * 4 + mt) * 64 + ln) * 4 + r0; s0 += p[0]; s1 += p[1]; }
              const int c = mt * 16 + 4 * (ln >> 4) + r0, cc = ln & 15;
              og[(size_t)(t0 + c) * 2048 + h * 512 + vs * 16 + cc] = f2bf(s0); og[(size_t)(t0 + c + 1) * 2048 + h * 512 + vs * 16 + cc] = f2bf(s1); }
        }
    }
#undef GLA_LOAD_OPS
    __syncthreads();
}

__device__ __forceinline__ void p6_mix(const Frame& F, unsigned char* ws, const float* g_mla, const float* g_gla) {
    const bf16_t* om = (const bf16_t*)(ws + WS_OMLA); bf16_t* mx = (bf16_t*)(ws + WS_XB); const bf16_t* og = (const bf16_t*)(ws + WS_OGLA); const bf16_t* gog = (const bf16_t*)(ws + WS_GOG);
    for (int m = F.gw; m < M; m += F.NGW) {
        const bf16x8* a = (const bf16x8*)(om + (size_t)m * 2048); bf16x8 v[4]; float ss = 0.f;
#pragma unroll
        for (int j = 0; j < 4; ++j) { v[j] = a[F.lane + 64 * j]; ss += ssq8(v[j]); }
        ss = wave_sum(ss); const float r = 1.0f / sqrtf(ss * (1.0f / 2048.0f) + EPS);
        u32x4* o = (u32x4*)(mx + (size_t)m * D);
#pragma unroll
        for (int j = 0; j < 4; ++j) { const int c0 = (F.lane + 64 * j) * 8; const f32x4 g0 = *(const f32x4*)(g_mla + c0), g1 = *(const f32x4*)(g_mla + c0 + 4);
            f32x4 x0, x1;
#pragma unroll
            for (int e = 0; e < 4; ++e) { x0[e] = bf2f((unsigned short)v[j][e]) * r * g0[e]; x1[e] = bf2f((unsigned short)v[j][4 + e]) * r * g1[e]; }
            const bf16x8 p = pack8(x0, x1); o[F.lane + 64 * j] = *(const u32x4*)&p; }
        const bf16x8* ga = (const bf16x8*)(og + (size_t)m * 2048); const bf16x8* gg = (const bf16x8*)(gog + (size_t)m * 2048);
#pragma unroll
        for (int j = 0; j < 4; ++j) { const bf16x8 ov = ga[F.lane + 64 * j], gt = gg[F.lane + 64 * j];
            const float hs = wave_sum(ssq8(ov)); const float rh = 1.0f / sqrtf(hs * (1.0f / 512.0f) + EPS);
            const int c0 = F.lane * 8; const f32x4 g0 = *(const f32x4*)(g_gla + c0), g1 = *(const f32x4*)(g_gla + c0 + 4);
            f32x4 x0, x1;
#pragma unroll
            for (int e = 0; e < 4; ++e) { const float z0 = bf2f((unsigned short)gt[e]), z1 = bf2f((unsigned short)gt[4 + e]);
                x0[e] = bf2f((unsigned short)ov[e]) * rh * g0[e] * (z0 / (1.0f + __expf(-z0)));
                x1[e] = bf2f((unsigned short)ov[4 + e]) * rh * g1[e] * (z1 / (1.0f + __expf(-z1))); }
            const bf16x8 p = pack8(x0, x1); o[256 + F.lane + 64 * j] = *(const u32x4*)&p; }
    }
}
__device__ __forceinline__ void p4_mla(const Frame& F, unsigned char* ws) {
    const bf16_t* q = (const bf16_t*)(ws + WS_Q); const bf16_t* kv = (const bf16_t*)(ws + WS_KV); const bf16_t* kr = (const bf16_t*)(ws + WS_KROPE);
    const float* cs = (const float*)(ws + WS_ROPE); const float* sn = cs + (size_t)M * 32; bf16_t* om = (bf16_t*)(ws + WS_OMLA);
    for (int L = F.bid; L < 512; L += F.G) {
        const int xcd = L & 7, I = L >> 3, bh = xcd * 4 + (I >> 4), pr = I & 15, b = bh >> 4, h = bh & 15;
        for (int pass = 0; pass < 2; ++pass) att::mla_block((LAS char*)F.lds, q, kv, kr, cs, sn, om, b, h, pass ? pr : 31 - pr);
    }
}


__device__ __forceinline__ void rstd_for_units(const Frame& F, const pg8::StaticOrder& S, const float* __restrict__ ssq, float* __restrict__ rstd) {
    pg8::Unit u;
    for (int i = 0; S.next(i, u); ++i) {
        float v[32];
#pragma unroll
        for (int k = 0; k < 32; ++k) v[k] = ssq[(size_t)(u.pm * 256 + F.wave * 32 + k) * 64 + F.lane];
        float mine = 0.f;
#pragma unroll
        for (int k = 0; k < 32; ++k) { const float s = wave_sum(v[k]); mine = (F.lane == k) ? s : mine; }
        if (F.lane < 32) rstd[u.pm * 256 + F.wave * 32 + F.lane] = 1.0f / sqrtf(mine * (1.0f / D) + EPS);
    }
    asm volatile("s_waitcnt vmcnt(0)" ::: "memory");
    __syncthreads();
}
__device__ __forceinline__ void p9_xattn(const Frame& F, unsigned char* ws) {
    const bf16_t* qc = (const bf16_t*)(ws + WS_QC); const bf16_t* kc = (const bf16_t*)(ws + WS_KC); const bf16_t* vc = (const bf16_t*)(ws + WS_VC); bf16_t* oc = (bf16_t*)(ws + WS_OC);
    for (int L = F.bid; L < 512; L += F.G) { const int h = L & 3, blk = L >> 2, b = blk >> 6, qb = blk & 63;
        att::xattn_block((LAS char*)F.lds, qc, kc, vc, oc, b, h, qb); }
}


typedef float f32x2 __attribute__((ext_vector_type(2)));
__device__ __forceinline__ bool fp4_probe_ok() {
    float a = 1.0f, b = 3.0f, c = 0.5f, d = 6.0f; asm volatile("" : "+v"(a), "+v"(b), "+v"(c), "+v"(d));
    unsigned w = 0u;
    w = __builtin_amdgcn_cvt_scalef32_pk_fp4_f32(w, a, b, 1.0f, 0); w = __builtin_amdgcn_cvt_scalef32_pk_fp4_f32(w, c, d, 1.0f, 3);
    const f32x2 y0 = __builtin_amdgcn_cvt_scalef32_pk_f32_fp4(w, 1.0f, 0), y3 = __builtin_amdgcn_cvt_scalef32_pk_f32_fp4(w, 1.0f, 3), y1 = __builtin_amdgcn_cvt_scalef32_pk_f32_fp4(w, 1.0f, 1);
    return y0.x == 1.0f && y0.y == 3.0f && y3.x == 0.5f && y3.y == 6.0f && y1.x == 0.0f && y1.y == 0.0f;
}
#define DPP_MAX(v, ctrl) (v) = fmaxf((v), __int_as_float(__builtin_amdgcn_update_dpp(0, __float_as_int(v), (ctrl), 0xF, 0xF, false)))
__device__ __forceinline__ void peer_tables_to_fp4(const Frame& F, unsigned char* ws, const float* pu, const float* pv) {
    const bool ok = fp4_probe_ok();
    for (int r = F.gw; r < 2 * 16384; r += F.NGW) {
        const int tab = r >= 16384, row = r & 16383;
        const float* srow = (tab ? pv : pu) + (size_t)row * D;
        unsigned char* vals = ws + (tab ? WS_VB : WS_UB); float* rsc = (float*)(ws + (tab ? WS_VSC : WS_USC));
        float ss = 0.f, am = 0.f;
#pragma unroll
        for (int kh = 0; kh < 2; ++kh) { f32x4 v[8];
#pragma unroll
            for (int k8 = 0; k8 < 8; ++k8) v[k8] = *(const f32x4*)(srow + (kh * 8 + k8) * 256 + F.lane * 4);
#pragma unroll
            for (int k8 = 0; k8 < 8; ++k8) { ss += (v[k8][0] * v[k8][0] + v[k8][1] * v[k8][1]) + (v[k8][2] * v[k8][2] + v[k8][3] * v[k8][3]);
                am = fmaxf(am, fmaxf(fmaxf(fabsf(v[k8][0]), fabsf(v[k8][1])), fmaxf(fabsf(v[k8][2]), fabsf(v[k8][3])))); } }
        ss = wave_sum(ss);
        DPP_MAX(am, 0xB1); DPP_MAX(am, 0x4E); DPP_MAX(am, 0x141); DPP_MAX(am, 0x140);
        am = fmaxf(fmaxf(__int_as_float(__builtin_amdgcn_readlane(__float_as_int(am), 0)), __int_as_float(__builtin_amdgcn_readlane(__float_as_int(am), 16))),
                   fmaxf(__int_as_float(__builtin_amdgcn_readlane(__float_as_int(am), 32)), __int_as_float(__builtin_amdgcn_readlane(__float_as_int(am), 48))));
        const float top = fminf(am, 3.0f * sqrtf(ss * (1.0f / D)));
        const float sc = top > 0.f ? top * (1.0f / 6.0f) : 1.0f, inv = 1.0f / sc;
        if (F.lane == 0) rsc[row] = ok ? sc : __uint_as_float(0x7FC00000u);
#pragma unroll
        for (int kh = 0; kh < 2; ++kh) { f32x4 v[8];
#pragma unroll
            for (int k8 = 0; k8 < 8; ++k8) v[k8] = *(const f32x4*)(srow + (kh * 8 + k8) * 256 + F.lane * 4);
#pragma unroll
            for (int k8 = 0; k8 < 8; ++k8) { const int k = kh * 8 + k8;
                const float q0 = fminf(fmaxf(v[k8][0] * inv, -6.0f), 6.0f), q1 = fminf(fmaxf(v[k8][1] * inv, -6.0f), 6.0f), q2 = fminf(fmaxf(v[k8][2] * inv, -6.0f), 6.0f), q3 = fminf(fmaxf(v[k8][3] * inv, -6.0f), 6.0f);
                unsigned p = 0u;
                p = __builtin_amdgcn_cvt_scalef32_pk_fp4_f32(p, q0, q1, 1.0f, 0); p = __builtin_amdgcn_cvt_scalef32_pk_fp4_f32(p, q2, q3, 1.0f, 1);
                const size_t sl = (size_t)(k >> 1) * 16384 + row;
                *(unsigned short*)(vals + sl * 256 + (k & 1) * 128 + 2 * F.lane) = (unsigned short)p; } }
    }
}
#define CE_(a, b) do { const float hi_ = fmaxf(a, b), lo_ = fminf(a, b); a = hi_; b = lo_; } while (0)
__device__ __forceinline__ void sort16_desc(float (&v)[16]) {
    CE_(v[0], v[1]); CE_(v[2], v[3]); CE_(v[0], v[2]); CE_(v[1], v[3]); CE_(v[1], v[2]); CE_(v[4], v[5]); CE_(v[6], v[7]); CE_(v[4], v[6]); CE_(v[5], v[7]); CE_(v[5], v[6]); CE_(v[0], v[4]); CE_(v[2], v[6]); CE_(v[2], v[4]); CE_(v[1], v[5]); CE_(v[3], v[7]); CE_(v[3], v[5]); CE_(v[1], v[2]); CE_(v[3], v[4]); CE_(v[5], v[6]); CE_(v[8], v[9]); CE_(v[10], v[11]); CE_(v[8], v[10]); CE_(v[9], v[11]); CE_(v[9], v[10]); CE_(v[12], v[13]); CE_(v[14], v[15]); CE_(v[12], v[14]); CE_(v[13], v[15]); CE_(v[13], v[14]); CE_(v[8], v[12]); CE_(v[10], v[14]); CE_(v[10], v[12]); CE_(v[9], v[13]); CE_(v[11], v[15]); CE_(v[11], v[13]); CE_(v[9], v[10]); CE_(v[11], v[12]); CE_(v[13], v[14]); CE_(v[0], v[8]); CE_(v[4], v[12]); CE_(v[4], v[8]); CE_(v[2], v[10]); CE_(v[6], v[14]); CE_(v[6], v[10]); CE_(v[2], v[4]); CE_(v[6], v[8]); CE_(v[10], v[12]); CE_(v[1], v[9]); CE_(v[5], v[13]); CE_(v[5], v[9]); CE_(v[3], v[11]); CE_(v[7], v[15]); CE_(v[7], v[11]); CE_(v[3], v[5]); CE_(v[7], v[9]); CE_(v[11], v[13]); CE_(v[1], v[2]); CE_(v[3], v[4]); CE_(v[5], v[6]); CE_(v[7], v[8]); CE_(v[9], v[10]); CE_(v[11], v[12]); CE_(v[13], v[14]);
}
__device__ __forceinline__ void bitonic16_desc(float (&v)[16]) {
    CE_(v[0], v[8]); CE_(v[1], v[9]); CE_(v[2], v[10]); CE_(v[3], v[11]); CE_(v[4], v[12]); CE_(v[5], v[13]); CE_(v[6], v[14]); CE_(v[7], v[15]); CE_(v[0], v[4]); CE_(v[1], v[5]); CE_(v[2], v[6]); CE_(v[3], v[7]); CE_(v[8], v[12]); CE_(v[9], v[13]); CE_(v[10], v[14]); CE_(v[11], v[15]); CE_(v[0], v[2]); CE_(v[1], v[3]); CE_(v[4], v[6]); CE_(v[5], v[7]); CE_(v[8], v[10]); CE_(v[9], v[11]); CE_(v[12], v[14]); CE_(v[13], v[15]); CE_(v[0], v[1]); CE_(v[2], v[3]); CE_(v[4], v[5]); CE_(v[6], v[7]); CE_(v[8], v[9]); CE_(v[10], v[11]); CE_(v[12], v[13]); CE_(v[14], v[15]);
}

__device__ __forceinline__ void merge_top16(float (&a)[16], const float (&b)[16]) {
#pragma unroll
    for (int i = 0; i < 16; ++i) a[i] = fmaxf(a[i], b[15 - i]);
    bitonic16_desc(a);
}
__device__ __forceinline__ void top16_of_64(const float (&s)[64], float (&t)[16]) {
    float g1[16], g2[16], g3[16];
#pragma unroll
    for (int i = 0; i < 16; ++i) { t[i] = s[i]; g1[i] = s[16 + i]; g2[i] = s[32 + i]; g3[i] = s[48 + i]; }
    sort16_desc(t); sort16_desc(g1); sort16_desc(g2); sort16_desc(g3);
    merge_top16(t, g1); merge_top16(g2, g3); merge_top16(t, g2);
}
__device__ __forceinline__ void p12_keys_to_lds(const Frame& F, unsigned char* ws) {
    const bf16_t* keys = (const bf16_t*)(ws + WS_KEYS) + (size_t)(F.bid & 7) * 256 * 128;
#pragma unroll
    for (int i = 0; i < 8; ++i) { const int gch = F.tid + 512 * i, R = gch >> 4, c = gch & 15;
        *(LAS u32x4*)(F.lds + R * 256 + ((c ^ (R & 15)) * 16)) = *(const u32x4*)(keys + (size_t)R * 128 + c * 8); }
}
__device__ __forceinline__ void p12_topk(const Frame& F, unsigned char* ws) {
    const bf16_t* qp = (const bf16_t*)(ws + WS_QP); int* ids = (int*)(ws + WS_IDS); float* gates = (float*)(ws + WS_GATES);
    const float NEG = -__builtin_inff();
    const int ngrp = (F.G - 1 - (F.bid & 7)) / 8 + 1;
#pragma unroll 1
    for (int it = 0; ; ++it) {
        const int tg = ((F.bid >> 3) + it * ngrp) * 8 + F.wave; if (tg >= 512) break;
        int lane_ = F.lane; asm volatile("" : "+v"(lane_));
        const int tok = lane_ & 31, hi = lane_ >> 5;
        const int h = F.bid & 7, token = tg * 32 + tok;
        float top[2][16];
#pragma unroll
        for (int p = 0; p < 2; ++p) {
            bf16x8 qr[8];
#pragma unroll
            for (int d0 = 0; d0 < 8; ++d0) qr[d0] = *(const bf16x8*)(qp + (size_t)token * 2048 + h * 256 + p * 128 + d0 * 16 + hi * 8);
            float s[64];
#pragma unroll
            for (int kb = 0; kb < 4; ++kb) { f32x16 acc = {};
                const int R = p * 128 + kb * 32 + tok; const LAS unsigned char* kl = F.lds + R * 256;
#pragma unroll
                for (int d0 = 0; d0 < 8; ++d0) acc = __builtin_amdgcn_mfma_f32_32x32x16_bf16(*(const LAS bf16x8*)(kl + (((2 * d0 + hi) ^ (R & 15)) * 16)), qr[d0], acc, 0, 0, 0);
#pragma unroll
                for (int r = 0; r < 16; ++r) { const int idx = kb * 32 + (r & 3) + 8 * (r >> 2) + 4 * hi;
                    s[kb * 16 + r] = __uint_as_float((__float_as_uint(acc[r]) & ~0x7Fu) | (unsigned)(127 - idx)); } }
            float t[16]; top16_of_64(s, t);
            float pt[16];
#pragma unroll
            for (int i = 0; i < 16; ++i) { const unsigned own = __float_as_uint(t[i]); auto rr = __builtin_amdgcn_permlane32_swap(own, own, false, false); pt[i] = __uint_as_float(rr[0] ^ rr[1] ^ own); }
            merge_top16(t, pt);
#pragma unroll
            for (int i = 0; i < 16; ++i) top[p][i] = t[i];
        }
        float c[64], cs_[16];
#define CAND_(k, i, j) c[k] = __uint_as_float((__float_as_uint(top[0][i] + top[1][j]) & ~0xFFu) | (unsigned)(255 - ((i) * 16 + (j))))
        CAND_(0, 0, 0); CAND_(1, 0, 1); CAND_(2, 0, 2); CAND_(3, 0, 3); CAND_(4, 0, 4); CAND_(5, 0, 5); CAND_(6, 0, 6); CAND_(7, 0, 7); CAND_(8, 0, 8); CAND_(9, 0, 9); CAND_(10, 0, 10); CAND_(11, 0, 11); CAND_(12, 0, 12); CAND_(13, 0, 13); CAND_(14, 0, 14); CAND_(15, 0, 15); CAND_(16, 1, 0); CAND_(17, 1, 1); CAND_(18, 1, 2); CAND_(19, 1, 3); CAND_(20, 1, 4); CAND_(21, 1, 5); CAND_(22, 1, 6); CAND_(23, 1, 7); CAND_(24, 2, 0); CAND_(25, 2, 1); CAND_(26, 2, 2); CAND_(27, 2, 3); CAND_(28, 2, 4); CAND_(29, 3, 0); CAND_(30, 3, 1); CAND_(31, 3, 2); CAND_(32, 3, 3); CAND_(33, 4, 0); CAND_(34, 4, 1); CAND_(35, 4, 2); CAND_(36, 5, 0); CAND_(37, 5, 1); CAND_(38, 6, 0); CAND_(39, 6, 1); CAND_(40, 7, 0); CAND_(41, 7, 1); CAND_(42, 8, 0); CAND_(43, 9, 0); CAND_(44, 10, 0); CAND_(45, 11, 0); CAND_(46, 12, 0); CAND_(47, 13, 0); CAND_(48, 14, 0); CAND_(49, 15, 0);
#undef CAND_
#pragma unroll
        for (int k = 50; k < 64; ++k) c[k] = NEG;
        top16_of_64(c, cs_);
        int ex[16];
#pragma unroll
        for (int k = 0; k < 16; ++k) { const int flat = 255 - (int)(__float_as_uint(cs_[k]) & 0xFFu), ci = flat >> 4, cj = flat & 15;
            float t0 = top[0][0], t1 = top[1][0];
#pragma unroll
            for (int t = 1; t < 16; ++t) { t0 = (ci == t) ? top[0][t] : t0; t1 = (cj == t) ? top[1][t] : t1; }
            const int i1 = 127 - (int)(__float_as_uint(t0) & 0x7Fu), i2 = 127 - (int)(__float_as_uint(t1) & 0x7Fu);
            ex[k] = i1 * 128 + i2; }
        float den = 0.f, ev[16];
#pragma unroll
        for (int k = 0; k < 16; ++k) { ev[k] = __expf(cs_[k] - cs_[0]); den += ev[k]; }
        const float rden = 1.0f / den;
        const size_t ob = ((size_t)token * 8 + h) * 16;
        if (hi == 0) {
#pragma unroll
            for (int k4 = 0; k4 < 4; ++k4) *(int4*)(ids + ob + k4 * 4) = make_int4(ex[k4 * 4], ex[k4 * 4 + 1], ex[k4 * 4 + 2], ex[k4 * 4 + 3]); }
        else {
#pragma unroll
            for (int k4 = 0; k4 < 4; ++k4) *(f32x4*)(gates + ob + k4 * 4) = (f32x4){ev[k4 * 4] * rden, ev[k4 * 4 + 1] * rden, ev[k4 * 4 + 2] * rden, ev[k4 * 4 + 3] * rden}; }
    }
}
__device__ __forceinline__ float gelu_erf(float v) {
    const float av = fabsf(v), t = __builtin_amdgcn_rcpf(fmaf(av, 0.2316418882f, 1.0f));
    float q = fmaf(t, 0.5307027145f, -0.7265760135f); q = fmaf(q, t, 0.7107068705f); q = fmaf(q, t, -0.142248368f); q = fmaf(q, t, 0.127414796f); q = q * t;
    const float e = __builtin_amdgcn_exp2f(v * v * -0.72134752044f), m = v * (q * e);
    return v < 0.f ? m : v - m;
}
struct PRow { u32x4 v; };
#define ROW16_ADD(v) do { DPP_ADD(v, 0xB1, 0xF); DPP_ADD(v, 0x4E, 0xF); DPP_ADD(v, 0x141, 0xF); DPP_ADD(v, 0x140, 0xF); } while (0)
#define PW_LOAD(W, q0, idp, vb, sb) do { const u32x4 ia_ = *(const LAS u32x4*)((idp) + (q0)), ib_ = *(const LAS u32x4*)((idp) + (q0) + 4); \
        _Pragma("unroll") for (int r_ = 0; r_ < 8; ++r_) { const unsigned id_ = r_ < 4 ? ia_[r_ & 3] : ib_[r_ & 3]; \
            W[r_].v = *(const u32x4*)((vb) + ((id_ << 8) + i16)); } } while (0)
#define PD_COMP(W, q0, ap) do { const u32x4 ta1_ = *(const LAS u32x4*)((ap) + (q0)), tb1_ = *(const LAS u32x4*)((ap) + (q0) + 4), tas_ = *(const LAS u32x4*)((ap) + 256 + (q0)), tbs_ = *(const LAS u32x4*)((ap) + 256 + (q0) + 4); \
        _Pragma("unroll") for (int r_ = 0; r_ < 8; ++r_) { const unsigned d1_ = r_ < 4 ? ta1_[r_ & 3] : tb1_[r_ & 3]; const int s1_ = (int)(r_ < 4 ? tas_[r_ & 3] : tbs_[r_ & 3]); \
            const i32x8 A8_ = {(int)W[r_].v.x, (int)W[r_].v.y, (int)W[r_].v.z, (int)W[r_].v.w, 0, 0, 0, 0}; \
            if (r_ & 1) { Q1a[0] = (int)(d1_ & mlo); Q1a[1] = (int)(d1_ & mhi); Q1b[2] = Q1a[0]; Q1b[3] = Q1a[1]; \
                y[2] = __builtin_amdgcn_mfma_scale_f32_16x16x128_f8f6f4(A8_, Q1a, y[2], 4, 4, 0, 127, 0, s1_); y[3] = __builtin_amdgcn_mfma_scale_f32_16x16x128_f8f6f4(A8_, Q1b, y[3], 4, 4, 0, 127, 0, s1_); } \
            else { P1a[0] = (int)(d1_ & mlo); P1a[1] = (int)(d1_ & mhi); P1b[2] = P1a[0]; P1b[3] = P1a[1]; \
                y[0] = __builtin_amdgcn_mfma_scale_f32_16x16x128_f8f6f4(A8_, P1a, y[0], 4, 4, 0, 127, 0, s1_); y[1] = __builtin_amdgcn_mfma_scale_f32_16x16x128_f8f6f4(A8_, P1b, y[1], 4, 4, 0, 127, 0, s1_); } } \
        __builtin_amdgcn_sched_barrier(0); } while (0)
#define BF_LO(w) __uint_as_float((w) << 16)
#define BF_HI(w) __uint_as_float((w) & 0xffff0000u)
#define FP4X2(q, k) __builtin_amdgcn_cvt_scalef32_pk_f32_fp4((q), 1.0f, (k))
__device__ __forceinline__ void p12c_quant(const Frame& F, unsigned char* ws, const float* g_ffn) {
    const bf16_t* h2b = (const bf16_t*)(ws + WS_H2B); unsigned char* xq = ws + WS_XQ; unsigned char* xsc = ws + WS_XQS;
    const bool ok = fp4_probe_ok();
#pragma unroll 1
    for (int token = F.gw; token < M; token += F.NGW) {
        int lane_ = F.lane; asm volatile("" : "+v"(lane_)); const int lane = lane_;
#pragma unroll
        for (int blk = 0; blk < 2; ++blk) { const int c0 = 64 * lane + 32 * blk;
            float v[32];
#pragma unroll
            for (int m = 0; m < 4; ++m) { const u32x4 hw = *(const u32x4*)(h2b + (size_t)token * D + c0 + 8 * m); const f32x4 g0 = *(const f32x4*)(g_ffn + c0 + 8 * m), g1 = *(const f32x4*)(g_ffn + c0 + 8 * m + 4);
                v[8 * m + 0] = BF_LO(hw.x) * g0[0]; v[8 * m + 1] = BF_HI(hw.x) * g0[1]; v[8 * m + 2] = BF_LO(hw.y) * g0[2]; v[8 * m + 3] = BF_HI(hw.y) * g0[3];
                v[8 * m + 4] = BF_LO(hw.z) * g1[0]; v[8 * m + 5] = BF_HI(hw.z) * g1[1]; v[8 * m + 6] = BF_LO(hw.w) * g1[2]; v[8 * m + 7] = BF_HI(hw.w) * g1[3]; }
#pragma unroll
            for (int term = 0; term < 2; ++term) { float am = 0.f;
#pragma unroll
                for (int k = 0; k < 32; ++k) am = fmaxf(am, fabsf(v[k]));
                const unsigned rb = __float_as_uint(am * (1.0f / 6.0f));
                int e = (int)(rb >> 23) - 127 + ((rb & 0x7FFFFFu) != 0u ? 1 : 0); e = e < -120 ? -120 : (e > 120 ? 120 : e);
                const float inv = __uint_as_float((unsigned)(127 - e) << 23), sc = __uint_as_float((unsigned)(127 + e) << 23);
                unsigned w[4];
#pragma unroll
                for (int k = 0; k < 4; ++k) { unsigned d = 0u;
                    d = __builtin_amdgcn_cvt_scalef32_pk_fp4_f32(d, v[8 * k] * inv, v[8 * k + 1] * inv, 1.0f, 0); d = __builtin_amdgcn_cvt_scalef32_pk_fp4_f32(d, v[8 * k + 2] * inv, v[8 * k + 3] * inv, 1.0f, 1);
                    d = __builtin_amdgcn_cvt_scalef32_pk_fp4_f32(d, v[8 * k + 4] * inv, v[8 * k + 5] * inv, 1.0f, 2); d = __builtin_amdgcn_cvt_scalef32_pk_fp4_f32(d, v[8 * k + 6] * inv, v[8 * k + 7] * inv, 1.0f, 3);
                    w[k] = d;
                    if (term == 0) { const f32x2 y0 = FP4X2(d, 0), y1 = FP4X2(d, 1), y2 = FP4X2(d, 2), y3 = FP4X2(d, 3);
                        v[8 * k] -= y0.x * sc; v[8 * k + 1] -= y0.y * sc; v[8 * k + 2] -= y1.x * sc; v[8 * k + 3] -= y1.y * sc; v[8 * k + 4] -= y2.x * sc; v[8 * k + 5] -= y2.y * sc; v[8 * k + 6] -= y3.x * sc; v[8 * k + 7] -= y3.y * sc; } }
                *(u32x4*)(xq + (size_t)term * M * 2048 + (size_t)token * 2048 + c0 / 2) = (u32x4){w[0], w[1], w[2], w[3]};
                xsc[(size_t)term * M * 128 + (size_t)token * 128 + 2 * lane + blk] = (unsigned char)(ok ? (unsigned)(e + 127) : 255u); }
        }
    }
}
typedef int i32x8 __attribute__((ext_vector_type(8)));
#define UG_LOAD(SB, TB, CB, idp) do { _Pragma("unroll") for (int tt_ = 0; tt_ < 4; ++tt_) _Pragma("unroll") for (int h_ = 0; h_ < 2; ++h_) { const unsigned id_ = (idp)[16 * ((TB) + tt_) + 8 * h_]; \
        __builtin_amdgcn_global_load_lds((const unsigned*)(uvj + ((id_ << 8) + 64u * (CB) + gsw16)), (LAS unsigned*)(slots + ((SB) + tt_ * 2 + h_) * 1024), 16, 0, 0); } \
        __builtin_amdgcn_sched_barrier(0); } while (0)
#define BPERM(v) ((unsigned)__builtin_amdgcn_ds_bpermute(pa, (int)(v)))
#define UG_COMP(SB, TB, CB, xp, NV) do { asm volatile("s_waitcnt vmcnt(" #NV ")" ::: "memory"); __builtin_amdgcn_sched_barrier(0); \
        u32x4 P_[8]; _Pragma("unroll") for (int tt_ = 0; tt_ < 4; ++tt_) { P_[tt_ * 2] = *(const LAS u32x4*)(slots + ((SB) + tt_ * 2) * 1024 + rdo0); P_[tt_ * 2 + 1] = *(const LAS u32x4*)(slots + ((SB) + tt_ * 2) * 1024 + rdo1); } \
        _Pragma("unroll") for (int cc_ = 0; cc_ < 2; ++cc_) { const int c_ = (CB) + cc_; \
            const u32x4 b0_ = *(const LAS u32x4*)((xp) + 64 * c_), b1_ = *(const LAS u32x4*)((xp) + 256 + 64 * c_); \
            const int s0_ = (int)*(const LAS unsigned char*)((xp) + 512 + 4 * c_ - 15 * kq), s1_ = (int)*(const LAS unsigned char*)((xp) + 528 + 4 * c_ - 15 * kq); \
            const i32x8 x0_ = {(int)b0_.x, (int)b0_.y, (int)b0_.z, (int)b0_.w, 0, 0, 0, 0}, x1_ = {(int)b1_.x, (int)b1_.y, (int)b1_.z, (int)b1_.w, 0, 0, 0, 0}; \
            _Pragma("unroll") for (int tt_ = 0; tt_ < 4; ++tt_) { const u32x4 q_ = P_[tt_ * 2 + cc_]; const i32x8 A8_ = {(int)q_.x, (int)q_.y, (int)q_.z, (int)q_.w, 0, 0, 0, 0}; \
                dacc[(TB) + tt_] = __builtin_amdgcn_mfma_scale_f32_16x16x128_f8f6f4(A8_, x0_, dacc[(TB) + tt_], 4, 4, 0, 127, 0, s0_); } \
            _Pragma("unroll") for (int tt_ = 0; tt_ < 4; ++tt_) { const u32x4 q_ = P_[tt_ * 2 + cc_]; const i32x8 A8_ = {(int)q_.x, (int)q_.y, (int)q_.z, (int)q_.w, 0, 0, 0, 0}; \
                dacc[(TB) + tt_] = __builtin_amdgcn_mfma_scale_f32_16x16x128_f8f6f4(A8_, x1_, dacc[(TB) + tt_], 4, 4, 0, 127, 0, s1_); } } \
        __builtin_amdgcn_sched_barrier(0); } while (0)
__device__ __forceinline__ void p13a_up(const Frame& F, unsigned char* ws) {
    const int j = F.xj, lw = F.xrank * NWAVES + F.wave, nw = F.xn * NWAVES;
    int lane_ = F.lane; asm volatile("" : "+v"(lane_));
    const int lane = lane_, r = lane & 15, kq = lane >> 4, ge = lane >> 2; const unsigned gp4 = 4u * (unsigned)(lane & 3), l4 = 4u * (unsigned)lane;
    const unsigned gsw16 = 16u * (unsigned)((lane & 7) ^ ((lane >> 3) & 6));
    const int rdo0 = (r >> 3) * 1024 + 128 * (r & 7) + 16 * (kq ^ (r & 6)), rdo1 = (r >> 3) * 1024 + 128 * (r & 7) + 16 * ((4 + kq) ^ (r & 6));
    const unsigned char* uvj = ws + WS_UB + (size_t)j * 16384 * 256; const unsigned char* usj = ws + WS_UB + PEER_VAL_BYTES + (size_t)j * 16384 * 16;
    const unsigned char* ids = ws + WS_IDS;
    const unsigned char* xq = ws + WS_XQ + (size_t)(lane >> 5) * M * 2048 + 256 * j + 8 * (lane & 31);
    const unsigned char* xsc = ws + WS_XQS + (size_t)((lane >> 4) & 1) * M * 128 + 16 * j + (lane & 15);
    float* pd = (float*)(ws + WS_PD) + (size_t)j * M * 128 + 4 * kq;
    LAS unsigned char* wl = F.lds + XSTG_OFF + F.wave * 2304; LAS unsigned char* slots = F.lds + F.wave * 16384;
    int t = lw; if (t >= M) return;
    { LAS unsigned* il = (LAS unsigned*)wl; const unsigned char* ip = ids + (size_t)t * 512; il[lane] = *(const unsigned*)(ip + l4); il[64 + lane] = *(const unsigned*)(ip + 256 + l4);
      *(LAS u32x2*)(wl + 512 + 8 * lane) = *(const u32x2*)(xq + (size_t)t * 2048); if (lane < 32) wl[1024 + lane] = xsc[(size_t)t * 128]; }
    UG_LOAD(0, 0, 0, (const LAS unsigned*)wl + (lane >> 3));
    asm volatile("s_waitcnt vmcnt(0)" ::: "memory");
    int buf = 0;
#pragma unroll 1
    for (; t < M; t += nw) {
        const int tn = (t + nw < M) ? t + nw : t;
        const LAS unsigned char* cb = wl + buf * 1152; LAS unsigned char* nb = wl + (buf ^ 1) * 1152;
        const LAS unsigned* idc = (const LAS unsigned*)cb + (lane >> 3); const LAS unsigned char* xc = cb + 512 + 16 * kq;
        const unsigned char* ip = ids + (size_t)tn * 512; const unsigned idn0 = *(const unsigned*)(ip + l4), idn1 = *(const unsigned*)(ip + 256 + l4);
        const u32x2 xn = *(const u32x2*)(xq + (size_t)tn * 2048); const unsigned char sn = xsc[(size_t)tn * 128];
        __builtin_amdgcn_sched_barrier(0);
        f32x4 dacc[8];
#pragma unroll
        for (int T = 0; T < 8; ++T) dacc[T] = (f32x4){0.f, 0.f, 0.f, 0.f};
        UG_LOAD(8, 4, 0, idc); UG_COMP(0, 0, 0, xc, 8);
        UG_LOAD(0, 0, 2, idc); UG_COMP(8, 4, 0, xc, 8);
        { LAS unsigned* il = (LAS unsigned*)nb; il[lane] = idn0; il[64 + lane] = idn1; *(LAS u32x2*)(nb + 512 + 8 * lane) = xn; if (lane < 32) nb[1024 + lane] = sn; }
        UG_LOAD(8, 4, 2, idc); UG_COMP(0, 0, 2, xc, 8);
        UG_LOAD(0, 0, 0, (const LAS unsigned*)nb + (lane >> 3));
        UG_COMP(8, 4, 2, xc, 8);
#pragma unroll
        for (int T = 0; T < 8; ++T) asm volatile("" : "+v"(dacc[T]));
        if (r == 0) {
#pragma unroll
            for (int T = 0; T < 8; ++T) *(f32x4*)(pd + (size_t)t * 128 + 16 * T) = dacc[T]; }
        buf ^= 1;
    }
}
__device__ __forceinline__ unsigned fp4_code_scale(float v, float& back) {
    const unsigned rb = __float_as_uint(fabsf(v) * (1.0f / 6.0f));
    int e = (int)(rb >> 23) - 127 + ((rb & 0x7FFFFFu) != 0u ? 1 : 0); e = e < -120 ? -120 : (e > 120 ? 120 : e);
    const float inv = __uint_as_float((unsigned)(127 - e) << 23), sc = __uint_as_float((unsigned)(127 + e) << 23);
    const unsigned by = __builtin_amdgcn_cvt_scalef32_pk_fp4_f32(0u, v * inv, v * inv, 1.0f, 0);
    const f32x2 dd = FP4X2(by, 0); back = dd.x * sc;
    return (by & 0xFu) | ((unsigned)(e + 127) << 8);
}
__device__ __forceinline__ void p13b_act(const Frame& F, unsigned char* ws) {
    const float* pd = (const float*)(ws + WS_PD); float* gates = (float*)(ws + WS_GATES); const float* ssq2 = (const float*)(ws + WS_SSQ2); unsigned* act = (unsigned*)(ws + WS_ACT);
    const int* ids = (const int*)(ws + WS_IDS); const float* usc = (const float*)(ws + WS_USC); const float* vsc = (const float*)(ws + WS_VSC);
    const bool ok = fp4_probe_ok();
#pragma unroll 1
    for (int token = F.gw; token < M; token += F.NGW) {
        const float r2 = 1.0f / sqrtf(wave_sum(ssq2[(size_t)token * 64 + F.lane]) * (1.0f / D) + EPS);
#pragma unroll
        for (int hh = 0; hh < 2; ++hh) { const size_t o = (size_t)token * 128 + hh * 64 + F.lane; float d = 0.f;
#pragma unroll
            for (int jj = 0; jj < 8; ++jj) d += pd[(size_t)jj * M * 128 + o];
            const int id = ids[o];
            const float a = gelu_erf(d * r2 * usc[id]) * gates[o] * vsc[id];
            float b1; const unsigned t1 = fp4_code_scale(a, b1);
            act[o] = (t1 & 0xFu) * 0x11111111u;
            act[(size_t)M * 128 + o] = ok ? ((t1 >> 8) & 0xFFu) : 0xFFu; }
    }
}
__device__ __forceinline__ void p13c_down(const Frame& F, unsigned char* ws) {
    const int j = F.xj, lw = F.xrank * NWAVES + F.wave, nw = F.xn * NWAVES;
    int lane_ = F.lane; asm volatile("" : "+v"(lane_));
    const int lane = lane_, g = lane >> 4, i = lane & 15; const unsigned i16 = 16u * (unsigned)i, sidx = (unsigned)((i & 3) * 4 + (i >> 2)), l4 = 4u * (unsigned)lane;
    const unsigned sh = 4u * (unsigned)(i & 7), mlo = i < 8 ? (0xFu << sh) : 0u, mhi = i >= 8 ? (0xFu << sh) : 0u;
    i32x8 P1a = {0, 0, 0, 0, 0, 0, 0, 0}, P1b = P1a, Q1a = P1a, Q1b = P1a;
    const unsigned char* vvj = ws + WS_VB + (size_t)j * 16384 * 256; const unsigned char* vsj = ws + WS_VB + PEER_VAL_BYTES + (size_t)j * 16384 * 16;
    const unsigned char* ids = ws + WS_IDS; const unsigned char* av = ws + WS_ACT;
    const bf16_t* h2b = (const bf16_t*)(ws + WS_H2B) + 512 * j + 128 * g + i; bf16_t* h3b = (bf16_t*)(ws + WS_H3B) + 512 * j + 128 * g + i; float* ssq3 = (float*)(ws + WS_SSQ3);
    LAS unsigned* idl = (LAS unsigned*)(F.lds + F.wave * 4096);
    LAS unsigned* al = idl + 256;
    constexpr size_t ASTR = (size_t)M * 128 * 4;
    int t = lw; if (t >= M) return;
    { const unsigned char* ip = ids + (size_t)t * 512; const unsigned char* ap = av + (size_t)t * 512;
      idl[lane] = *(const unsigned*)(ip + l4); idl[64 + lane] = *(const unsigned*)(ip + 256 + l4);
#pragma unroll
      for (int k = 0; k < 2; ++k) { al[256 * k + lane] = *(const unsigned*)(ap + k * ASTR + l4); al[256 * k + 64 + lane] = *(const unsigned*)(ap + k * ASTR + 256 + l4); } }
    PRow A[8], B[8];
    PW_LOAD(A, 0, idl + 32 * g, vvj, vsj);
    int buf = 0;
#pragma unroll 1
    for (; t < M; t += nw) {
        const int tn = (t + nw < M) ? t + nw : t;
        const LAS unsigned* cur = idl + buf * 128 + 32 * g; LAS unsigned* nxt = idl + (buf ^ 1) * 128;
        const LAS unsigned* acur = al + buf * 128 + 32 * g; LAS unsigned* anxt = al + (buf ^ 1) * 128;
        const unsigned char* ip = ids + (size_t)tn * 512; const unsigned char* ap = av + (size_t)tn * 512;
        const unsigned idn0 = *(const unsigned*)(ip + l4), idn1 = *(const unsigned*)(ip + 256 + l4);
        unsigned an[4];
#pragma unroll
        for (int k = 0; k < 2; ++k) { an[2 * k] = *(const unsigned*)(ap + k * ASTR + l4); an[2 * k + 1] = *(const unsigned*)(ap + k * ASTR + 256 + l4); }
        unsigned short hq[8];
#pragma unroll
        for (int k = 0; k < 8; ++k) hq[k] = h2b[(size_t)t * D + 32 * (k & 3) + 16 * (k >> 2)];
        f32x4 y[4];
#pragma unroll
        for (int k = 0; k < 4; ++k) y[k] = (f32x4){0.f, 0.f, 0.f, 0.f};
        PW_LOAD(B, 8, cur, vvj, vsj); PD_COMP(A, 0, acur);
        PW_LOAD(A, 16, cur, vvj, vsj); PD_COMP(B, 8, acur);
        nxt[lane] = idn0; nxt[64 + lane] = idn1;
#pragma unroll
        for (int k = 0; k < 2; ++k) { anxt[256 * k + lane] = an[2 * k]; anxt[256 * k + 64 + lane] = an[2 * k + 1]; }
        PW_LOAD(B, 24, cur, vvj, vsj); PD_COMP(A, 16, acur);
        PW_LOAD(A, 0, nxt + 32 * g, vvj, vsj);
        PD_COMP(B, 24, acur);
        const f32x4 Y0 = y[0] + y[2], Y1 = y[1] + y[3];
        const float h0 = bf2f(hq[0]) + Y0[0], h1 = bf2f(hq[1]) + Y0[1], h2 = bf2f(hq[2]) + Y0[2], h3 = bf2f(hq[3]) + Y0[3];
        const float h4 = bf2f(hq[4]) + Y1[0], h5 = bf2f(hq[5]) + Y1[1], h6 = bf2f(hq[6]) + Y1[2], h7 = bf2f(hq[7]) + Y1[3];
        { bf16_t* op = h3b + (size_t)t * D;
          op[0] = (bf16_t)(cvt_pk_bf16(h0, h0) & 0xffffu); op[32] = (bf16_t)(cvt_pk_bf16(h1, h1) & 0xffffu); op[64] = (bf16_t)(cvt_pk_bf16(h2, h2) & 0xffffu); op[96] = (bf16_t)(cvt_pk_bf16(h3, h3) & 0xffffu);
          op[16] = (bf16_t)(cvt_pk_bf16(h4, h4) & 0xffffu); op[48] = (bf16_t)(cvt_pk_bf16(h5, h5) & 0xffffu); op[80] = (bf16_t)(cvt_pk_bf16(h6, h6) & 0xffffu); op[112] = (bf16_t)(cvt_pk_bf16(h7, h7) & 0xffffu); }
        const float ss = wave_sum(((h0 * h0 + h1 * h1) + (h2 * h2 + h3 * h3)) + ((h4 * h4 + h5 * h5) + (h6 * h6 + h7 * h7)));
        if (lane == 0) ssq3[(size_t)t * 8 + j] = ss;
        buf ^= 1;
    }
}
__device__ __forceinline__ void p13d_final(const Frame& F, unsigned char* ws, const float* g_final, float* out) {
    const bf16_t* h3b = (const bf16_t*)(ws + WS_H3B); const float* ssq3 = (const float*)(ws + WS_SSQ3);
#pragma unroll 1
    for (int token = F.gw; token < M; token += F.NGW) {
        int lane_ = F.lane; asm volatile("" : "+v"(lane_)); const int lane = lane_;
        const float rf = 1.0f / sqrtf(wave_sum(lane < 8 ? ssq3[(size_t)token * 8 + lane] : 0.f) * (1.0f / D) + EPS);
        u32x4 hv[8];
#pragma unroll
        for (int p = 0; p < 8; ++p) hv[p] = *(const u32x4*)(h3b + (size_t)token * D + p * 512 + lane * 8);
#pragma unroll
        for (int p = 0; p < 8; ++p) { const f32x4 g0 = *(const f32x4*)(g_final + p * 512 + lane * 8), g1 = *(const f32x4*)(g_final + p * 512 + lane * 8 + 4);
            float* op = out + (size_t)token * D + p * 512 + lane * 8;
            *(f32x4*)op = (f32x4){BF_LO(hv[p].x) * rf * g0[0], BF_HI(hv[p].x) * rf * g0[1], BF_LO(hv[p].y) * rf * g0[2], BF_HI(hv[p].y) * rf * g0[3]};
            *(f32x4*)(op + 4) = (f32x4){BF_LO(hv[p].z) * rf * g1[0], BF_HI(hv[p].z) * rf * g1[1], BF_LO(hv[p].w) * rf * g1[2], BF_HI(hv[p].w) * rf * g1[3]}; }
    }
}

__device__ __forceinline__ void final_norm_rows(const Frame& F, const float* h, const float* g, float* out) {
    for (int m = F.gw; m < M; m += F.NGW) {
        const f32x4* xr = (const f32x4*)(h + (size_t)m * D); const f32x4* gr = (const f32x4*)g; f32x4* xo = (f32x4*)(out + (size_t)m * D);
        f32x4 v[16]; float ss = 0.f;
#pragma unroll
        for (int j = 0; j < 16; ++j) v[j] = xr[F.lane + 64 * j];
#pragma unroll
        for (int j = 0; j < 16; ++j) ss += (v[j][0] * v[j][0] + v[j][1] * v[j][1]) + (v[j][2] * v[j][2] + v[j][3] * v[j][3]);
        ss = wave_sum(ss); const float r = 1.0f / sqrtf(ss * (1.0f / D) + EPS);
#pragma unroll
        for (int j = 0; j < 16; ++j) xo[F.lane + 64 * j] = v[j] * r * gr[F.lane + 64 * j];
    }
}

__global__ void __launch_bounds__(NTHREADS, 2) mega_fwd(Args args) {
    extern __shared__ __attribute__((aligned(16))) unsigned char lds_raw[];
    Frame F;
    F.lds = (LAS unsigned char*)lds_raw;
    F.tid = threadIdx.x; F.lane = F.tid & 63; F.wave = __builtin_amdgcn_readfirstlane(F.tid >> 6);
    F.G = gridDim.x; F.bid = blockIdx.x; F.gw = F.bid * NWAVES + F.wave; F.NGW = F.G * NWAVES;
    volatile LAS unsigned* MISC = (volatile LAS unsigned*)(F.lds + MISC_OFF);
    if (F.tid < 16) MISC[F.tid] = 0u;
    __syncthreads();
    XcdBarrier bar = xcd_barrier_post((unsigned*)(args.ws + WS_CTL), MISC + 8);
    const int lo = args.ph_lo, hi = args.ph_hi;
#define IN(k) (lo <= (k) && (k) < hi)
#define BOTH(k) (IN(k) && IN((k) + 1))
#define GRID_BAR() xcd_barrier(bar)

    unsigned char* ws = args.ws;
#define GEMM(KINDS, k) gemm_run<KINDS>(F.lds, args.in[0], args.out, ws, (k), F.G, F.bid)
    if (IN(0)) { p0_prologue(F, args); if (BOTH(0)) GRID_BAR(); }
    if (IN(1)) {
#pragma unroll 1
        for (int gi = 0; gi < 3; ++gi) GEMM(3, gi);
        if (BOTH(1)) GRID_BAR(); }
    if (IN(2)) { p2_stats(F, ws); p2_gla_prep(F, ws, args.in[11], args.in[12]); if (BOTH(2)) GRID_BAR(); }
    if (IN(3)) {
#pragma unroll 1
        for (int gi = 3; gi < 5; ++gi) GEMM(1, gi);
        p3_gla_att(F, ws);
        if (BOTH(3)) GRID_BAR(); }
    if (IN(4)) { p4_mla(F, ws);   }
    if (IN(5)) { p5_gla_scan(F, ws); if (BOTH(5)) GRID_BAR(); }
    if (IN(6)) { p6_mix(F, ws, args.in[10], args.in[13]); if (BOTH(6)) GRID_BAR(); }
    if (IN(7)) {
        GEMM(4, 5);
        if (BOTH(7)) GRID_BAR(); }
    if (IN(8)) {
        { pg8::StaticOrder S; S.init(M, 1024, F.G, F.bid); rstd_for_units(F, S, (const float*)(ws + WS_SSQ1), (float*)(ws + WS_RSTD1)); }
        GEMM(1, 6);
        if (BOTH(8)) GRID_BAR(); }
    if (IN(9)) { p9_xattn(F, ws); if (BOTH(9)) GRID_BAR(); }
    if (IN(10)) {
        GEMM(4, 7);
        if (BOTH(10)) GRID_BAR(); }
    if (IN(11)) {
        { pg8::StaticOrder S; S.init(M, 2048, F.G, F.bid); rstd_for_units(F, S, (const float*)(ws + WS_SSQ2), (float*)(ws + WS_RSTD2)); }
        GEMM(1, 8);
        p12c_quant(F, ws, args.in[20]);
        if (BOTH(11)) GRID_BAR(); }
    if (IN(12)) {
        p12_keys_to_lds(F, ws); __syncthreads();
#pragma unroll 1
        for (int s = 0; s < 2; ++s) { if (((s ^ (F.wave >> 2)) & 1) != 0) peer_tables_to_fp4(F, ws, args.in[23], args.in[24]); else p12_topk(F, ws); }
        if (BOTH(12)) GRID_BAR(); }
    if (IN(13)) {
        { const unsigned nx = MISC[9], nloc = MISC[8], rk = MISC[10];
          const bool hw = (nx == 8u) && (bar.x < 8u) && (nloc > 0u) && (lo < 13);
          F.xj = hw ? (int)bar.x : (F.bid & 7); F.xrank = hw ? (int)rk : (F.bid >> 3); F.xn = hw ? (int)nloc : ((F.G - 1 - (F.bid & 7)) / 8 + 1); }
        p13a_up(F, ws); GRID_BAR(); p13b_act(F, ws); GRID_BAR(); p13c_down(F, ws); GRID_BAR(); p13d_final(F, ws, args.in[25], args.out);
    }
#undef GEMM
#undef IN
#undef BOTH
}

extern "C" void kernel_launch(void* const* d_in, const int* in_sizes, int n_in, void* d_out, int out_size, void* d_ws, size_t ws_size, hipStream_t stream) {
    static int grid = 0;
    if (grid == 0) {
        if (n_in != 26 || out_size != M * D || ws_size < WS_END0) { fprintf(stderr, "kernel_launch: unexpected problem (n_in %d out %d ws %zu need %zu)\n", n_in, out_size, ws_size, (size_t)WS_END0); grid = -1; return; }
        int dev = 0, cus = 0, per_cu = 0;
        if (hipGetDevice(&dev) != hipSuccess || hipDeviceGetAttribute(&cus, hipDeviceAttributeMultiprocessorCount, dev) != hipSuccess) { grid = -1; return; }
        if (hipFuncSetAttribute((const void*)mega_fwd, hipFuncAttributeMaxDynamicSharedMemorySize, LDS_BYTES) != hipSuccess) { fprintf(stderr, "kernel_launch: hipFuncSetAttribute failed\n"); grid = -1; return; }
        if (hipOccupancyMaxActiveBlocksPerMultiprocessor(&per_cu, (const void*)mega_fwd, NTHREADS, LDS_BYTES) != hipSuccess || per_cu < 1) { fprintf(stderr, "kernel_launch: occupancy query says %d\n", per_cu); }
        (void)hipGetLastError();
        if (cus < 8) { fprintf(stderr, "kernel_launch: needs at least 8 CUs\n"); grid = -1; return; }
        grid = cus;
    }
    if (grid < 0) return;
    (void)hipMemsetAsync((char*)d_ws + WS_CTL, 0, CTL_BYTES, stream);
    Args a{};
    for (int i = 0; i < 26; ++i) a.in[i] = (const float*)d_in[i];
    a.out = (float*)d_out; a.ws = (unsigned char*)d_ws; a.ph_lo = 0; a.ph_hi = 14;
    hipLaunchKernelGGL(mega_fwd, dim3(grid), dim3(NTHREADS), LDS_BYTES, stream, a);
}
```

```cpp
#include <hip/hip_runtime.h>
#include <cstdio>
#include <cstdint>

#define LAS __attribute__((address_space(3)))
typedef unsigned short bf16_t;
typedef short bf16x8 __attribute__((ext_vector_type(8)));
typedef short s16x4 __attribute__((ext_vector_type(4)));
typedef float f32x4 __attribute__((ext_vector_type(4)));
typedef float f32x16 __attribute__((ext_vector_type(16)));
typedef unsigned u32x4 __attribute__((ext_vector_type(4)));
typedef unsigned u32x2 __attribute__((ext_vector_type(2)));

constexpr int D = 4096, NB = 2, SEQ = 8192, M = NB * SEQ;
constexpr float EPS = 1e-6f;
constexpr int MEMT = 256, MROWS = NB * MEMT;
constexpr int IN_W = 7760, IN_WP = 7936;
constexpr int NWAVES = 8, NTHREADS = 512;

constexpr size_t al256(size_t x) { return (x + 255) & ~(size_t)255; }
constexpr size_t WS_CTL = 0, CTL_BYTES = 65536;
constexpr size_t WS_WIN = WS_CTL + CTL_BYTES;
constexpr size_t WS_WUQ = WS_WIN + (size_t)IN_WP * D * 2;
constexpr size_t WS_WUKV = WS_WUQ + (size_t)3072 * 1024 * 2;
constexpr size_t WS_WOUT = WS_WUKV + (size_t)4096 * 512 * 2;
constexpr size_t WS_WCQ = WS_WOUT + (size_t)D * D * 2;
constexpr size_t WS_WCK = WS_WCQ + (size_t)1024 * D * 2;
constexpr size_t WS_WCV = WS_WCK + (size_t)1024 * D * 2;
constexpr size_t WS_WCO = WS_WCV + (size_t)1024 * D * 2;
constexpr size_t WS_WPQ = WS_WCO + (size_t)D * 1024 * 2;
constexpr size_t WS_KEYS = WS_WPQ + (size_t)2048 * D * 2;
constexpr size_t WS_MN = WS_KEYS + (size_t)8 * 2 * 128 * 128 * 2;
constexpr size_t WS_KC = WS_MN + (size_t)MROWS * D * 2;
constexpr size_t WS_VC = WS_KC + (size_t)MROWS * 1024 * 2;
constexpr size_t WS_ROPE = WS_VC + (size_t)MROWS * 1024 * 2;
constexpr size_t WS_RSTDX = WS_ROPE + (size_t)M * 32 * 4 * 2;
constexpr size_t WS_RSTDQ = WS_RSTDX + (size_t)M * 4;
constexpr size_t WS_RSTDKV = WS_RSTDQ + (size_t)M * 4;
constexpr size_t WS_SSQ1 = WS_RSTDKV + (size_t)M * 4;
constexpr size_t WS_SSQ2 = WS_SSQ1 + (size_t)M * 64 * 4;
constexpr size_t WS_XB = WS_SSQ2 + (size_t)M * 64 * 4;
constexpr size_t WS_CQ = WS_XB + (size_t)M * D * 2;
constexpr size_t WS_CKV = WS_CQ + (size_t)M * 1024 * 2;
constexpr size_t WS_GQ = WS_CKV + (size_t)M * 512 * 2;
constexpr size_t WS_GK = WS_GQ + (size_t)M * 1024 * 2;
constexpr size_t WS_GV = WS_GK + (size_t)M * 1024 * 2;
constexpr size_t WS_GOG = WS_GV + (size_t)M * 2048 * 2;
constexpr size_t WS_SM = WS_GOG + (size_t)M * 2048 * 2;
constexpr size_t WS_Q = WS_SM + (size_t)M * 256 * 2;
constexpr size_t WS_KV = WS_Q + (size_t)M * 3072 * 2;
constexpr size_t WS_KROPE = WS_KV + (size_t)M * 4096 * 2;
constexpr size_t WS_OMLA = WS_KROPE + (size_t)M * 64 * 2;
constexpr size_t WS_OGLA = WS_OMLA + (size_t)M * 2048 * 2;
constexpr size_t WS_QEP = WS_OGLA + (size_t)M * 2048 * 2;
constexpr size_t WS_KEP = WS_QEP + (size_t)M * 1024 * 2;
constexpr size_t WS_KDT = WS_KEP + (size_t)M * 1024 * 2;
constexpr size_t WS_ATT = WS_KDT + (size_t)M * 1024 * 2;
constexpr size_t WS_DEC = WS_ATT + (size_t)1024 * 64 * 64 * 2;
constexpr size_t WS_RSTD1 = WS_DEC + (size_t)1024 * 256 * 4;
constexpr size_t WS_RSTD2 = WS_RSTD1 + (size_t)M * 4;
constexpr size_t WS_END0 = WS_RSTD2 + (size_t)M * 4;
constexpr size_t WS_QC = WS_Q;
constexpr size_t WS_OC = WS_Q + (size_t)M * 1024 * 2;
constexpr size_t WS_H1B = WS_KV;
constexpr size_t WS_H2B = WS_XB;
constexpr size_t WS_QP = WS_Q;
constexpr int PEER_ROW_BYTES = 2176;
constexpr size_t PEER_VAL_BYTES = (size_t)8 * 16384 * 256;
constexpr size_t WS_PD = WS_Q;
constexpr size_t WS_ACT = WS_OGLA;
constexpr size_t WS_H3B = WS_KV;
constexpr size_t WS_XQ = WS_KV;
constexpr size_t WS_XQS = WS_XQ + (size_t)M * D;
constexpr size_t WS_SSQ3 = WS_SSQ1;
constexpr size_t WS_UB = WS_CQ;
constexpr size_t WS_VB = WS_UB + (size_t)16384 * PEER_ROW_BYTES;
constexpr size_t WS_USC = WS_VB + (size_t)16384 * PEER_ROW_BYTES;
constexpr size_t WS_VSC = WS_USC + (size_t)16384 * 4;
constexpr size_t WS_IDS = WS_VSC + (size_t)16384 * 4;
constexpr size_t WS_GATES = WS_IDS + (size_t)M * 128 * 4;
static_assert(WS_GATES + (size_t)M * 128 * 4 <= WS_Q, "peer scratch overlaps q_p");

__device__ __forceinline__ unsigned cvt_pk_bf16(float lo, float hi) { unsigned r; asm volatile("v_cvt_pk_bf16_f32 %0, %1, %2" : "=v"(r) : "v"(lo), "v"(hi)); return r; }
__device__ __forceinline__ float bf2f(unsigned short b) { return __uint_as_float(((unsigned)b) << 16); }
#define DPP_ADD(v, ctrl, rmask) (v) += __int_as_float(__builtin_amdgcn_update_dpp(0, __float_as_int(v), (ctrl), (rmask), 0xF, false))
__device__ __forceinline__ float wave_sum(float v) {
    DPP_ADD(v, 0xB1, 0xF); DPP_ADD(v, 0x4E, 0xF); DPP_ADD(v, 0x141, 0xF); DPP_ADD(v, 0x140, 0xF);
    DPP_ADD(v, 0x142, 0xA); DPP_ADD(v, 0x143, 0xC);
    return __int_as_float(__builtin_amdgcn_readlane(__float_as_int(v), 63));
}
#define LDS_WAIT() asm volatile("s_waitcnt lgkmcnt(0)" ::: "memory")
__device__ __forceinline__ bf16x8 pack8(f32x4 a, f32x4 b) {
    u32x4 w = {cvt_pk_bf16(a[0], a[1]), cvt_pk_bf16(a[2], a[3]), cvt_pk_bf16(b[0], b[1]), cvt_pk_bf16(b[2], b[3])};
    return *reinterpret_cast<bf16x8*>(&w);
}

#define XB_TMO      128
#define XB_XCNT(j)  (256  + 64 * (j))
#define XB_XSUB(j)  (1280 + 64 * (j))
#define XB_XGEN(j)  (2304 + 64 * (j))
#define XB_TOP      3328
#define XB_TOPGEN   3392
#define XCD_BAR_WORDS 3456
#define XB_SPIN_CAP (1u << 22)

__device__ __forceinline__ unsigned xb_ld(unsigned* p)              { return __hip_atomic_load(p, __ATOMIC_RELAXED, __HIP_MEMORY_SCOPE_AGENT); }
__device__ __forceinline__ unsigned xb_add(unsigned* p, unsigned v) { return __hip_atomic_fetch_add(p, v, __ATOMIC_RELAXED, __HIP_MEMORY_SCOPE_AGENT); }
__device__ __forceinline__ unsigned xb_xcc_id() { return (unsigned)__builtin_amdgcn_s_getreg((3 << 11) | 20) & 0xFu; }
#define XB_SPIN(cond, bar) do { unsigned _sp = 0; while (cond) { __builtin_amdgcn_s_sleep(1); \
    if ((++_sp & 255u) == 0u) { if (xb_ld(&(bar)[XB_TMO])) break; if (_sp > XB_SPIN_CAP) { atomicAdd(&(bar)[XB_TMO], 1u); break; } } } } while (0)

struct XcdBarrier { unsigned* bar; unsigned x; volatile LAS unsigned* st; };

__device__ __forceinline__ XcdBarrier xcd_barrier_post(unsigned* bar, volatile LAS unsigned* st) {
    XcdBarrier b; b.bar = bar; b.x = xb_xcc_id(); b.st = st;
    if (threadIdx.x == 0) st[2] = xb_add(&bar[XB_XCNT(b.x)], 1u);
    return b;
}
__device__ __forceinline__ void xcd_barrier_complete(unsigned* bar, unsigned x, unsigned& nloc, unsigned& nx) {
    const unsigned G = gridDim.x * gridDim.y * gridDim.z;
    unsigned sum, cnt, mine, sp = 0u;
    for (;;) {
        sum = 0u; cnt = 0u; mine = 0u;
#pragma unroll
        for (unsigned j = 0; j < 16; ++j) { const unsigned c = xb_ld(&bar[XB_XCNT(j)]); sum += c; cnt += (c > 0u) ? 1u : 0u; mine = (j == x) ? c : mine; }
        if (sum == G) break;
        __builtin_amdgcn_s_sleep(1);
        if ((++sp & 255u) == 0u) { if (xb_ld(&bar[XB_TMO])) break; if (sp > XB_SPIN_CAP) { atomicAdd(&bar[XB_TMO], 1u); break; } }
    }
    nloc = mine > 0u ? mine : 1u; nx = cnt > 0u ? cnt : 1u;
}
__device__ __forceinline__ void xcd_barrier(const XcdBarrier& b) {
    asm volatile("s_waitcnt vmcnt(0)" ::: "memory");
    __syncthreads();
    if (threadIdx.x == 0) {
        unsigned* bar = b.bar;
        __builtin_amdgcn_s_waitcnt(0);
        unsigned nloc = b.st[0], nx = b.st[1];
        if (nloc == 0u) { xcd_barrier_complete(bar, b.x, nloc, nx); b.st[0] = nloc; b.st[1] = nx; }
        const unsigned old = xb_add(&bar[XB_XSUB(b.x)], 1u);
        const unsigned gen = old / nloc;
        if (old + 1u == (gen + 1u) * nloc) {
            __builtin_amdgcn_fence(__ATOMIC_RELEASE, "agent");
            asm volatile("s_waitcnt vmcnt(0)" ::: "memory");
            const unsigned og = xb_add(&bar[XB_TOP], 1u);
            const unsigned tg = og / nx;
            if (og + 1u == (tg + 1u) * nx) xb_add(&bar[XB_TOPGEN], 1u);
            else XB_SPIN(xb_ld(&bar[XB_TOPGEN]) == tg, bar);
            __builtin_amdgcn_fence(__ATOMIC_ACQUIRE, "agent");
            xb_add(&bar[XB_XGEN(b.x)], 1u);
            asm volatile("s_waitcnt vmcnt(0)" ::: "memory");
        } else {
            XB_SPIN(xb_ld(&bar[XB_XGEN(b.x)]) == gen, bar);
            __builtin_amdgcn_fence(__ATOMIC_ACQUIRE, "agent");
            asm volatile("s_waitcnt vmcnt(0)" ::: "memory");
        }
    }
    __syncthreads();
}


namespace pg8 {
constexpr int BM = 256, BK = 64, HALF = 128, HTB = HALF * BK * 2, NXCD = 8, WGM = 8;
__host__ __device__ __forceinline__ int lds_byte(int r, int c) { const int st = (r >> 4) * 2 + (c >> 5), rr = r & 15, cc = c & 31, ob = rr * 64 + cc * 2; return st * 1024 + (ob ^ (((ob >> 9) & 1) << 5)); }
__host__ __device__ __forceinline__ void stage_rc(int b, int& R, int& C) { const int st = b / 1024, sb = b % 1024, swz = sb ^ (((sb >> 9) & 1) << 5); R = (st >> 1) * 16 + swz / 64; C = (st & 1) * 32 + (swz % 64) / 2; }
__host__ __device__ __forceinline__ int perm32(int rho) { const int n = rho >> 4, i = rho & 15; return 8 * (i >> 2) + 4 * n + (i & 3); }
struct Unit { int pm, pn; };
struct Gemm { const bf16_t* A; const bf16_t* Bt; int M, N, K, lda, ldb; };
struct StaticOrder {
    int nM, nN, nwg, G, c;
    __host__ __device__ void init(int M_, int N_, int G_, int c_) { nM = M_ / BM; nN = N_ / BM; nwg = nM * nN; G = G_; c = c_; }
    __host__ __device__ bool next(int i, Unit& u) const {
        const long L = (long)i * G + c; if (L >= nwg) return false;
        int wgid = (int)L; { const int q = nwg / NXCD, r = nwg % NXCD, xcd = wgid % NXCD, off = wgid / NXCD; wgid = (xcd < r ? xcd * (q + 1) : r * (q + 1) + (xcd - r) * q) + off; }
        const int nig = WGM * nN, gid = wgid / nig, fm = gid * WGM, gsz = (nM - fm) < WGM ? (nM - fm) : WGM;
        u.pm = fm + ((wgid % nig) % gsz); u.pn = (wgid % nig) / gsz; return true;
    }
};
template <class Epi>
__device__ __forceinline__ void gemm_phase(LAS unsigned char* lds, const Gemm g, const StaticOrder& S, const Epi& E, const bool perm) {
    int tid_ = threadIdx.x; asm volatile("" : "+v"(tid_));
    const int tid = tid_, wid = __builtin_amdgcn_readfirstlane(tid >> 6), lane = tid & 63, wr = wid >> 2, wc = wid & 3, fr = lane & 15, fq = lane >> 4;
    const int K = g.K, nt = K / BK;
    unsigned voffA[2], voffB[2];
#pragma unroll
    for (int i = 0; i < 2; ++i) { int R, C; stage_rc(tid * 16 + i * 8192, R, C); const int Rb = perm ? ((R & ~31) + perm32(R & 31)) : R;
        voffA[i] = (unsigned)(R * g.lda + C) * 2u; voffB[i] = (unsigned)(Rb * g.ldb + C) * 2u; }
    const size_t kstep = (size_t)(BK * 2);
    const size_t hstepA = (size_t)HALF * g.lda * 2, hstepB = (size_t)HALF * g.ldb * 2;
    const size_t tstepA = 2 * hstepA, tstepB = 2 * hstepB;
    const unsigned ldsw = (unsigned)wid * 1024u;
    const int aoff = lds_byte(wr * 64 + fr, fq * 8), boff = lds_byte(wc * 32 + fr, fq * 8);
#define PG8_SA(b, h) (((b) * 2 + (h)) * HTB)
#define PG8_SB(b, h) ((4 + (b) * 2 + (h)) * HTB)
#define PG8_STAGE(bufoff, gbase, voff) do { _Pragma("unroll") for (int _i = 0; _i < 2; ++_i) \
        __builtin_amdgcn_global_load_lds((const unsigned*)((const char*)(gbase) + (voff)[_i]), (LAS unsigned*)(lds + (bufoff) + ldsw + _i * 8192), 16, 0, 0); } while (0)
#define PG8_LDA(dst, b, h) do { _Pragma("unroll") for (int m = 0; m < 4; ++m) _Pragma("unroll") for (int k = 0; k < 2; ++k) dst[m][k] = *(const LAS bf16x8*)(lds + PG8_SA(b, h) + aoff + m * 2048 + k * 1024); } while (0)
#define PG8_LDB(dst, b, h) do { _Pragma("unroll") for (int n = 0; n < 2; ++n) _Pragma("unroll") for (int k = 0; k < 2; ++k) dst[n][k] = *(const LAS bf16x8*)(lds + PG8_SB(b, h) + boff + n * 2048 + k * 1024); } while (0)
#define PG8_MMA(ai, bj, At, Bt) do { __builtin_amdgcn_s_setprio(1); _Pragma("unroll") for (int m = 0; m < 4; ++m) _Pragma("unroll") for (int n = 0; n < 2; ++n) _Pragma("unroll") for (int k = 0; k < 2; ++k) \
        acc[ai][bj][m][n] = __builtin_amdgcn_mfma_f32_16x16x32_bf16(Bt[n][k], At[m][k], acc[ai][bj][m][n], 0, 0, 0); __builtin_amdgcn_s_setprio(0); } while (0)
#define PG8_WAIT_V(n) asm volatile("s_waitcnt vmcnt(" #n ")" ::: "memory")
#define PG8_WAIT_L(n) asm volatile("s_waitcnt lgkmcnt(" #n ")" ::: "memory")
#define PG8_BAR __builtin_amdgcn_s_barrier()
#define PG8_SCHED __builtin_amdgcn_sched_barrier(0)
    Unit cur, nxt; int ui = 0;
    if (!S.next(0, cur)) return;
    f32x4 acc[2][2][4][2];
#pragma unroll
    for (int a = 0; a < 2; ++a)
#pragma unroll
        for (int b = 0; b < 2; ++b)
#pragma unroll
            for (int m = 0; m < 4; ++m)
#pragma unroll
                for (int n = 0; n < 2; ++n) acc[a][b][m][n] = (f32x4){0.f, 0.f, 0.f, 0.f};
    bf16x8 At[4][2], B0[2][2], B1[2][2];
    const char* cA = (const char*)g.A + (size_t)cur.pm * tstepA; const char* cB = (const char*)g.Bt + (size_t)cur.pn * tstepB;
    PG8_STAGE(PG8_SB(0, 0), cB, voffB); PG8_STAGE(PG8_SA(0, 0), cA, voffA); PG8_STAGE(PG8_SB(0, 1), cB + hstepB, voffB); PG8_STAGE(PG8_SA(0, 1), cA + hstepA, voffA);
    if (wr == 1) PG8_BAR;
    PG8_WAIT_V(4); PG8_BAR;
    PG8_STAGE(PG8_SB(1, 0), cB + kstep, voffB); PG8_STAGE(PG8_SA(1, 0), cA + kstep, voffA); PG8_STAGE(PG8_SB(1, 1), cB + hstepB + kstep, voffB);
    PG8_WAIT_V(6); PG8_BAR;
    for (;;) {
        const bool has_next = S.next(ui + 1, nxt);
        const char* nA = has_next ? (const char*)g.A + (size_t)nxt.pm * tstepA : cA; const char* nB = has_next ? (const char*)g.Bt + (size_t)nxt.pn * tstepB : cB;
        for (int t = 0; t < nt; t += 2) {
            const bool last = (t == nt - 2);
            const char* a1 = cA + (size_t)(t + 1) * kstep;
            const char* a2 = last ? nA : cA + (size_t)(t + 2) * kstep; const char* b2 = last ? nB : cB + (size_t)(t + 2) * kstep;
            const char* a3 = a2 + kstep; const char* b3 = b2 + kstep;
            PG8_LDB(B0, 0, 0); PG8_SCHED; PG8_LDA(At, 0, 0); PG8_STAGE(PG8_SA(1, 1), a1 + hstepA, voffA);
            PG8_WAIT_L(8); PG8_BAR; PG8_WAIT_L(0); PG8_MMA(0, 0, At, B0); PG8_BAR; PG8_SCHED;
            PG8_LDB(B1, 0, 1); PG8_STAGE(PG8_SB(0, 0), b2, voffB);
            PG8_BAR; PG8_WAIT_L(0); PG8_MMA(0, 1, At, B1); PG8_BAR;
            PG8_LDA(At, 0, 1); PG8_STAGE(PG8_SA(0, 0), a2, voffA);
            PG8_BAR; PG8_WAIT_L(0); PG8_MMA(1, 0, At, B0); PG8_BAR; PG8_SCHED;
            PG8_STAGE(PG8_SB(0, 1), b2 + hstepB, voffB);
            PG8_WAIT_V(6); PG8_BAR; PG8_MMA(1, 1, At, B1); PG8_BAR;
            PG8_LDB(B0, 1, 0); PG8_SCHED; PG8_LDA(At, 1, 0); PG8_STAGE(PG8_SA(0, 1), a2 + hstepA, voffA);
            PG8_WAIT_L(8); PG8_BAR; PG8_WAIT_L(0); PG8_MMA(0, 0, At, B0); PG8_BAR; PG8_SCHED;
            PG8_LDB(B1, 1, 1); PG8_STAGE(PG8_SB(1, 0), b3, voffB);
            PG8_BAR; PG8_WAIT_L(0); PG8_MMA(0, 1, At, B1); PG8_BAR;
            PG8_LDA(At, 1, 1); PG8_STAGE(PG8_SA(1, 0), a3, voffA);
            PG8_BAR; PG8_WAIT_L(0); PG8_MMA(1, 0, At, B0); PG8_BAR; PG8_SCHED;
            PG8_STAGE(PG8_SB(1, 1), b3 + hstepB, voffB);
            PG8_WAIT_V(6); PG8_BAR; PG8_MMA(1, 1, At, B1); PG8_BAR;
        }
        E(acc, cur, wr, wc, fr, fq);
        if (!has_next) break;
#pragma unroll
        for (int a = 0; a < 2; ++a)
#pragma unroll
            for (int b = 0; b < 2; ++b)
#pragma unroll
                for (int m = 0; m < 4; ++m)
#pragma unroll
                    for (int n = 0; n < 2; ++n) acc[a][b][m][n] = (f32x4){0.f, 0.f, 0.f, 0.f};
        cur = nxt; cA = nA; cB = nB; ++ui;
    }
    PG8_WAIT_V(0);
    if (wr == 0) PG8_BAR;
    PG8_BAR;
#undef PG8_SA
#undef PG8_SB
#undef PG8_STAGE
#undef PG8_LDA
#undef PG8_LDB
#undef PG8_MMA
#undef PG8_WAIT_V
#undef PG8_WAIT_L
#undef PG8_BAR
#undef PG8_SCHED
}

struct EpiRowScaleBf16 {
    static constexpr bool PERM = true;
    const float* rs; bf16_t* base; int ldc;
    __device__ __forceinline__ void store(const f32x4 (&acc)[2][2][4][2], bf16_t* __restrict__ dst, int ld, int ctile, const Unit& u, int wr, int wc, int fr, int fq) const {
        const int row0 = u.pm * BM + wr * 64 + fr, col0 = ctile * BM + wc * 32 + 8 * fq;
        float sv[2][4];
        const float* __restrict__ rsp = rs;
#pragma unroll
        for (int ai = 0; ai < 2; ++ai)
#pragma unroll
            for (int m = 0; m < 4; ++m) sv[ai][m] = rsp ? rsp[row0 + ai * HALF + m * 16] : 1.0f;
#pragma unroll
        for (int ai = 0; ai < 2; ++ai)
#pragma unroll
            for (int m = 0; m < 4; ++m) { const int row = row0 + ai * HALF + m * 16; const float s = sv[ai][m]; bf16_t* rowp = dst + (size_t)row * ld + col0;
#pragma unroll
                for (int bj = 0; bj < 2; ++bj) { const f32x4 v0 = acc[ai][bj][m][0] * s, v1 = acc[ai][bj][m][1] * s;
                    u32x4 w; w.x = cvt_pk_bf16(v0[0], v0[1]); w.y = cvt_pk_bf16(v0[2], v0[3]); w.z = cvt_pk_bf16(v1[0], v1[1]); w.w = cvt_pk_bf16(v1[2], v1[3]);
                    *(u32x4*)(rowp + bj * HALF) = w; } }
    }
    __device__ __forceinline__ void operator()(const f32x4 (&acc)[2][2][4][2], const Unit& u, int wr, int wc, int fr, int fq) const { store(acc, base, ldc, u.pn, u, wr, wc, fr, fq); }
};
struct EpiInProj : EpiRowScaleBf16 {
    unsigned char* ws;
    __device__ __forceinline__ void operator()(const f32x4 (&acc)[2][2][4][2], const Unit& u, int wr, int wc, int fr, int fq) const {
        const int pn = u.pn; size_t off; int ld, t0;
        if (pn < 4) { off = WS_CQ; ld = 1024; t0 = 0; } else if (pn < 6) { off = WS_CKV; ld = 512; t0 = 4; } else if (pn < 10) { off = WS_GQ; ld = 1024; t0 = 6; }
        else if (pn < 14) { off = WS_GK; ld = 1024; t0 = 10; } else if (pn < 22) { off = WS_GV; ld = 2048; t0 = 14; } else if (pn < 30) { off = WS_GOG; ld = 2048; t0 = 22; }
        else { off = WS_SM; ld = 256; t0 = 30; }
        store(acc, (bf16_t*)(ws + off), ld, pn - t0, u, wr, wc, fr, fq);
    }
};
struct EpiResidual {
    static constexpr bool PERM = true;
    const float* basef; const bf16_t* baseb; bf16_t* hb; float* ssq; int ldc; int nslots;
    __device__ __forceinline__ void operator()(const f32x4 (&acc)[2][2][4][2], const Unit& u, int wr, int wc, int fr, int fq) const {
        const int row0 = u.pm * BM + wr * 64 + fr, col0 = u.pn * BM + wc * 32 + 8 * fq;
        const float* __restrict__ bf = basef; const bf16_t* __restrict__ bb = baseb; bf16_t* __restrict__ ho = hb;
        if (bf) {
#pragma unroll
            for (int ai = 0; ai < 2; ++ai)
#pragma unroll
                for (int mp = 0; mp < 2; ++mp) {
                    f32x4 bs[2][2][2];
#pragma unroll
                    for (int mm = 0; mm < 2; ++mm) { const size_t off = (size_t)(row0 + ai * HALF + (2 * mp + mm) * 16) * ldc + col0;
#pragma unroll
                        for (int bj = 0; bj < 2; ++bj)
#pragma unroll
                            for (int n = 0; n < 2; ++n) bs[mm][bj][n] = *(const f32x4*)(bf + off + bj * HALF + n * 4); }
#pragma unroll
                    for (int mm = 0; mm < 2; ++mm) { const int m = 2 * mp + mm; const int row = row0 + ai * HALF + m * 16; const size_t off = (size_t)row * ldc + col0; float ss = 0.f;
#pragma unroll
                        for (int bj = 0; bj < 2; ++bj) { const f32x4 h0 = bs[mm][bj][0] + acc[ai][bj][m][0], h1 = bs[mm][bj][1] + acc[ai][bj][m][1];
                            u32x4 w; w.x = cvt_pk_bf16(h0[0], h0[1]); w.y = cvt_pk_bf16(h0[2], h0[3]); w.z = cvt_pk_bf16(h1[0], h1[1]); w.w = cvt_pk_bf16(h1[2], h1[3]);
                            *(u32x4*)(ho + off + bj * HALF) = w;
                            ss += ((h0[0] * h0[0] + h0[1] * h0[1]) + (h0[2] * h0[2] + h0[3] * h0[3])) + ((h1[0] * h1[0] + h1[1] * h1[1]) + (h1[2] * h1[2] + h1[3] * h1[3])); }
                        ss += __shfl_xor(ss, 16); ss += __shfl_xor(ss, 32);
                        if (fq == 0) ssq[(size_t)row * nslots + u.pn * 4 + wc] = ss; }
                }
        } else {
#pragma unroll
            for (int ai = 0; ai < 2; ++ai) {
                u32x4 bs[4][2];
#pragma unroll
                for (int m = 0; m < 4; ++m) { const size_t off = (size_t)(row0 + ai * HALF + m * 16) * ldc + col0;
#pragma unroll
                    for (int bj = 0; bj < 2; ++bj) bs[m][bj] = *(const u32x4*)(bb + off + bj * HALF); }
#pragma unroll
                for (int m = 0; m < 4; ++m) { const int row = row0 + ai * HALF + m * 16; const size_t off = (size_t)row * ldc + col0; float ss = 0.f;
#pragma unroll
                    for (int bj = 0; bj < 2; ++bj) { const u32x4 q = bs[m][bj];
                        const f32x4 h0 = (f32x4){__uint_as_float(q.x << 16), __uint_as_float(q.x & 0xffff0000u), __uint_as_float(q.y << 16), __uint_as_float(q.y & 0xffff0000u)} + acc[ai][bj][m][0];
                        const f32x4 h1 = (f32x4){__uint_as_float(q.z << 16), __uint_as_float(q.z & 0xffff0000u), __uint_as_float(q.w << 16), __uint_as_float(q.w & 0xffff0000u)} + acc[ai][bj][m][1];
                        u32x4 w; w.x = cvt_pk_bf16(h0[0], h0[1]); w.y = cvt_pk_bf16(h0[2], h0[3]); w.z = cvt_pk_bf16(h1[0], h1[1]); w.w = cvt_pk_bf16(h1[2], h1[3]);
                        *(u32x4*)(ho + off + bj * HALF) = w;
                        ss += ((h0[0] * h0[0] + h0[1] * h0[1]) + (h0[2] * h0[2] + h0[3] * h0[3])) + ((h1[0] * h1[0] + h1[1] * h1[1]) + (h1[2] * h1[2] + h1[3] * h1[3])); }
                    ss += __shfl_xor(ss, 16); ss += __shfl_xor(ss, 32);
                    if (fq == 0) ssq[(size_t)row * nslots + u.pn * 4 + wc] = ss; }
            }
        }
    }
};
}


struct GemmDesc { unsigned long long a_off, b_off, d_off, rs_off, ssq_off; int M, N, K, lda, ldb, ldc, kind, base_is_x, crot; };
constexpr unsigned long long NO_OFF = ~0ull;
__device__ __constant__ GemmDesc g_gemm[9] = {
      {WS_XB,  WS_WIN,  0,      WS_RSTDX,  NO_OFF,  M,     IN_WP, D,    D,    D,    0,    1, 0, 0},
      {WS_MN,  WS_WCK,  WS_KC,  NO_OFF,    NO_OFF,  MROWS, 1024,  D,    D,    D,    1024, 0, 0, 64},
      {WS_MN,  WS_WCV,  WS_VC,  NO_OFF,    NO_OFF,  MROWS, 1024,  D,    D,    D,    1024, 0, 0, 56},
      {WS_CQ,  WS_WUQ,  WS_Q,   WS_RSTDQ,  NO_OFF,  M,     3072,  1024, 1024, 1024, 3072, 0, 0, 0},
      {WS_CKV, WS_WUKV, WS_KV,  WS_RSTDKV, NO_OFF,  M,     4096,  512,  512,  512,  4096, 0, 0, 0},
      {WS_XB,  WS_WOUT, WS_H1B, NO_OFF,    WS_SSQ1, M,     D,     D,    D,    D,    D,    2, 1, 0},
      {WS_H1B, WS_WCQ,  WS_QC,  WS_RSTD1,  NO_OFF,  M,     1024,  D,    D,    D,    1024, 0, 0, 0},
      {WS_OC,  WS_WCO,  WS_H2B, NO_OFF,    WS_SSQ2, M,     D,     1024, 1024, 1024, D,    2, 0, 0},
      {WS_H2B, WS_WPQ,  WS_QP,  WS_RSTD2,  NO_OFF,  M,     2048,  D,    D,    D,    2048, 0, 0, 0},
};
template <int KINDS>
struct EpiGeneric {
    int kind; pg8::EpiInProj ein; pg8::EpiResidual eres;
    __device__ __forceinline__ void operator()(const f32x4 (&acc)[2][2][4][2], const pg8::Unit& u, int wr, int wc, int fr, int fq) const {
        if ((KINDS & 4) && (kind == 2 || KINDS == 4)) eres(acc, u, wr, wc, fr, fq);
        else if ((KINDS & 2) && (kind == 1 || KINDS == 2)) ein(acc, u, wr, wc, fr, fq);
        else if (KINDS & 1) ein.pg8::EpiRowScaleBf16::operator()(acc, u, wr, wc, fr, fq);
    }
};
template <int KINDS>
__device__ __forceinline__ void gemm_run(LAS unsigned char* lds, const float* x_in, float* out, unsigned char* ws, int idx, int G, int bid) {
    const GemmDesc d = g_gemm[idx];
    pg8::Gemm g{(const bf16_t*)(ws + d.a_off), (const bf16_t*)(ws + d.b_off), d.M, d.N, d.K, d.lda, d.ldb};
    pg8::StaticOrder S; S.init(d.M, d.N, G, (bid + d.crot) % G);
    EpiGeneric<KINDS> E{};
    E.kind = d.kind;
    E.ein.rs = d.rs_off == NO_OFF ? nullptr : (const float*)(ws + d.rs_off); E.ein.base = (bf16_t*)(ws + d.d_off); E.ein.ldc = d.ldc; E.ein.ws = ws;
    E.eres.basef = d.base_is_x ? x_in : nullptr; E.eres.baseb = (const bf16_t*)(ws + WS_H1B); E.eres.hb = (bf16_t*)(ws + d.d_off); E.eres.ssq = (float*)(ws + (d.ssq_off == NO_OFF ? 0ull : d.ssq_off)); E.eres.ldc = d.ldc; E.eres.nslots = 64;
    pg8::gemm_phase(lds, g, S, E, true);
}

namespace att {
constexpr int KVBLK = 64;
constexpr float THR = 8.f;
#define SBAR() __builtin_amdgcn_sched_barrier(0)
__device__ __forceinline__ int v_st(int k, int c) { const int kk = (k & ~0xC) | ((k & 4) << 1) | ((k & 8) >> 1); return ((kk >> 3) * 4 + (c >> 5)) * 512 + ((kk & 7) * 32 + (c & 31)) * 2; }
__device__ __forceinline__ int v_rd_base(int lane) { return ((lane & 3) << 3) | (((lane >> 2) & 3) << 6) | (((lane >> 4) & 1) << 5) | (((lane >> 5) & 1) << 8); }
constexpr int v_rd_off(int d0, int ks, int half) { return d0 * 512 + ks * 4096 + half * 2048; }
__device__ __forceinline__ int crow(int r, int hi) { return (r & 3) + 8 * (r >> 2) + 4 * hi; }
__device__ __forceinline__ void mask_tile(f32x16& p0, f32x16& p1, int dq, unsigned W) {
    const float NEG = -__builtin_inff();
#pragma unroll
    for (int r = 0; r < 16; ++r) {
        const int c = (r & 3) + 8 * (r >> 2);
        if ((unsigned)(dq - c) >= W) p0[r] = NEG;
        if ((unsigned)(dq - c - 32) >= W) p1[r] = NEG;
    }
}
__device__ __forceinline__ void partialSM(f32x16& p0, f32x16& p1, float& m_reg, float& mn, float& alpha, const float SCALE) {
    float pmax = p0[0];
#pragma unroll
    for (int r = 1; r < 16; ++r) pmax = fmaxf(pmax, p0[r]);
#pragma unroll
    for (int r = 0; r < 16; ++r) pmax = fmaxf(pmax, p1[r]);
    { auto rr = __builtin_amdgcn_permlane32_swap(__float_as_uint(pmax), __float_as_uint(pmax), false, false);
      pmax = fmaxf(__uint_as_float(rr[0]), __uint_as_float(rr[1])); }
    const float C2 = 1.4426950408889634f * SCALE;
    if (__builtin_expect(__all((pmax - m_reg) * SCALE <= THR), 1)) { mn = m_reg; alpha = 1.f; }
    else { mn = fmaxf(m_reg, pmax); alpha = __builtin_amdgcn_exp2f((m_reg - mn) * C2); m_reg = mn; }
    const float mnL = -mn * C2;
#pragma unroll
    for (int r = 0; r < 16; ++r) p0[r] = fmaf(p0[r], C2, mnL);
#pragma unroll
    for (int r = 0; r < 16; ++r) p1[r] = fmaf(p1[r], C2, mnL);
#pragma unroll
    for (int r = 0; r < 16; ++r) p0[r] = __builtin_amdgcn_exp2f(p0[r]);
}
__device__ __forceinline__ void finishSM(f32x16& p0, f32x16& p1, float alpha, float& l_reg, bf16x8& pa0, bf16x8& pa1, bf16x8& pa2, bf16x8& pa3) {
#pragma unroll
    for (int r = 0; r < 16; ++r) p1[r] = __builtin_amdgcn_exp2f(p1[r]);
    float ps = 0;
#pragma unroll
    for (int r = 0; r < 16; ++r) ps += p0[r];
#pragma unroll
    for (int r = 0; r < 16; ++r) ps += p1[r];
    { auto rr = __builtin_amdgcn_permlane32_swap(__float_as_uint(ps), __float_as_uint(ps), false, false);
      ps = __uint_as_float(rr[0]) + __uint_as_float(rr[1]); }
    l_reg = l_reg * alpha + ps;
#define PK4(P, B_, OUT) do { unsigned a0 = cvt_pk_bf16(P[B_+0], P[B_+1]), a1 = cvt_pk_bf16(P[B_+2], P[B_+3]);                          \
        unsigned b0 = cvt_pk_bf16(P[B_+4], P[B_+5]), b1 = cvt_pk_bf16(P[B_+6], P[B_+7]);                                             \
        auto r0 = __builtin_amdgcn_permlane32_swap(a0, b0, false, false); auto r1 = __builtin_amdgcn_permlane32_swap(a1, b1, false, false); \
        u32x4 w = {r0[0], r1[0], r0[1], r1[1]}; OUT = *reinterpret_cast<bf16x8*>(&w); } while (0)
    PK4(p0, 0, pa0); PK4(p0, 8, pa1); PK4(p1, 0, pa2); PK4(p1, 8, pa3);
#undef PK4
}
template <int DQK>
__device__ __forceinline__ void qkt(f32x16& p0, f32x16& p1, const LAS char* Kt, int r32, int hi, const bf16x8* qr) {
    constexpr int PITCH = DQK * 2;
    p0 = f32x16{}; p1 = f32x16{};
    const LAS char* kb[4];
#pragma unroll
    for (int dd = 0; dd < 4; ++dd) kb[dd] = Kt + r32 * PITCH + (((dd * 16 + hi * 8) * 2) ^ ((r32 & 7) << 4));
#pragma unroll
    for (int d0 = 0; d0 < DQK / 16; ++d0) { const LAS char* a = kb[d0 & 3] + (d0 >> 2) * 128;
        bf16x8 b0 = *reinterpret_cast<const LAS bf16x8*>(a);
        bf16x8 b1 = *reinterpret_cast<const LAS bf16x8*>(a + 32 * PITCH);
        p0 = __builtin_amdgcn_mfma_f32_32x32x16_bf16(b0, qr[d0], p0, 0, 0, 0);
        p1 = __builtin_amdgcn_mfma_f32_32x32x16_bf16(b1, qr[d0], p1, 0, 0, 0); }
}
template <int VOFF>
__device__ __forceinline__ void pv_tile(f32x16* o, int vaddr, bf16x8 pa0, bf16x8 pa1, bf16x8 pa2, bf16x8 pa3) {
#define TRRD(dst, off) asm volatile("ds_read_b64_tr_b16 %0, %1 offset:%2" : "=&v"(dst) : "v"(vaddr), "i"(off) : "memory")
#define PV_D0(d0) do { s16x4 l0, l1, l2, l3, h0, h1, h2, h3; constexpr int b_ = VOFF + v_rd_off(d0, 0, 0); \
        TRRD(l0, b_); TRRD(h0, b_ + 2048); TRRD(l1, b_ + 4096); TRRD(h1, b_ + 6144); TRRD(l2, b_ + 8192); TRRD(h2, b_ + 10240); TRRD(l3, b_ + 12288); TRRD(h3, b_ + 14336); \
        asm volatile("s_waitcnt lgkmcnt(0)" ::: "memory"); SBAR();   \
        o[d0] = __builtin_amdgcn_mfma_f32_32x32x16_bf16(pa0, (bf16x8){l0[0], l0[1], l0[2], l0[3], h0[0], h0[1], h0[2], h0[3]}, o[d0], 0, 0, 0);   \
        o[d0] = __builtin_amdgcn_mfma_f32_32x32x16_bf16(pa1, (bf16x8){l1[0], l1[1], l1[2], l1[3], h1[0], h1[1], h1[2], h1[3]}, o[d0], 0, 0, 0);   \
        o[d0] = __builtin_amdgcn_mfma_f32_32x32x16_bf16(pa2, (bf16x8){l2[0], l2[1], l2[2], l2[3], h2[0], h2[1], h2[2], h2[3]}, o[d0], 0, 0, 0);   \
        o[d0] = __builtin_amdgcn_mfma_f32_32x32x16_bf16(pa3, (bf16x8){l3[0], l3[1], l3[2], l3[3], h3[0], h3[1], h3[2], h3[3]}, o[d0], 0, 0, 0); } while (0)
    PV_D0(0); PV_D0(1); PV_D0(2); PV_D0(3);
#undef PV_D0
#undef TRRD
}

constexpr int MLA_TILE = 16384;
constexpr int MLA_V_OFF = 0, MLA_KN_OFF = 2 * MLA_TILE, MLA_KR_OFF = 4 * MLA_TILE, MLA_KR_BYTES = 8192, MLA_WS_OFF = MLA_KR_OFF + 2 * MLA_KR_BYTES;
__device__ __forceinline__ void mla_block(LAS char* lds, const bf16_t* __restrict__ q, const bf16_t* __restrict__ kv, const bf16_t* __restrict__ krope,
                                          const float* __restrict__ cs, const float* __restrict__ sn, bf16_t* __restrict__ omla, int b, int h, int qb) {
    const float SCALE = 0.07216878364870322f;
    int tid_ = threadIdx.x; asm volatile("" : "+v"(tid_));
    const int tid = tid_, wid = __builtin_amdgcn_readfirstlane(tid >> 6), lane = tid & 63, r32 = lane & 31, hi = lane >> 5;
    LAS float* wsf = (LAS float*)(lds + MLA_WS_OFF) + wid * 64; LAS float* li_l = wsf; LAS float* al_l = wsf + 32;
    const int P0 = qb * 256, tb = b * SEQ;
    const int NT = (P0 + 256) / KVBLK;
    const int qlo = P0 + wid * 32, qm = qlo + r32 - 4 * hi;
    bf16x8 qr[12];
    { const size_t qrow = (size_t)(tb + qlo + r32); const bf16_t* qp = q + qrow * 3072 + h * 192;
#pragma unroll
      for (int d0 = 0; d0 < 8; ++d0) qr[d0] = *(const bf16x8*)(qp + d0 * 16 + hi * 8);
      const bf16x8 x8 = *(const bf16x8*)(qp + 128 + hi * 8), x9 = *(const bf16x8*)(qp + 144 + hi * 8), x10 = *(const bf16x8*)(qp + 160 + hi * 8), x11 = *(const bf16x8*)(qp + 176 + hi * 8);
      const float* cp = cs + qrow * 32 + hi * 8; const float* sp = sn + qrow * 32 + hi * 8;
      float n8[8], n9[8], n10[8], n11[8];
#pragma unroll
      for (int e = 0; e < 8; ++e) { const float c0 = cp[e], s0 = sp[e], c1 = cp[16 + e], s1 = sp[16 + e];
          const float a8 = bf2f((unsigned short)x8[e]), a9 = bf2f((unsigned short)x9[e]), a10 = bf2f((unsigned short)x10[e]), a11 = bf2f((unsigned short)x11[e]);
          n8[e] = a8 * c0 - a10 * s0; n10[e] = a10 * c0 + a8 * s0; n9[e] = a9 * c1 - a11 * s1; n11[e] = a11 * c1 + a9 * s1; }
      qr[8] = pack8((f32x4){n8[0], n8[1], n8[2], n8[3]}, (f32x4){n8[4], n8[5], n8[6], n8[7]});
      qr[9] = pack8((f32x4){n9[0], n9[1], n9[2], n9[3]}, (f32x4){n9[4], n9[5], n9[6], n9[7]});
      qr[10] = pack8((f32x4){n10[0], n10[1], n10[2], n10[3]}, (f32x4){n10[4], n10[5], n10[6], n10[7]});
      qr[11] = pack8((f32x4){n11[0], n11[1], n11[2], n11[3]}, (f32x4){n11[4], n11[5], n11[6], n11[7]}); }
    unsigned voff_kn, voff_v, voff_kr;
    { const int row = tid >> 4, cp_ = tid & 15, g = cp_ >> 3, j = cp_ & 7;
      voff_kn = (unsigned)(row * 8192 + (h * 256 + (g * 8 + (j ^ (row & 7))) * 8) * 2);
      const int kk = (tid >> 7) * 8 + ((tid & 31) >> 2), key = (kk & ~0xC) | ((kk & 4) << 1) | ((kk & 8) >> 1), c = ((tid >> 5) & 3) * 32 + (tid & 3) * 8;
      voff_v = (unsigned)(key * 8192 + (h * 256 + 128 + c) * 2);
      const int prow = tid >> 4, half = (tid >> 3) & 1, jr = (tid & 7) ^ (prow & 7);
      voff_kr = (unsigned)((prow + 32 * half) * 128 + jr * 16); }
    const char* kvb = (const char*)(kv + (size_t)tb * 4096); const char* krb = (const char*)(krope + (size_t)tb * 64);
    const unsigned ldsw = (unsigned)wid * 1024u;
#define GLDS(gp, lp) __builtin_amdgcn_global_load_lds((const unsigned*)(gp), (LAS unsigned*)(lp), 16, 0, 0)
#define ST_ISSUE(kb_, BF) do { const char* kt_ = kvb + (size_t)(kb_) * 8192;                                                              \
        GLDS(kt_ + voff_kn, lds + MLA_KN_OFF + (BF) * MLA_TILE + ldsw); GLDS(kt_ + 32 * 8192 + voff_kn, lds + MLA_KN_OFF + (BF) * MLA_TILE + 8192 + ldsw); \
        GLDS(kt_ + voff_v, lds + MLA_V_OFF + (BF) * MLA_TILE + ldsw);   GLDS(kt_ + 32 * 8192 + voff_v, lds + MLA_V_OFF + (BF) * MLA_TILE + 8192 + ldsw);   \
        GLDS(krb + (size_t)(kb_) * 128 + voff_kr, lds + MLA_KR_OFF + (BF) * MLA_KR_BYTES + ldsw); } while (0)
    float m_reg = -1e30f, l_reg = 0.f; f32x16 o[4] = {};
    const int vb0 = (int)(size_t)(lds + MLA_V_OFF) + v_rd_base(lane);
    const LAS char* kbn[4];
#pragma unroll
    for (int dd = 0; dd < 4; ++dd) kbn[dd] = lds + MLA_KN_OFF + r32 * 256 + (((dd * 16 + hi * 8) * 2) ^ ((r32 & 7) << 4));
#define ST_ISSUE_K(kb_, BF) do { const char* kt_ = kvb + (size_t)(kb_) * 8192;                                                             \
        GLDS(kt_ + voff_kn, lds + MLA_KN_OFF + (BF) * MLA_TILE + ldsw); GLDS(kt_ + 32 * 8192 + voff_kn, lds + MLA_KN_OFF + (BF) * MLA_TILE + 8192 + ldsw); \
        GLDS(krb + (size_t)(kb_) * 128 + voff_kr, lds + MLA_KR_OFF + (BF) * MLA_KR_BYTES + ldsw); } while (0)
#define ST_ISSUE_V(kb_, BF) do { const char* kt_ = kvb + (size_t)(kb_) * 8192;                                                             \
        GLDS(kt_ + voff_v, lds + MLA_V_OFF + (BF) * MLA_TILE + ldsw);   GLDS(kt_ + 32 * 8192 + voff_v, lds + MLA_V_OFF + (BF) * MLA_TILE + 8192 + ldsw); } while (0)
#define QK_TILE(P0_, P1_, BF) do { P0_ = f32x16{}; P1_ = f32x16{};                                                                          \
        _Pragma("unroll") for (int d0 = 0; d0 < 8; ++d0) { const LAS char* a_ = kbn[d0 & 3] + (BF) * MLA_TILE + (d0 >> 2) * 128;            \
            const bf16x8 b0 = *reinterpret_cast<const LAS bf16x8*>(a_), b1 = *reinterpret_cast<const LAS bf16x8*>(a_ + 32 * 256);            \
            P0_ = __builtin_amdgcn_mfma_f32_32x32x16_bf16(b0, qr[d0], P0_, 0, 0, 0); P1_ = __builtin_amdgcn_mfma_f32_32x32x16_bf16(b1, qr[d0], P1_, 0, 0, 0); } \
        _Pragma("unroll") for (int d0 = 0; d0 < 4; ++d0) { const LAS char* a_ = kbn[d0] + (MLA_KR_OFF - MLA_KN_OFF) + (BF) * MLA_KR_BYTES;  \
            const bf16x8 b0 = *reinterpret_cast<const LAS bf16x8*>(a_), b1 = *reinterpret_cast<const LAS bf16x8*>(a_ + 128);                 \
            P0_ = __builtin_amdgcn_mfma_f32_32x32x16_bf16(b0, qr[8 + d0], P0_, 0, 0, 0); P1_ = __builtin_amdgcn_mfma_f32_32x32x16_bf16(b1, qr[8 + d0], P1_, 0, 0, 0); } } while (0)
    f32x16 pA0, pA1, pB0, pB1;
    const bool grpA = wid < 4;
#define HB(vm) do { asm volatile("s_waitcnt vmcnt(" #vm ") lgkmcnt(0)" ::: "memory"); __builtin_amdgcn_s_barrier(); asm volatile("" ::: "memory"); } while (0)
#define QK_IF(t_, P0_, P1_, BF) do { if ((t_) < NT && (t_) * KVBLK <= qlo + 31) QK_TILE(P0_, P1_, BF); } while (0)
#define SMPV(t_, C0, C1, BF) do { const int kb = (t_) * KVBLK;                                                                            \
        if (kb <= qlo + 31) {                                                                                                             \
            float mn, alpha; bf16x8 pa0, pa1, pa2, pa3;                                                                                   \
            if (kb + KVBLK - 1 > qlo) mask_tile(C0, C1, qm - kb, 0x7fffffffu);                                                            \
            partialSM(C0, C1, m_reg, mn, alpha, SCALE);                                                                                   \
            finishSM(C0, C1, alpha, l_reg, pa0, pa1, pa2, pa3);                                                                           \
            if (__any(alpha < 1.f)) { if (hi == 0) al_l[r32] = alpha; LDS_WAIT();                                                         \
                _Pragma("unroll") for (int d_ = 0; d_ < 4; ++d_) _Pragma("unroll") for (int r = 0; r < 16; ++r) o[d_][r] *= al_l[crow(r, hi)]; } \
            pv_tile<MLA_V_OFF + (BF) * MLA_TILE>(o, vb0, pa0, pa1, pa2, pa3);                                                             \
        } } while (0)
#define ISSUE_K2(kb_, BF) do { const char* kt_ = kvb + (size_t)(kb_) * 8192; const char* kr_ = krb + (size_t)(kb_) * 128;                   \
        _Pragma("unroll") for (int pp = 0; pp < 2; ++pp) {                                                                                 \
            GLDS(kt_ + pp * 16 * 8192 + voff_kn, lds + MLA_KN_OFF + (BF) * MLA_TILE + pp * 4096 + ldsw);                                    \
            GLDS(kt_ + (32 + pp * 16) * 8192 + voff_kn, lds + MLA_KN_OFF + (BF) * MLA_TILE + 8192 + pp * 4096 + ldsw);                      \
            GLDS(kr_ + pp * 16 * 128 + voff_kr, lds + MLA_KR_OFF + (BF) * MLA_KR_BYTES + pp * 4096 + ldsw); } } while (0)
#define ISSUE_V2(kb_, BF) do { const char* kt_ = kvb + (size_t)(kb_) * 8192;                                                               \
        _Pragma("unroll") for (int pp = 0; pp < 2; ++pp) {                                                                                 \
            GLDS(kt_ + pp * 16 * 8192 + voff_v, lds + MLA_V_OFF + (BF) * MLA_TILE + pp * 4096 + ldsw);                                      \
            GLDS(kt_ + (32 + pp * 16) * 8192 + voff_v, lds + MLA_V_OFF + (BF) * MLA_TILE + 8192 + pp * 4096 + ldsw); } } while (0)
    ST_ISSUE_K(0, 0); ST_ISSUE_V(0, 0); ST_ISSUE_K(KVBLK, 1);
    HB(0);
    QK_TILE(pA0, pA1, 0);
    HB(0);
    if (!grpA) HB(0);
    for (int t = 0; t < NT; t += 2) {
        if (grpA && t + 2 < NT) ISSUE_K2((t + 2) * KVBLK, 0);
        QK_IF(t + 1, pB0, pB1, 1);
        if (t + 2 < NT) HB(6); else HB(0);
        if (grpA) ISSUE_V2((t + 1) * KVBLK, 1);
        SMPV(t, pA0, pA1, 0);
        HB(4);
        if (grpA && t + 3 < NT) ISSUE_K2((t + 3) * KVBLK, 1);
        QK_IF(t + 2, pA0, pA1, 0);
        if (t + 3 < NT) HB(6); else HB(0);
        if (grpA && t + 2 < NT) ISSUE_V2((t + 2) * KVBLK, 0);
        SMPV(t + 1, pB0, pB1, 1);
        if (t + 2 < NT) HB(4); else HB(0);
    }
    if (grpA) HB(0);
#undef ISSUE_K2
#undef ISSUE_V2
#undef SMPV
#undef QK_IF
#undef HB
#undef QK_TILE
#undef ST_ISSUE_K
#undef ST_ISSUE_V
#undef TILE_STEP
#undef ST_ISSUE
#undef GLDS
    if (hi == 0) li_l[r32] = l_reg; LDS_WAIT();
    LAS char* ost = lds + wid * 8192;
#pragma unroll
    for (int r = 0; r < 16; ++r) { const int orow = crow(r, hi); const float rl = __builtin_amdgcn_rcpf(li_l[orow]);
#pragma unroll
        for (int d0 = 0; d0 < 4; ++d0) { const float v = o[d0][r] * rl; const float vn = __shfl_xor(v, 1);
            if ((r32 & 1) == 0) *(LAS unsigned*)(ost + orow * 256 + (d0 * 32 + r32) * 2) = cvt_pk_bf16(v, vn); } }
    LDS_WAIT();
    bf16_t* Ow = omla + (size_t)(tb + qlo) * 2048 + h * 128;
#pragma unroll
    for (int k = 0; k < 8; ++k) { const int row = k * 4 + (lane >> 4), ch = lane & 15;
        const u32x4 w = *(const LAS u32x4*)(ost + row * 256 + ch * 16);
        *(u32x4*)(Ow + (size_t)row * 2048 + ch * 8) = w; }
    __syncthreads();
}

constexpr int XA_K_OFF = 32768, XA_WS_OFF = 65536;
__device__ __forceinline__ void xattn_block(LAS char* lds, const bf16_t* __restrict__ qc, const bf16_t* __restrict__ kc, const bf16_t* __restrict__ vc, bf16_t* __restrict__ oc, int b, int h, int qb) {
    const float SCALE = 0.0625f;
    int tid_ = threadIdx.x; asm volatile("" : "+v"(tid_));
    const int tid = tid_, wid = __builtin_amdgcn_readfirstlane(tid >> 6), lane = tid & 63, r32 = lane & 31, hi = lane >> 5;
    const int rg = wid & 3, vsp = wid >> 2;
    LAS float* wsf = (LAS float*)(lds + XA_WS_OFF) + wid * 64; LAS float* li_l = wsf; LAS float* al_l = wsf + 32;
    const int row0 = b * SEQ + qb * 128 + rg * 32;
    bf16x8 qr[16];
    { const bf16_t* qp = qc + (size_t)(row0 + r32) * 1024 + h * 256;
#pragma unroll
      for (int d0 = 0; d0 < 16; ++d0) qr[d0] = *(const bf16x8*)(qp + d0 * 16 + hi * 8); }
    unsigned voff_k, voff_v;
    { const int row = tid >> 5, cp_ = tid & 31, g = cp_ >> 3, j = cp_ & 7;
      voff_k = (unsigned)(row * 2048 + (h * 256 + (g * 8 + (j ^ (row & 7))) * 8) * 2);
      const int kk = (tid >> 7) * 8 + ((tid & 31) >> 2), key = (kk & ~0xC) | ((kk & 4) << 1) | ((kk & 8) >> 1), c = ((tid >> 5) & 3) * 32 + (tid & 3) * 8;
      voff_v = (unsigned)(key * 2048 + (h * 256 + c) * 2); }
    const char* kcb = (const char*)(kc + (size_t)b * MEMT * 1024); const char* vcb = (const char*)(vc + (size_t)b * MEMT * 1024);
    const unsigned ldsw = (unsigned)wid * 1024u;
#define GLDS(gp, lp) __builtin_amdgcn_global_load_lds((const unsigned*)(gp), (LAS unsigned*)(lp), 16, 0, 0)
    float m_reg = -1e30f, l_reg = 0.f; f32x16 o[4] = {};
    const int vb0 = (int)(size_t)(lds + vsp * 16384) + v_rd_base(lane);
    const LAS char* kbn[4];
#pragma unroll
    for (int dd = 0; dd < 4; ++dd) kbn[dd] = lds + XA_K_OFF + r32 * 512 + (((dd * 16 + hi * 8) * 2) ^ ((r32 & 7) << 4));
    for (int t = 0; t < 4; ++t) {
        const char* kt_ = kcb + (size_t)(t * 64) * 2048; const char* vt_ = vcb + (size_t)(t * 64) * 2048;
        __syncthreads();
#pragma unroll
        for (int i = 0; i < 4; ++i) GLDS(kt_ + (size_t)i * 16 * 2048 + voff_k, lds + XA_K_OFF + i * 8192 + ldsw);
#pragma unroll
        for (int hv = 0; hv < 2; ++hv)
#pragma unroll
            for (int i = 0; i < 2; ++i) GLDS(vt_ + (size_t)i * 32 * 2048 + hv * 256 + voff_v, lds + hv * 16384 + i * 8192 + ldsw);
        asm volatile("s_waitcnt vmcnt(0)" ::: "memory");
        __syncthreads();
        f32x16 p0 = {}, p1 = {}; float mn, alpha; bf16x8 pa0, pa1, pa2, pa3;
#pragma unroll
        for (int d0 = 0; d0 < 16; ++d0) { const LAS char* a_ = kbn[d0 & 3] + (d0 >> 2) * 128;
            const bf16x8 b0 = *reinterpret_cast<const LAS bf16x8*>(a_), b1 = *reinterpret_cast<const LAS bf16x8*>(a_ + 32 * 512);
            p0 = __builtin_amdgcn_mfma_f32_32x32x16_bf16(b0, qr[d0], p0, 0, 0, 0); p1 = __builtin_amdgcn_mfma_f32_32x32x16_bf16(b1, qr[d0], p1, 0, 0, 0); }
        partialSM(p0, p1, m_reg, mn, alpha, SCALE);
        finishSM(p0, p1, alpha, l_reg, pa0, pa1, pa2, pa3);
        if (__any(alpha < 1.f)) { if (hi == 0) al_l[r32] = alpha; LDS_WAIT();
#pragma unroll
            for (int d_ = 0; d_ < 4; ++d_)
#pragma unroll
                for (int r = 0; r < 16; ++r) o[d_][r] *= al_l[crow(r, hi)]; }
        pv_tile<0>(o, vb0, pa0, pa1, pa2, pa3);
    }
#undef GLDS
    if (hi == 0) li_l[r32] = l_reg; LDS_WAIT();
    bf16_t* Ow = oc + (size_t)row0 * 1024 + h * 256 + vsp * 128;
#pragma unroll
    for (int r = 0; r < 16; ++r) { const int orow = crow(r, hi); const float rl = __builtin_amdgcn_rcpf(li_l[orow]);
#pragma unroll
        for (int d0 = 0; d0 < 4; ++d0) { const float v = o[d0][r] * rl; const float vn = __shfl_xor(v, 1);
            if ((r32 & 1) == 0) *(unsigned*)(Ow + (size_t)orow * 1024 + d0 * 32 + r32) = cvt_pk_bf16(v, vn); } }
    __syncthreads();
}
}

constexpr int STAGE_BYTES = 131072;
constexpr int MISC_OFF = STAGE_BYTES;
constexpr int XSTG_OFF = STAGE_BYTES + 256;
constexpr int LDS_BYTES = XSTG_OFF + 8 * 2304;

struct Args { const float* in[26]; float* out; unsigned char* ws; int ph_lo, ph_hi; };

struct Frame {
    LAS unsigned char* lds;
    int tid, lane, wave, G, bid;
    int gw, NGW;
    int xj, xrank, xn;
};

__device__ __forceinline__ int win_map(int n) {
    if (n < 1536) return n;
    if (n < 1600) return 7680 + (n - 1536);
    if (n < 5696) return n - 64;
    if (n < 5712) return 7744 + (n - 5696);
    return n - 80;
}
template <int MODE>
__device__ __forceinline__ void transpose_item(const float* W, int K, int N, bf16_t* WT, const float* gain, LAS float* scr, int item, int lane) {
    const int nblk = (N + 31) / 32, kb = item / nblk, nb = item % nblk, k0 = 64 * kb, n0 = 32 * nb;
    const int n4 = n0 + 4 * (lane & 7); const bool nok = n4 < N;
    f32x4 v[8];
#pragma unroll
    for (int i = 0; i < 8; ++i) v[i] = nok ? *(const f32x4*)(W + (size_t)(k0 + 8 * i + (lane >> 3)) * N + n4) : (f32x4){0.f, 0.f, 0.f, 0.f};
#pragma unroll
    for (int i = 0; i < 8; ++i) { const int kk = 8 * i + (lane >> 3); const float g = gain ? gain[k0 + kk] : 1.0f; LAS float* d = scr + kk * 33 + 4 * (lane & 7);
        d[0] = v[i][0] * g; d[1] = v[i][1] * g; d[2] = v[i][2] * g; d[3] = v[i][3] * g; }
    LDS_WAIT();
    const int c = lane & 7;
#pragma unroll
    for (int j = 0; j < 4; ++j) { const int n = (lane >> 3) + 8 * j; const LAS float* s = scr + (8 * c) * 33 + n;
        u32x4 o; o.x = cvt_pk_bf16(s[0 * 33], s[1 * 33]); o.y = cvt_pk_bf16(s[2 * 33], s[3 * 33]); o.z = cvt_pk_bf16(s[4 * 33], s[5 * 33]); o.w = cvt_pk_bf16(s[6 * 33], s[7 * 33]);
        const int ng = n0 + n;
        if (ng < N) { const int row = MODE == 1 ? win_map(ng) : ng; *(u32x4*)(WT + (size_t)row * K + k0 + 8 * c) = o; } }
    LDS_WAIT();
}
template <int MODE>
__device__ __forceinline__ void transpose_all(const Frame& F, const float* W, int K, int N, bf16_t* WT, const float* gain, int& cursor) {
    LAS float* scr = (LAS float*)(F.lds + F.wave * 8704);
    const int nitems = (K / 64) * ((N + 31) / 32);
    int first = (F.gw - cursor % F.NGW + F.NGW) % F.NGW;
    for (int it = first; it < nitems; it += F.NGW) transpose_item<MODE>(W, K, N, WT, gain, scr, it, F.lane);
    cursor += nitems;
}


__device__ __forceinline__ void p0_prologue(const Frame& F, const Args& a) {
    unsigned char* ws = a.ws;
    int cursor = 0;
    transpose_all<1>(F, a.in[5], D, IN_W, (bf16_t*)(ws + WS_WIN), a.in[4], cursor);
    transpose_all<0>(F, a.in[7], 1024, 3072, (bf16_t*)(ws + WS_WUQ), a.in[6], cursor);
    transpose_all<0>(F, a.in[9], 512, 4096, (bf16_t*)(ws + WS_WUKV), a.in[8], cursor);
    transpose_all<0>(F, a.in[14], D, D, (bf16_t*)(ws + WS_WOUT), nullptr, cursor);
    transpose_all<0>(F, a.in[16], D, 1024, (bf16_t*)(ws + WS_WCQ), a.in[15], cursor);
    transpose_all<0>(F, a.in[17], D, 1024, (bf16_t*)(ws + WS_WCK), nullptr, cursor);
    transpose_all<0>(F, a.in[18], D, 1024, (bf16_t*)(ws + WS_WCV), nullptr, cursor);
    transpose_all<0>(F, a.in[19], 1024, D, (bf16_t*)(ws + WS_WCO), nullptr, cursor);
    transpose_all<0>(F, a.in[21], D, 2048, (bf16_t*)(ws + WS_WPQ), a.in[20], cursor);
    { u32x4* z = (u32x4*)(ws + WS_WIN + (size_t)IN_W * D * 2); const size_t n16 = (size_t)(IN_WP - IN_W) * D * 2 / 16;
      for (size_t i = (size_t)F.bid * NTHREADS + F.tid; i < n16; i += (size_t)F.G * NTHREADS) z[i] = (u32x4){0u, 0u, 0u, 0u}; }
    { const float* k = a.in[22]; bf16_t* o = (bf16_t*)(ws + WS_KEYS); const size_t n8 = (size_t)8 * 2 * 128 * 128 / 8;
      for (size_t i = (size_t)F.bid * NTHREADS + F.tid; i < n8; i += (size_t)F.G * NTHREADS) {
          const f32x4 v0 = *(const f32x4*)(k + i * 8), v1 = *(const f32x4*)(k + i * 8 + 4); *(bf16x8*)(o + i * 8) = pack8(v0, v1); } }
    { const int* pos = (const int*)a.in[2]; float* cs = (float*)(ws + WS_ROPE); float* sn = cs + (size_t)M * 32;
      for (size_t i = (size_t)F.bid * NTHREADS + F.tid; i < (size_t)M * 32; i += (size_t)F.G * NTHREADS) {
          const int m = (int)(i >> 5), fi = (int)(i & 31);
          const float inv = exp2f(-(float)fi * (13.287712379549449f / 32.0f));
          const float ang = (float)pos[m] * inv;
          const float kf = rintf(ang * 0.15915494309189535f);
          float r = fmaf(-kf, 6.28125f, ang); r = fmaf(-kf, 1.9353071795864769e-3f, r);
          const float rev = r * 0.15915494309189535f;
          cs[i] = __builtin_amdgcn_cosf(rev); sn[i] = __builtin_amdgcn_sinf(rev); } }
    { const float* x = a.in[0]; bf16_t* xb = (bf16_t*)(ws + WS_XB); float* rs = (float*)(ws + WS_RSTDX);
      for (int m = F.gw; m < M; m += F.NGW) {
          const f32x4* xr = (const f32x4*)(x + (size_t)m * D); u32x2* xo = (u32x2*)(xb + (size_t)m * D); float ss = 0.f;
          f32x4 v[16];
#pragma unroll
          for (int j = 0; j < 16; ++j) v[j] = xr[F.lane + 64 * j];
#pragma unroll
          for (int j = 0; j < 16; ++j) { ss += (v[j][0] * v[j][0] + v[j][1] * v[j][1]) + (v[j][2] * v[j][2] + v[j][3] * v[j][3]);
              u32x2 p; p.x = cvt_pk_bf16(v[j][0], v[j][1]); p.y = cvt_pk_bf16(v[j][2], v[j][3]); xo[F.lane + 64 * j] = p; }
          ss = wave_sum(ss);
          if (F.lane == 0) rs[m] = 1.0f / sqrtf(ss * (1.0f / D) + EPS); } }
    { const float* mem = a.in[1]; const float* g = a.in[3]; bf16_t* mn = (bf16_t*)(ws + WS_MN);
      for (int m = F.gw; m < MROWS; m += F.NGW) {
          const f32x4* xr = (const f32x4*)(mem + (size_t)m * D); const f32x4* gr = (const f32x4*)g; u32x4* xo = (u32x4*)(mn + (size_t)m * D);
          f32x4 v[16]; float ss = 0.f;
#pragma unroll
          for (int j = 0; j < 8; ++j) { v[2 * j] = xr[2 * F.lane + 128 * j]; v[2 * j + 1] = xr[2 * F.lane + 1 + 128 * j]; }
#pragma unroll
          for (int j = 0; j < 16; ++j) ss += (v[j][0] * v[j][0] + v[j][1] * v[j][1]) + (v[j][2] * v[j][2] + v[j][3] * v[j][3]);
          ss = wave_sum(ss); const float r = 1.0f / sqrtf(ss * (1.0f / D) + EPS);
#pragma unroll
          for (int j = 0; j < 8; ++j) { const f32x4 g0 = gr[2 * F.lane + 128 * j], g1 = gr[2 * F.lane + 1 + 128 * j];
              const bf16x8 p = pack8(v[2 * j] * r * g0, v[2 * j + 1] * r * g1); xo[F.lane + 64 * j] = *(const u32x4*)&p; } } }
}


__device__ __forceinline__ unsigned short f2bf(float v) { return (unsigned short)(cvt_pk_bf16(v, 0.f) & 0xffffu); }
__device__ __forceinline__ float ssq8(bf16x8 v) { float s = 0.f;
#pragma unroll
    for (int e = 0; e < 8; ++e) { const float a = bf2f((unsigned short)v[e]); s += a * a; } return s; }
__device__ __forceinline__ void p2_stats(const Frame& F, unsigned char* ws) {
    const bf16_t* cq = (const bf16_t*)(ws + WS_CQ); const bf16_t* ckv = (const bf16_t*)(ws + WS_CKV); const bf16_t* sm = (const bf16_t*)(ws + WS_SM);
    const float* cs = (const float*)(ws + WS_ROPE); const float* sn = cs + (size_t)M * 32;
    float* rq = (float*)(ws + WS_RSTDQ); float* rkv = (float*)(ws + WS_RSTDKV); bf16_t* kr = (bf16_t*)(ws + WS_KROPE);
    for (int m = F.gw; m < M; m += F.NGW) {
        const bf16x8* a = (const bf16x8*)(cq + (size_t)m * 1024);
        float s1 = ssq8(a[2 * F.lane]) + ssq8(a[2 * F.lane + 1]);
        float s2 = ssq8(((const bf16x8*)(ckv + (size_t)m * 512))[F.lane]);
        s1 = wave_sum(s1); s2 = wave_sum(s2);
        if (F.lane == 0) { rq[m] = 1.0f / sqrtf(s1 * (1.0f / 1024.0f) + EPS); rkv[m] = 1.0f / sqrtf(s2 * (1.0f / 512.0f) + EPS); }
        if (F.lane < 32) { const float x1 = bf2f(sm[(size_t)m * 256 + F.lane]), x2 = bf2f(sm[(size_t)m * 256 + 32 + F.lane]);
            const float c = cs[(size_t)m * 32 + F.lane], s = sn[(size_t)m * 32 + F.lane];
            kr[(size_t)m * 64 + F.lane] = f2bf(x1 * c - x2 * s); kr[(size_t)m * 64 + 32 + F.lane] = f2bf(x2 * c + x1 * s); }
    }
}

__device__ __forceinline__ size_t fr_index(int cgh, int kblk, int mt, int lane, int j) { return ((((size_t)cgh * 8 + kblk) * 4 + mt) * 64 + lane) * 8 + j; }
__device__ __forceinline__ size_t kd_index(int cgh, int w, int t, int s, int lane, int j) { return (((((size_t)cgh * 8 + w) * 2 + t) * 2 + s) * 64 + lane) * 8 + j; }
__device__ __forceinline__ void p2_gla_prep(const Frame& F, unsigned char* ws, const float* __restrict__ w_gate_up, const float* __restrict__ b_gate) {
    const bf16_t* __restrict__ gq = (const bf16_t*)(ws + WS_GQ); const bf16_t* __restrict__ gk = (const bf16_t*)(ws + WS_GK); const bf16_t* __restrict__ sm = (const bf16_t*)(ws + WS_SM);
    bf16_t* __restrict__ qep = (bf16_t*)(ws + WS_QEP); bf16_t* __restrict__ kep = (bf16_t*)(ws + WS_KEP); bf16_t* __restrict__ kdt = (bf16_t*)(ws + WS_KDT); float* __restrict__ dec = (float*)(ws + WS_DEC);
    LAS float* glr = (LAS float*)F.lds;
    LAS float* tot = glr + 1024;
    LAS float* bcl = glr + 1280;
    constexpr int BP = 260;
    for (int cgh = F.bid; cgh < 1024; cgh += F.G) {
        const int cg = cgh >> 2, h = cgh & 3, t0 = cg * 64;
        __syncthreads();
        if (F.tid < 128) { const int tok = F.tid >> 1, half = F.tid & 1; const bf16x8 v = *(const bf16x8*)(sm + (size_t)(t0 + tok) * 256 + 64 + half * 8);
#pragma unroll
            for (int e = 0; e < 8; ++e) glr[tok * 16 + half * 8 + e] = bf2f((unsigned short)v[e]); }
        const int d = F.tid & 255, th = F.tid >> 8;
        float w[16];
#pragma unroll
        for (int r = 0; r < 16; ++r) w[r] = w_gate_up[r * 1024 + h * 256 + d];
        const float bg = b_gate[h * 256 + d];
        unsigned short kraw[32];
#pragma unroll
        for (int c = 0; c < 32; ++c) kraw[c] = gk[(size_t)(t0 + 32 * th + c) * 1024 + h * 256 + d];
        __syncthreads();
        float bc[32]; float cum = 0.f;
#pragma unroll
        for (int c = 0; c < 32; ++c) { float z = bg;
#pragma unroll
            for (int r4 = 0; r4 < 4; ++r4) { const f32x4 gv = *(const LAS f32x4*)(glr + (32 * th + c) * 16 + r4 * 4); z += gv[0] * w[r4 * 4] + gv[1] * w[r4 * 4 + 1] + gv[2] * w[r4 * 4 + 2] + gv[3] * w[r4 * 4 + 3]; }
            const float ls = fminf(z, 0.f) - __logf(1.0f + __expf(-fabsf(z)));
            cum += ls * (1.0f / 16.0f); bc[c] = cum; }
        if (th == 0) tot[d] = cum;
        __syncthreads();
        const float base = th ? tot[d] : 0.f;
        const float blast = th ? base + cum : 0.f;
        if (th == 1) tot[d] = blast;
#pragma unroll
        for (int c = 0; c < 32; ++c) { bc[c] += base; bcl[(32 * th + c) * BP + d] = bc[c]; }
        __syncthreads();
        const float bl = tot[d];
        if (th == 0) dec[(size_t)cgh * 256 + d] = __expf(bl);
        { const int wq = d >> 5, tq = (d >> 4) & 1, col = d & 15;
#pragma unroll
          for (int q_ = 0; q_ < 4; ++q_) { float kd8[8];
#pragma unroll
              for (int j = 0; j < 8; ++j) kd8[j] = bf2f(kraw[8 * q_ + j]) * __expf(bl - bc[8 * q_ + j]);
              *(bf16x8*)(kdt + kd_index(cgh, wq, tq, th, q_ * 16 + col, 0)) = pack8((f32x4){kd8[0], kd8[1], kd8[2], kd8[3]}, (f32x4){kd8[4], kd8[5], kd8[6], kd8[7]}); } }
        { const int c = F.tid & 63, o = F.tid >> 6; const size_t tok = (size_t)(t0 + c);
          bf16x8 qv[4], kv[4];
#pragma unroll
          for (int i = 0; i < 4; ++i) { qv[i] = *(const bf16x8*)(gq + tok * 1024 + h * 256 + 32 * o + 8 * i); kv[i] = *(const bf16x8*)(gk + tok * 1024 + h * 256 + 32 * o + 8 * i); }
          float eb[32];
#pragma unroll
          for (int i = 0; i < 8; ++i) { const f32x4 bv = *(const LAS f32x4*)(bcl + c * BP + 32 * o + 4 * i);
#pragma unroll
              for (int e = 0; e < 4; ++e) eb[4 * i + e] = __expf(bv[e]); }
#pragma unroll
          for (int q_ = 0; q_ < 4; ++q_) { float qe8[8], ke8[8];
#pragma unroll
              for (int j = 0; j < 8; ++j) { const int kk = j < 4 ? 4 * q_ + j : 16 + 4 * q_ + (j - 4);
                  const float e_ = eb[kk];
                  qe8[j] = bf2f((unsigned short)qv[kk >> 3][kk & 7]) * 0.0625f * e_; ke8[j] = bf2f((unsigned short)kv[kk >> 3][kk & 7]) * __builtin_amdgcn_rcpf(e_); }
              const size_t fi = fr_index(cgh, o, c >> 4, q_ * 16 + (c & 15), 0);
              *(bf16x8*)(qep + fi) = pack8((f32x4){qe8[0], qe8[1], qe8[2], qe8[3]}, (f32x4){qe8[4], qe8[5], qe8[6], qe8[7]});
              *(bf16x8*)(kep + fi) = pack8((f32x4){ke8[0], ke8[1], ke8[2], ke8[3]}, (f32x4){ke8[4], ke8[5], ke8[6], ke8[7]}); } }
    }
    __syncthreads();
}
__device__ __forceinline__ void p3_gla_att(const Frame& F, unsigned char* ws) {
    const bf16_t* qep = (const bf16_t*)(ws + WS_QEP); const bf16_t* kep = (const bf16_t*)(ws + WS_KEP); bf16_t* att = (bf16_t*)(ws + WS_ATT);
    const int mt = F.wave >> 1, nt0 = (F.wave & 1) * 2, col = F.lane & 15, q_ = F.lane >> 4;
    for (int cgh = F.bid; cgh < 1024; cgh += F.G) {
        f32x4 a0 = {0.f, 0.f, 0.f, 0.f}, a1 = {0.f, 0.f, 0.f, 0.f};
#pragma unroll
        for (int kb = 0; kb < 8; ++kb) { const bf16x8 A = *(const bf16x8*)(qep + fr_index(cgh, kb, mt, F.lane, 0));
            const bf16x8 B0 = *(const bf16x8*)(kep + fr_index(cgh, kb, nt0, F.lane, 0)), B1 = *(const bf16x8*)(kep + fr_index(cgh, kb, nt0 + 1, F.lane, 0));
            a0 = __builtin_amdgcn_mfma_f32_16x16x32_bf16(A, B0, a0, 0, 0, 0); a1 = __builtin_amdgcn_mfma_f32_16x16x32_bf16(A, B1, a1, 0, 0, 0); }
#pragma unroll
        for (int r = 0; r < 4; ++r) { const int c = mt * 16 + 4 * q_ + r, j0 = nt0 * 16 + col, j1 = j0 + 16;
            att[((size_t)cgh * 64 + c) * 64 + j0] = f2bf(j0 <= c ? a0[r] : 0.f); att[((size_t)cgh * 64 + c) * 64 + j1] = f2bf(j1 <= c ? a1[r] : 0.f); }
    }
}
__device__ __forceinline__ void p5_gla_scan(const Frame& F, unsigned char* ws) {
    const bf16_t* qep = (const bf16_t*)(ws + WS_QEP); const bf16_t* kdt = (const bf16_t*)(ws + WS_KDT); const bf16_t* att = (const bf16_t*)(ws + WS_ATT);
    const float* dec = (const float*)(ws + WS_DEC); const bf16_t* gv = (const bf16_t*)(ws + WS_GV); bf16_t* og = (bf16_t*)(ws + WS_OGLA);
    LAS bf16_t* vbuf = (LAS bf16_t*)F.lds;
    LAS float* red = (LAS float*)(F.lds + 4096);
    const int w = F.wave, lane = F.lane, col = lane & 15, q_ = lane >> 4;
    const int vtr = (int)(size_t)vbuf + (8 * q_ + (col >> 2)) * 32 + 8 * (col & 3);
    for (int item = F.bid; item < 256; item += F.G) {
        const int bh = item >> 5, vs = item & 31, b = bh >> 2, h = bh & 3;
        f32x4 st0 = {0.f, 0.f, 0.f, 0.f}, st1 = {0.f, 0.f, 0.f, 0.f};
        __syncthreads();
        bf16x8 vst = {};
        if (F.tid < 128) vst = *(const bf16x8*)(gv + (size_t)(b * SEQ + (F.tid >> 1)) * 2048 + h * 512 + vs * 16 + (F.tid & 1) * 8);
        if (F.tid < 128) *(LAS bf16x8*)(vbuf + (F.tid >> 1) * 16 + (F.tid & 1) * 8) = vst;
        __syncthreads();
        bf16x8 Aq[4], Ak[2][2], Aa[2] = {}; f32x4 dc0, dc1;
#define GLA_LOAD_OPS(n_) do { const int cg_ = (b * 128 + (n_)) * 4 + h;                                                                   \
            _Pragma("unroll") for (int mt = 0; mt < 4; ++mt) Aq[mt] = *(const bf16x8*)(qep + fr_index(cg_, w, mt, lane, 0));                 \
            _Pragma("unroll") for (int t = 0; t < 2; ++t) _Pragma("unroll") for (int s = 0; s < 2; ++s)                                       \
                Ak[t][s] = *(const bf16x8*)(kdt + kd_index(cg_, w, t, s, lane, 0));                                                              \
            if (w < 4) { _Pragma("unroll") for (int s = 0; s < 2; ++s) Aa[s] = *(const bf16x8*)(att + ((size_t)cg_ * 64 + 16 * w + col) * 64 + 32 * s + 8 * q_); } \
            dc0 = *(const f32x4*)(dec + (size_t)cg_ * 256 + 32 * w + 4 * q_); dc1 = *(const f32x4*)(dec + (size_t)cg_ * 256 + 32 * w + 16 + 4 * q_); } while (0)
        GLA_LOAD_OPS(0);
        for (int n = 0; n < 128; ++n) {
            const int t0 = b * SEQ + n * 64, pb = n & 1;
            if (n + 1 < 128 && F.tid < 128) vst = *(const bf16x8*)(gv + (size_t)(t0 + 64 + (F.tid >> 1)) * 2048 + h * 512 + vs * 16 + (F.tid & 1) * 8);
            bf16x8 Bv[2];
            { const int va = vtr + pb * 2048; s16x4 t0, t1, t2, t3;
              asm volatile("ds_read_b64_tr_b16 %0, %4\n\tds_read_b64_tr_b16 %1, %4 offset:128\n\tds_read_b64_tr_b16 %2, %4 offset:1024\n\tds_read_b64_tr_b16 %3, %4 offset:1152\n\ts_waitcnt lgkmcnt(0)"
                           : "=&v"(t0), "=&v"(t1), "=&v"(t2), "=&v"(t3) : "v"(va) : "memory");
              Bv[0] = (bf16x8){t0[0], t0[1], t0[2], t0[3], t1[0], t1[1], t1[2], t1[3]}; Bv[1] = (bf16x8){t2[0], t2[1], t2[2], t2[3], t3[0], t3[1], t3[2], t3[3]}; }
            u32x4 sw = {cvt_pk_bf16(st0[0], st0[1]), cvt_pk_bf16(st0[2], st0[3]), cvt_pk_bf16(st1[0], st1[1]), cvt_pk_bf16(st1[2], st1[3])};
            const bf16x8 Bs = *reinterpret_cast<bf16x8*>(&sw);
            f32x4 part[4];
#pragma unroll
            for (int mt = 0; mt < 4; ++mt) part[mt] = __builtin_amdgcn_mfma_f32_16x16x32_bf16(Aq[mt], Bs, (f32x4){0.f, 0.f, 0.f, 0.f}, 0, 0, 0);
            if (w < 4) {
#pragma unroll
                for (int mt = 0; mt < 4; ++mt) if (mt == w) {
                    part[mt] = __builtin_amdgcn_mfma_f32_16x16x32_bf16(Aa[0], Bv[0], part[mt], 0, 0, 0);
                    part[mt] = __builtin_amdgcn_mfma_f32_16x16x32_bf16(Aa[1], Bv[1], part[mt], 0, 0, 0); } }
            st0 = st0 * dc0; st1 = st1 * dc1;
            st0 = __builtin_amdgcn_mfma_f32_16x16x32_bf16(Ak[0][0], Bv[0], st0, 0, 0, 0); st0 = __builtin_amdgcn_mfma_f32_16x16x32_bf16(Ak[0][1], Bv[1], st0, 0, 0, 0);
            st1 = __builtin_amdgcn_mfma_f32_16x16x32_bf16(Ak[1][0], Bv[0], st1, 0, 0, 0); st1 = __builtin_amdgcn_mfma_f32_16x16x32_bf16(Ak[1][1], Bv[1], st1, 0, 0, 0);
            __builtin_amdgcn_sched_barrier(0);
            if (n + 1 < 128) GLA_LOAD_OPS(n + 1);
#pragma unroll
            for (int mt = 0; mt < 4; ++mt) *(LAS f32x4*)(red + (size_t)pb * 8192 + ((w * 4 + mt) * 64 + lane) * 4) = part[mt];
            if (n + 1 < 128 && F.tid < 128) *(LAS bf16x8*)(vbuf + (pb ^ 1) * 1024 + (F.tid >> 1) * 16 + (F.tid & 1) * 8) = vst;
            __syncthreads();
            { const int e0 = F.tid * 2, mt = e0 >> 8, ln = (e0 >> 2) & 63, r0 = e0 & 3;
              float s0 = 0.f, s1 = 0.f;
#pragma unroll
              for (int ww = 0; ww < 8; ++ww) { const LAS float* p = red + (size_t)pb * 8192 + ((ww * 4 + mt) * 64 + ln) * 4 + r0; s0 += p[0]; s1 += p[1]; }
              const int c = mt * 16 + 4 * (ln >> 4) + r0, cc = ln & 15;
              og[(size_t)(t0 + c) * 2048 + h * 512 + vs * 16 + cc] = f2bf(s0); og[(size_t)(t0 + c + 1) * 2048 + h * 512 + vs * 16 + cc] = f2bf(s1); }
        }
    }
#undef GLA_LOAD_OPS
    __syncthreads();
}

__device__ __forceinline__ void p6_mix(const Frame& F, unsigned char* ws, const float* g_mla, const float* g_gla) {
    const bf16_t* om = (const bf16_t*)(ws + WS_OMLA); bf16_t* mx = (bf16_t*)(ws + WS_XB); const bf16_t* og = (const bf16_t*)(ws + WS_OGLA); const bf16_t* gog = (const bf16_t*)(ws + WS_GOG);
    for (int m = F.gw; m < M; m += F.NGW) {
        const bf16x8* a = (const bf16x8*)(om + (size_t)m * 2048); bf16x8 v[4]; float ss = 0.f;
#pragma unroll
        for (int j = 0; j < 4; ++j) { v[j] = a[F.lane + 64 * j]; ss += ssq8(v[j]); }
        ss = wave_sum(ss); const float r = 1.0f / sqrtf(ss * (1.0f / 2048.0f) + EPS);
        u32x4* o = (u32x4*)(mx + (size_t)m * D);
#pragma unroll
        for (int j = 0; j < 4; ++j) { const int c0 = (F.lane + 64 * j) * 8; const f32x4 g0 = *(const f32x4*)(g_mla + c0), g1 = *(const f32x4*)(g_mla + c0 + 4);
            f32x4 x0, x1;
#pragma unroll
            for (int e = 0; e < 4; ++e) { x0[e] = bf2f((unsigned short)v[j][e]) * r * g0[e]; x1[e] = bf2f((unsigned short)v[j][4 + e]) * r * g1[e]; }
            const bf16x8 p = pack8(x0, x1); o[F.lane + 64 * j] = *(const u32x4*)&p; }
        const bf16x8* ga = (const bf16x8*)(og + (size_t)m * 2048); const bf16x8* gg = (const bf16x8*)(gog + (size_t)m * 2048);
#pragma unroll
        for (int j = 0; j < 4; ++j) { const bf16x8 ov = ga[F.lane + 64 * j], gt = gg[F.lane + 64 * j];
            const float hs = wave_sum(ssq8(ov)); const float rh = 1.0f / sqrtf(hs * (1.0f / 512.0f) + EPS);
            const int c0 = F.lane * 8; const f32x4 g0 = *(const f32x4*)(g_gla + c0), g1 = *(const f32x4*)(g_gla + c0 + 4);
            f32x4 x0, x1;
#pragma unroll
            for (int e = 0; e < 4; ++e) { const float z0 = bf2f((unsigned short)gt[e]), z1 = bf2f((unsigned short)gt[4 + e]);
                x0[e] = bf2f((unsigned short)ov[e]) * rh * g0[e] * (z0 / (1.0f + __expf(-z0)));
                x1[e] = bf2f((unsigned short)ov[4 + e]) * rh * g1[e] * (z1 / (1.0f + __expf(-z1))); }
            const bf16x8 p = pack8(x0, x1); o[256 + F.lane + 64 * j] = *(const u32x4*)&p; }
    }
}
__device__ __forceinline__ void p4_mla(const Frame& F, unsigned char* ws) {
    const bf16_t* q = (const bf16_t*)(ws + WS_Q); const bf16_t* kv = (const bf16_t*)(ws + WS_KV); const bf16_t* kr = (const bf16_t*)(ws + WS_KROPE);
    const float* cs = (const float*)(ws + WS_ROPE); const float* sn = cs + (size_t)M * 32; bf16_t* om = (bf16_t*)(ws + WS_OMLA);
    for (int L = F.bid; L < 512; L += F.G) {
        const int xcd = L & 7, I = L >> 3, bh = xcd * 4 + (I >> 4), pr = I & 15, b = bh >> 4, h = bh & 15;
        for (int pass = 0; pass < 2; ++pass) att::mla_block((LAS char*)F.lds, q, kv, kr, cs, sn, om, b, h, pass ? pr : 31 - pr);
    }
}


__device__ __forceinline__ void rstd_for_units(const Frame& F, const pg8::StaticOrder& S, const float* __restrict__ ssq, float* __restrict__ rstd) {
    pg8::Unit u;
    for (int i = 0; S.next(i, u); ++i) {
        float v[32];
#pragma unroll
        for (int k = 0; k < 32; ++k) v[k] = ssq[(size_t)(u.pm * 256 + F.wave * 32 + k) * 64 + F.lane];
        float mine = 0.f;
#pragma unroll
        for (int k = 0; k < 32; ++k) { const float s = wave_sum(v[k]); mine = (F.lane == k) ? s : mine; }
        if (F.lane < 32) rstd[u.pm * 256 + F.wave * 32 + F.lane] = 1.0f / sqrtf(mine * (1.0f / D) + EPS);
    }
    asm volatile("s_waitcnt vmcnt(0)" ::: "memory");
    __syncthreads();
}
__device__ __forceinline__ void p9_xattn(const Frame& F, unsigned char* ws) {
    const bf16_t* qc = (const bf16_t*)(ws + WS_QC); const bf16_t* kc = (const bf16_t*)(ws + WS_KC); const bf16_t* vc = (const bf16_t*)(ws + WS_VC); bf16_t* oc = (bf16_t*)(ws + WS_OC);
    for (int L = F.bid; L < 512; L += F.G) { const int h = L & 3, blk = L >> 2, b = blk >> 6, qb = blk & 63;
        att::xattn_block((LAS char*)F.lds, qc, kc, vc, oc, b, h, qb); }
}


typedef float f32x2 __attribute__((ext_vector_type(2)));
__device__ __forceinline__ bool fp4_probe_ok() {
    float a = 1.0f, b = 3.0f, c = 0.5f, d = 6.0f; asm volatile("" : "+v"(a), "+v"(b), "+v"(c), "+v"(d));
    unsigned w = 0u;
    w = __builtin_amdgcn_cvt_scalef32_pk_fp4_f32(w, a, b, 1.0f, 0); w = __builtin_amdgcn_cvt_scalef32_pk_fp4_f32(w, c, d, 1.0f, 3);
    const f32x2 y0 = __builtin_amdgcn_cvt_scalef32_pk_f32_fp4(w, 1.0f, 0), y3 = __builtin_amdgcn_cvt_scalef32_pk_f32_fp4(w, 1.0f, 3), y1 = __builtin_amdgcn_cvt_scalef32_pk_f32_fp4(w, 1.0f, 1);
    return y0.x == 1.0f && y0.y == 3.0f && y3.x == 0.5f && y3.y == 6.0f && y1.x == 0.0f && y1.y == 0.0f;
}
#define DPP_MAX(v, ctrl) (v) = fmaxf((v), __int_as_float(__builtin_amdgcn_update_dpp(0, __float_as_int(v), (ctrl), 0xF, 0xF, false)))
__device__ __forceinline__ void peer_tables_to_fp4(const Frame& F, unsigned char* ws, const float* pu, const float* pv) {
    const bool ok = fp4_probe_ok();
    for (int r = F.gw; r < 2 * 16384; r += F.NGW) {
        const int tab = r >= 16384, row = r & 16383;
        const float* srow = (tab ? pv : pu) + (size_t)row * D;
        unsigned char* vals = ws + (tab ? WS_VB : WS_UB); float* rsc = (float*)(ws + (tab ? WS_VSC : WS_USC));
        float ss = 0.f, am = 0.f;
#pragma unroll
        for (int kh = 0; kh < 2; ++kh) { f32x4 v[8];
#pragma unroll
            for (int k8 = 0; k8 < 8; ++k8) v[k8] = *(const f32x4*)(srow + (kh * 8 + k8) * 256 + F.lane * 4);
#pragma unroll
            for (int k8 = 0; k8 < 8; ++k8) { ss += (v[k8][0] * v[k8][0] + v[k8][1] * v[k8][1]) + (v[k8][2] * v[k8][2] + v[k8][3] * v[k8][3]);
                am = fmaxf(am, fmaxf(fmaxf(fabsf(v[k8][0]), fabsf(v[k8][1])), fmaxf(fabsf(v[k8][2]), fabsf(v[k8][3])))); } }
        ss = wave_sum(ss);
        DPP_MAX(am, 0xB1); DPP_MAX(am, 0x4E); DPP_MAX(am, 0x141); DPP_MAX(am, 0x140);
        am = fmaxf(fmaxf(__int_as_float(__builtin_amdgcn_readlane(__float_as_int(am), 0)), __int_as_float(__builtin_amdgcn_readlane(__float_as_int(am), 16))),
                   fmaxf(__int_as_float(__builtin_amdgcn_readlane(__float_as_int(am), 32)), __int_as_float(__builtin_amdgcn_readlane(__float_as_int(am), 48))));
        const float top = fminf(am, 3.0f * sqrtf(ss * (1.0f / D)));
        const float sc = top > 0.f ? top * (1.0f / 6.0f) : 1.0f, inv = 1.0f / sc;
        if (F.lane == 0) rsc[row] = ok ? sc : __uint_as_float(0x7FC00000u);
#pragma unroll
        for (int kh = 0; kh < 2; ++kh) { f32x4 v[8];
#pragma unroll
            for (int k8 = 0; k8 < 8; ++k8) v[k8] = *(const f32x4*)(srow + (kh * 8 + k8) * 256 + F.lane * 4);
#pragma unroll
            for (int k8 = 0; k8 < 8; ++k8) { const int k = kh * 8 + k8;
                const float q0 = fminf(fmaxf(v[k8][0] * inv, -6.0f), 6.0f), q1 = fminf(fmaxf(v[k8][1] * inv, -6.0f), 6.0f), q2 = fminf(fmaxf(v[k8][2] * inv, -6.0f), 6.0f), q3 = fminf(fmaxf(v[k8][3] * inv, -6.0f), 6.0f);
                unsigned p = 0u;
                p = __builtin_amdgcn_cvt_scalef32_pk_fp4_f32(p, q0, q1, 1.0f, 0); p = __builtin_amdgcn_cvt_scalef32_pk_fp4_f32(p, q2, q3, 1.0f, 1);
                const size_t sl = (size_t)(k >> 1) * 16384 + row;
                *(unsigned short*)(vals + sl * 256 + (k & 1) * 128 + 2 * F.lane) = (unsigned short)p; } }
    }
}
#define CE_(a, b) do { const float hi_ = fmaxf(a, b), lo_ = fminf(a, b); a = hi_; b = lo_; } while (0)
__device__ __forceinline__ void sort16_desc(float (&v)[16]) {
    CE_(v[0], v[1]); CE_(v[2], v[3]); CE_(v[0], v[2]); CE_(v[1], v[3]); CE_(v[1], v[2]); CE_(v[4], v[5]); CE_(v[6], v[7]); CE_(v[4], v[6]); CE_(v[5], v[7]); CE_(v[5], v[6]); CE_(v[0], v[4]); CE_(v[2], v[6]); CE_(v[2], v[4]); CE_(v[1], v[5]); CE_(v[3], v[7]); CE_(v[3], v[5]); CE_(v[1], v[2]); CE_(v[3], v[4]); CE_(v[5], v[6]); CE_(v[8], v[9]); CE_(v[10], v[11]); CE_(v[8], v[10]); CE_(v[9], v[11]); CE_(v[9], v[10]); CE_(v[12], v[13]); CE_(v[14], v[15]); CE_(v[12], v[14]); CE_(v[13], v[15]); CE_(v[13], v[14]); CE_(v[8], v[12]); CE_(v[10], v[14]); CE_(v[10], v[12]); CE_(v[9], v[13]); CE_(v[11], v[15]); CE_(v[11], v[13]); CE_(v[9], v[10]); CE_(v[11], v[12]); CE_(v[13], v[14]); CE_(v[0], v[8]); CE_(v[4], v[12]); CE_(v[4], v[8]); CE_(v[2], v[10]); CE_(v[6], v[14]); CE_(v[6], v[10]); CE_(v[2], v[4]); CE_(v[6], v[8]); CE_(v[10], v[12]); CE_(v[1], v[9]); CE_(v[5], v[13]); CE_(v[5], v[9]); CE_(v[3], v[11]); CE_(v[7], v[15]); CE_(v[7], v[11]); CE_(v[3], v[5]); CE_(v[7], v[9]); CE_(v[11], v[13]); CE_(v[1], v[2]); CE_(v[3], v[4]); CE_(v[5], v[6]); CE_(v[7], v[8]); CE_(v[9], v[10]); CE_(v[11], v[12]); CE_(v[13], v[14]);
}
__device__ __forceinline__ void bitonic16_desc(float (&v)[16]) {
    CE_(v[0], v[8]); CE_(v[1], v[9]); CE_(v[2], v[10]); CE_(v[3], v[11]); CE_(v[4], v[12]); CE_(v[5], v[13]); CE_(v[6], v[14]); CE_(v[7], v[15]); CE_(v[0], v[4]); CE_(v[1], v[5]); CE_(v[2], v[6]); CE_(v[3], v[7]); CE_(v[8], v[12]); CE_(v[9], v[13]); CE_(v[10], v[14]); CE_(v[11], v[15]); CE_(v[0], v[2]); CE_(v[1], v[3]); CE_(v[4], v[6]); CE_(v[5], v[7]); CE_(v[8], v[10]); CE_(v[9], v[11]); CE_(v[12], v[14]); CE_(v[13], v[15]); CE_(v[0], v[1]); CE_(v[2], v[3]); CE_(v[4], v[5]); CE_(v[6], v[7]); CE_(v[8], v[9]); CE_(v[10], v[11]); CE_(v[12], v[13]); CE_(v[14], v[15]);
}

__device__ __forceinline__ void merge_top16(float (&a)[16], const float (&b)[16]) {
#pragma unroll
    for (int i = 0; i < 16; ++i) a[i] = fmaxf(a[i], b[15 - i]);
    bitonic16_desc(a);
}
__device__ __forceinline__ void top16_of_64(const float (&s)[64], float (&t)[16]) {
    float g1[16], g2[16], g3[16];
#pragma unroll
    for (int i = 0; i < 16; ++i) { t[i] = s[i]; g1[i] = s[16 + i]; g2[i] = s[32 + i]; g3[i] = s[48 + i]; }
    sort16_desc(t); sort16_desc(g1); sort16_desc(g2); sort16_desc(g3);
    merge_top16(t, g1); merge_top16(g2, g3); merge_top16(t, g2);
}
__device__ __forceinline__ void p12_keys_to_lds(const Frame& F, unsigned char* ws) {
    const bf16_t* keys = (const bf16_t*)(ws + WS_KEYS) + (size_t)(F.bid & 7) * 256 * 128;
#pragma unroll
    for (int i = 0; i < 8; ++i) { const int gch = F.tid + 512 * i, R = gch >> 4, c = gch & 15;
        *(LAS u32x4*)(F.lds + R * 256 + ((c ^ (R & 15)) * 16)) = *(const u32x4*)(keys + (size_t)R * 128 + c * 8); }
}
__device__ __forceinline__ void p12_topk(const Frame& F, unsigned char* ws) {
    const bf16_t* qp = (const bf16_t*)(ws + WS_QP); int* ids = (int*)(ws + WS_IDS); float* gates = (float*)(ws + WS_GATES);
    const float NEG = -__builtin_inff();
    const int ngrp = (F.G - 1 - (F.bid & 7)) / 8 + 1;
#pragma unroll 1
    for (int it = 0; ; ++it) {
        const int tg = ((F.bid >> 3) + it * ngrp) * 8 + F.wave; if (tg >= 512) break;
        int lane_ = F.lane; asm volatile("" : "+v"(lane_));
        const int tok = lane_ & 31, hi = lane_ >> 5;
        const int h = F.bid & 7, token = tg * 32 + tok;
        float top[2][16];
#pragma unroll
        for (int p = 0; p < 2; ++p) {
            bf16x8 qr[8];
#pragma unroll
            for (int d0 = 0; d0 < 8; ++d0) qr[d0] = *(const bf16x8*)(qp + (size_t)token * 2048 + h * 256 + p * 128 + d0 * 16 + hi * 8);
            float s[64];
#pragma unroll
            for (int kb = 0; kb < 4; ++kb) { f32x16 acc = {};
                const int R = p * 128 + kb * 32 + tok; const LAS unsigned char* kl = F.lds + R * 256;
#pragma unroll
                for (int d0 = 0; d0 < 8; ++d0) acc = __builtin_amdgcn_mfma_f32_32x32x16_bf16(*(const LAS bf16x8*)(kl + (((2 * d0 + hi) ^ (R & 15)) * 16)), qr[d0], acc, 0, 0, 0);
#pragma unroll
                for (int r = 0; r < 16; ++r) { const int idx = kb * 32 + (r & 3) + 8 * (r >> 2) + 4 * hi;
                    s[kb * 16 + r] = __uint_as_float((__float_as_uint(acc[r]) & ~0x7Fu) | (unsigned)(127 - idx)); } }
            float t[16]; top16_of_64(s, t);
            float pt[16];
#pragma unroll
            for (int i = 0; i < 16; ++i) { const unsigned own = __float_as_uint(t[i]); auto rr = __builtin_amdgcn_permlane32_swap(own, own, false, false); pt[i] = __uint_as_float(rr[0] ^ rr[1] ^ own); }
            merge_top16(t, pt);
#pragma unroll
            for (int i = 0; i < 16; ++i) top[p][i] = t[i];
        }
        float c[64], cs_[16];
#define CAND_(k, i, j) c[k] = __uint_as_float((__float_as_uint(top[0][i] + top[1][j]) & ~0xFFu) | (unsigned)(255 - ((i) * 16 + (j))))
        CAND_(0, 0, 0); CAND_(1, 0, 1); CAND_(2, 0, 2); CAND_(3, 0, 3); CAND_(4, 0, 4); CAND_(5, 0, 5); CAND_(6, 0, 6); CAND_(7, 0, 7); CAND_(8, 0, 8); CAND_(9, 0, 9); CAND_(10, 0, 10); CAND_(11, 0, 11); CAND_(12, 0, 12); CAND_(13, 0, 13); CAND_(14, 0, 14); CAND_(15, 0, 15); CAND_(16, 1, 0); CAND_(17, 1, 1); CAND_(18, 1, 2); CAND_(19, 1, 3); CAND_(20, 1, 4); CAND_(21, 1, 5); CAND_(22, 1, 6); CAND_(23, 1, 7); CAND_(24, 2, 0); CAND_(25, 2, 1); CAND_(26, 2, 2); CAND_(27, 2, 3); CAND_(28, 2, 4); CAND_(29, 3, 0); CAND_(30, 3, 1); CAND_(31, 3, 2); CAND_(32, 3, 3); CAND_(33, 4, 0); CAND_(34, 4, 1); CAND_(35, 4, 2); CAND_(36, 5, 0); CAND_(37, 5, 1); CAND_(38, 6, 0); CAND_(39, 6, 1); CAND_(40, 7, 0); CAND_(41, 7, 1); CAND_(42, 8, 0); CAND_(43, 9, 0); CAND_(44, 10, 0); CAND_(45, 11, 0); CAND_(46, 12, 0); CAND_(47, 13, 0); CAND_(48, 14, 0); CAND_(49, 15, 0);
#undef CAND_
#pragma unroll
        for (int k = 50; k < 64; ++k) c[k] = NEG;
        top16_of_64(c, cs_);
        int ex[16];
#pragma unroll
        for (int k = 0; k < 16; ++k) { const int flat = 255 - (int)(__float_as_uint(cs_[k]) & 0xFFu), ci = flat >> 4, cj = flat & 15;
            float t0 = top[0][0], t1 = top[1][0];
#pragma unroll
            for (int t = 1; t < 16; ++t) { t0 = (ci == t) ? top[0][t] : t0; t1 = (cj == t) ? top[1][t] : t1; }
            const int i1 = 127 - (int)(__float_as_uint(t0) & 0x7Fu), i2 = 127 - (int)(__float_as_uint(t1) & 0x7Fu);
            ex[k] = i1 * 128 + i2; }
        float den = 0.f, ev[16];
#pragma unroll
        for (int k = 0; k < 16; ++k) { ev[k] = __expf(cs_[k] - cs_[0]); den += ev[k]; }
        const float rden = 1.0f / den;
        const size_t ob = ((size_t)token * 8 + h) * 16;
        if (hi == 0) {
#pragma unroll
            for (int k4 = 0; k4 < 4; ++k4) *(int4*)(ids + ob + k4 * 4) = make_int4(ex[k4 * 4], ex[k4 * 4 + 1], ex[k4 * 4 + 2], ex[k4 * 4 + 3]); }
        else {
#pragma unroll
            for (int k4 = 0; k4 < 4; ++k4) *(f32x4*)(gates + ob + k4 * 4) = (f32x4){ev[k4 * 4] * rden, ev[k4 * 4 + 1] * rden, ev[k4 * 4 + 2] * rden, ev[k4 * 4 + 3] * rden}; }
    }
}
__device__ __forceinline__ float gelu_erf(float v) {
    const float av = fabsf(v), t = __builtin_amdgcn_rcpf(fmaf(av, 0.2316418882f, 1.0f));
    float q = fmaf(t, 0.5307027145f, -0.7265760135f); q = fmaf(q, t, 0.7107068705f); q = fmaf(q, t, -0.142248368f); q = fmaf(q, t, 0.127414796f); q = q * t;
    const float e = __builtin_amdgcn_exp2f(v * v * -0.72134752044f), m = v * (q * e);
    return v < 0.f ? m : v - m;
}
struct PRow { u32x4 v; };
#define ROW16_ADD(v) do { DPP_ADD(v, 0xB1, 0xF); DPP_ADD(v, 0x4E, 0xF); DPP_ADD(v, 0x141, 0xF); DPP_ADD(v, 0x140, 0xF); } while (0)
#define PW_LOAD(W, q0, idp, vb, sb) do { const u32x4 ia_ = *(const LAS u32x4*)((idp) + (q0)), ib_ = *(const LAS u32x4*)((idp) + (q0) + 4); \
        _Pragma("unroll") for (int r_ = 0; r_ < 8; ++r_) { const unsigned id_ = r_ < 4 ? ia_[r_ & 3] : ib_[r_ & 3]; \
            W[r_].v = *(const u32x4*)((vb) + ((id_ << 8) + i16)); } } while (0)
#define PD_COMP(W, q0, ap) do { const u32x4 ta1_ = *(const LAS u32x4*)((ap) + (q0)), tb1_ = *(const LAS u32x4*)((ap) + (q0) + 4), tas_ = *(const LAS u32x4*)((ap) + 256 + (q0)), tbs_ = *(const LAS u32x4*)((ap) + 256 + (q0) + 4); \
        _Pragma("unroll") for (int r_ = 0; r_ < 8; ++r_) { const unsigned d1_ = r_ < 4 ? ta1_[r_ & 3] : tb1_[r_ & 3]; const int s1_ = (int)(r_ < 4 ? tas_[r_ & 3] : tbs_[r_ & 3]); \
            const i32x8 A8_ = {(int)W[r_].v.x, (int)W[r_].v.y, (int)W[r_].v.z, (int)W[r_].v.w, 0, 0, 0, 0}; \
            if (r_ & 1) { Q1a[0] = (int)(d1_ & mlo); Q1a[1] = (int)(d1_ & mhi); Q1b[2] = Q1a[0]; Q1b[3] = Q1a[1]; \
                y[2] = __builtin_amdgcn_mfma_scale_f32_16x16x128_f8f6f4(A8_, Q1a, y[2], 4, 4, 0, 127, 0, s1_); y[3] = __builtin_amdgcn_mfma_scale_f32_16x16x128_f8f6f4(A8_, Q1b, y[3], 4, 4, 0, 127, 0, s1_); } \
            else { P1a[0] = (int)(d1_ & mlo); P1a[1] = (int)(d1_ & mhi); P1b[2] = P1a[0]; P1b[3] = P1a[1]; \
                y[0] = __builtin_amdgcn_mfma_scale_f32_16x16x128_f8f6f4(A8_, P1a, y[0], 4, 4, 0, 127, 0, s1_); y[1] = __builtin_amdgcn_mfma_scale_f32_16x16x128_f8f6f4(A8_, P1b, y[1], 4, 4, 0, 127, 0, s1_); } } \
        __builtin_amdgcn_sched_barrier(0); } while (0)
#define BF_LO(w) __uint_as_float((w) << 16)
#define BF_HI(w) __uint_as_float((w) & 0xffff0000u)
#define FP4X2(q, k) __builtin_amdgcn_cvt_scalef32_pk_f32_fp4((q), 1.0f, (k))
__device__ __forceinline__ void p12c_quant(const Frame& F, unsigned char* ws, const float* g_ffn) {
    const bf16_t* h2b = (const bf16_t*)(ws + WS_H2B); unsigned char* xq = ws + WS_XQ; unsigned char* xsc = ws + WS_XQS;
    const bool ok = fp4_probe_ok();
#pragma unroll 1
    for (int token = F.gw; token < M; token += F.NGW) {
        int lane_ = F.lane; asm volatile("" : "+v"(lane_)); const int lane = lane_;
#pragma unroll
        for (int blk = 0; blk < 2; ++blk) { const int c0 = 64 * lane + 32 * blk;
            float v[32];
#pragma unroll
            for (int m = 0; m < 4; ++m) { const u32x4 hw = *(const u32x4*)(h2b + (size_t)token * D + c0 + 8 * m); const f32x4 g0 = *(const f32x4*)(g_ffn + c0 + 8 * m), g1 = *(const f32x4*)(g_ffn + c0 + 8 * m + 4);
                v[8 * m + 0] = BF_LO(hw.x) * g0[0]; v[8 * m + 1] = BF_HI(hw.x) * g0[1]; v[8 * m + 2] = BF_LO(hw.y) * g0[2]; v[8 * m + 3] = BF_HI(hw.y) * g0[3];
                v[8 * m + 4] = BF_LO(hw.z) * g1[0]; v[8 * m + 5] = BF_HI(hw.z) * g1[1]; v[8 * m + 6] = BF_LO(hw.w) * g1[2]; v[8 * m + 7] = BF_HI(hw.w) * g1[3]; }
#pragma unroll
            for (int term = 0; term < 2; ++term) { float am = 0.f;
#pragma unroll
                for (int k = 0; k < 32; ++k) am = fmaxf(am, fabsf(v[k]));
                const unsigned rb = __float_as_uint(am * (1.0f / 6.0f));
                int e = (int)(rb >> 23) - 127 + ((rb & 0x7FFFFFu) != 0u ? 1 : 0); e = e < -120 ? -120 : (e > 120 ? 120 : e);
                const float inv = __uint_as_float((unsigned)(127 - e) << 23), sc = __uint_as_float((unsigned)(127 + e) << 23);
                unsigned w[4];
#pragma unroll
                for (int k = 0; k < 4; ++k) { unsigned d = 0u;
                    d = __builtin_amdgcn_cvt_scalef32_pk_fp4_f32(d, v[8 * k] * inv, v[8 * k + 1] * inv, 1.0f, 0); d = __builtin_amdgcn_cvt_scalef32_pk_fp4_f32(d, v[8 * k + 2] * inv, v[8 * k + 3] * inv, 1.0f, 1);
                    d = __builtin_amdgcn_cvt_scalef32_pk_fp4_f32(d, v[8 * k + 4] * inv, v[8 * k + 5] * inv, 1.0f, 2); d = __builtin_amdgcn_cvt_scalef32_pk_fp4_f32(d, v[8 * k + 6] * inv, v[8 * k + 7] * inv, 1.0f, 3);
                    w[k] = d;
                    if (term == 0) { const f32x2 y0 = FP4X2(d, 0), y1 = FP4X2(d, 1), y2 = FP4X2(d, 2), y3 = FP4X2(d, 3);
                        v[8 * k] -= y0.x * sc; v[8 * k + 1] -= y0.y * sc; v[8 * k + 2] -= y1.x * sc; v[8 * k + 3] -= y1.y * sc; v[8 * k + 4] -= y2.x * sc; v[8 * k + 5] -= y2.y * sc; v[8 * k + 6] -= y3.x * sc; v[8 * k + 7] -= y3.y * sc; } }
                *(u32x4*)(xq + (size_t)term * M * 2048 + (size_t)token * 2048 + c0 / 2) = (u32x4){w[0], w[1], w[2], w[3]};
                xsc[(size_t)term * M * 128 + (size_t)token * 128 + 2 * lane + blk] = (unsigned char)(ok ? (unsigned)(e + 127) : 255u); }
        }
    }
}
typedef int i32x8 __attribute__((ext_vector_type(8)));
#define UG_LOAD(SB, TB, CB, idp) do { _Pragma("unroll") for (int tt_ = 0; tt_ < 4; ++tt_) _Pragma("unroll") for (int h_ = 0; h_ < 2; ++h_) { const unsigned id_ = (idp)[16 * ((TB) + tt_) + 8 * h_]; \
        __builtin_amdgcn_global_load_lds((const unsigned*)(uvj + ((id_ << 8) + 64u * (CB) + gsw16)), (LAS unsigned*)(slots + ((SB) + tt_ * 2 + h_) * 1024), 16, 0, 0); } \
        __builtin_amdgcn_sched_barrier(0); } while (0)
#define BPERM(v) ((unsigned)__builtin_amdgcn_ds_bpermute(pa, (int)(v)))
#define UG_COMP(SB, TB, CB, xp, NV) do { asm volatile("s_waitcnt vmcnt(" #NV ")" ::: "memory"); __builtin_amdgcn_sched_barrier(0); \
        u32x4 P_[8]; _Pragma("unroll") for (int tt_ = 0; tt_ < 4; ++tt_) { P_[tt_ * 2] = *(const LAS u32x4*)(slots + ((SB) + tt_ * 2) * 1024 + rdo0); P_[tt_ * 2 + 1] = *(const LAS u32x4*)(slots + ((SB) + tt_ * 2) * 1024 + rdo1); } \
        _Pragma("unroll") for (int cc_ = 0; cc_ < 2; ++cc_) { const int c_ = (CB) + cc_; \
            const u32x4 b0_ = *(const LAS u32x4*)((xp) + 64 * c_), b1_ = *(const LAS u32x4*)((xp) + 256 + 64 * c_); \
            const int s0_ = (int)*(const LAS unsigned char*)((xp) + 512 + 4 * c_ - 15 * kq), s1_ = (int)*(const LAS unsigned char*)((xp) + 528 + 4 * c_ - 15 * kq); \
            const i32x8 x0_ = {(int)b0_.x, (int)b0_.y, (int)b0_.z, (int)b0_.w, 0, 0, 0, 0}, x1_ = {(int)b1_.x, (int)b1_.y, (int)b1_.z, (int)b1_.w, 0, 0, 0, 0}; \
            _Pragma("unroll") for (int tt_ = 0; tt_ < 4; ++tt_) { const u32x4 q_ = P_[tt_ * 2 + cc_]; const i32x8 A8_ = {(int)q_.x, (int)q_.y, (int)q_.z, (int)q_.w, 0, 0, 0, 0}; \
                dacc[(TB) + tt_] = __builtin_amdgcn_mfma_scale_f32_16x16x128_f8f6f4(A8_, x0_, dacc[(TB) + tt_], 4, 4, 0, 127, 0, s0_); } \
            _Pragma("unroll") for (int tt_ = 0; tt_ < 4; ++tt_) { const u32x4 q_ = P_[tt_ * 2 + cc_]; const i32x8 A8_ = {(int)q_.x, (int)q_.y, (int)q_.z, (int)q_.w, 0, 0, 0, 0}; \
                dacc[(TB) + tt_] = __builtin_amdgcn_mfma_scale_f32_16x16x128_f8f6f4(A8_, x1_, dacc[(TB) + tt_], 4, 4, 0, 127, 0, s1_); } } \
        __builtin_amdgcn_sched_barrier(0); } while (0)
__device__ __forceinline__ void p13a_up(const Frame& F, unsigned char* ws) {
    const int j = F.xj, lw = F.xrank * NWAVES + F.wave, nw = F.xn * NWAVES;
    int lane_ = F.lane; asm volatile("" : "+v"(lane_));
    const int lane = lane_, r = lane & 15, kq = lane >> 4, ge = lane >> 2; const unsigned gp4 = 4u * (unsigned)(lane & 3), l4 = 4u * (unsigned)lane;
    const unsigned gsw16 = 16u * (unsigned)((lane & 7) ^ ((lane >> 3) & 6));
    const int rdo0 = (r >> 3) * 1024 + 128 * (r & 7) + 16 * (kq ^ (r & 6)), rdo1 = (r >> 3) * 1024 + 128 * (r & 7) + 16 * ((4 + kq) ^ (r & 6));
    const unsigned char* uvj = ws + WS_UB + (size_t)j * 16384 * 256; const unsigned char* usj = ws + WS_UB + PEER_VAL_BYTES + (size_t)j * 16384 * 16;
    const unsigned char* ids = ws + WS_IDS;
    const unsigned char* xq = ws + WS_XQ + (size_t)(lane >> 5) * M * 2048 + 256 * j + 8 * (lane & 31);
    const unsigned char* xsc = ws + WS_XQS + (size_t)((lane >> 4) & 1) * M * 128 + 16 * j + (lane & 15);
    float* pd = (float*)(ws + WS_PD) + (size_t)j * M * 128 + 4 * kq;
    LAS unsigned char* wl = F.lds + XSTG_OFF + F.wave * 2304; LAS unsigned char* slots = F.lds + F.wave * 16384;
    int t = lw; if (t >= M) return;
    { LAS unsigned* il = (LAS unsigned*)wl; const unsigned char* ip = ids + (size_t)t * 512; il[lane] = *(const unsigned*)(ip + l4); il[64 + lane] = *(const unsigned*)(ip + 256 + l4);
      *(LAS u32x2*)(wl + 512 + 8 * lane) = *(const u32x2*)(xq + (size_t)t * 2048); if (lane < 32) wl[1024 + lane] = xsc[(size_t)t * 128]; }
    UG_LOAD(0, 0, 0, (const LAS unsigned*)wl + (lane >> 3));
    asm volatile("s_waitcnt vmcnt(0)" ::: "memory");
    int buf = 0;
#pragma unroll 1
    for (; t < M; t += nw) {
        const int tn = (t + nw < M) ? t + nw : t;
        const LAS unsigned char* cb = wl + buf * 1152; LAS unsigned char* nb = wl + (buf ^ 1) * 1152;
        const LAS unsigned* idc = (const LAS unsigned*)cb + (lane >> 3); const LAS unsigned char* xc = cb + 512 + 16 * kq;
        const unsigned char* ip = ids + (size_t)tn * 512; const unsigned idn0 = *(const unsigned*)(ip + l4), idn1 = *(const unsigned*)(ip + 256 + l4);
        const u32x2 xn = *(const u32x2*)(xq + (size_t)tn * 2048); const unsigned char sn = xsc[(size_t)tn * 128];
        __builtin_amdgcn_sched_barrier(0);
        f32x4 dacc[8];
#pragma unroll
        for (int T = 0; T < 8; ++T) dacc[T] = (f32x4){0.f, 0.f, 0.f, 0.f};
        UG_LOAD(8, 4, 0, idc); UG_COMP(0, 0, 0, xc, 8);
        UG_LOAD(0, 0, 2, idc); UG_COMP(8, 4, 0, xc, 8);
        { LAS unsigned* il = (LAS unsigned*)nb; il[lane] = idn0; il[64 + lane] = idn1; *(LAS u32x2*)(nb + 512 + 8 * lane) = xn; if (lane < 32) nb[1024 + lane] = sn; }
        UG_LOAD(8, 4, 2, idc); UG_COMP(0, 0, 2, xc, 8);
        UG_LOAD(0, 0, 0, (const LAS unsigned*)nb + (lane >> 3));
        UG_COMP(8, 4, 2, xc, 8);
#pragma unroll
        for (int T = 0; T < 8; ++T) asm volatile("" : "+v"(dacc[T]));
        if (r == 0) {
#pragma unroll
            for (int T = 0; T < 8; ++T) *(f32x4*)(pd + (size_t)t * 128 + 16 * T) = dacc[T]; }
        buf ^= 1;
    }
}
__device__ __forceinline__ unsigned fp4_code_scale(float v, float& back) {
    const unsigned rb = __float_as_uint(fabsf(v) * (1.0f / 6.0f));
    int e = (int)(rb >> 23) - 127 + ((rb & 0x7FFFFFu) != 0u ? 1 : 0); e = e < -120 ? -120 : (e > 120 ? 120 : e);
    const float inv = __uint_as_float((unsigned)(127 - e) << 23), sc = __uint_as_float((unsigned)(127 + e) << 23);
    const unsigned by = __builtin_amdgcn_cvt_scalef32_pk_fp4_f32(0u, v * inv, v * inv, 1.0f, 0);
    const f32x2 dd = FP4X2(by, 0); back = dd.x * sc;
    return (by & 0xFu) | ((unsigned)(e + 127) << 8);
}
__device__ __forceinline__ void p13b_act(const Frame& F, unsigned char* ws) {
    const float* pd = (const float*)(ws + WS_PD); float* gates = (float*)(ws + WS_GATES); const float* ssq2 = (const float*)(ws + WS_SSQ2); unsigned* act = (unsigned*)(ws + WS_ACT);
    const int* ids = (const int*)(ws + WS_IDS); const float* usc = (const float*)(ws + WS_USC); const float* vsc = (const float*)(ws + WS_VSC);
    const bool ok = fp4_probe_ok();
#pragma unroll 1
    for (int token = F.gw; token < M; token += F.NGW) {
        const float r2 = 1.0f / sqrtf(wave_sum(ssq2[(size_t)token * 64 + F.lane]) * (1.0f / D) + EPS);
#pragma unroll
        for (int hh = 0; hh < 2; ++hh) { const size_t o = (size_t)token * 128 + hh * 64 + F.lane; float d = 0.f;
#pragma unroll
            for (int jj = 0; jj < 8; ++jj) d += pd[(size_t)jj * M * 128 + o];
            const int id = ids[o];
            const float a = gelu_erf(d * r2 * usc[id]) * gates[o] * vsc[id];
            float b1; const unsigned t1 = fp4_code_scale(a, b1);
            act[o] = (t1 & 0xFu) * 0x11111111u;
            act[(size_t)M * 128 + o] = ok ? ((t1 >> 8) & 0xFFu) : 0xFFu; }
    }
}
__device__ __forceinline__ void p13c_down(const Frame& F, unsigned char* ws) {
    const int j = F.xj, lw = F.xrank * NWAVES + F.wave, nw = F.xn * NWAVES;
    int lane_ = F.lane; asm volatile("" : "+v"(lane_));
    const int lane = lane_, g = lane >> 4, i = lane & 15; const unsigned i16 = 16u * (unsigned)i, sidx = (unsigned)((i & 3) * 4 + (i >> 2)), l4 = 4u * (unsigned)lane;
    const unsigned sh = 4u * (unsigned)(i & 7), mlo = i < 8 ? (0xFu << sh) : 0u, mhi = i >= 8 ? (0xFu << sh) : 0u;
    i32x8 P1a = {0, 0, 0, 0, 0, 0, 0, 0}, P1b = P1a, Q1a = P1a, Q1b = P1a;
    const unsigned char* vvj = ws + WS_VB + (size_t)j * 16384 * 256; const unsigned char* vsj = ws + WS_VB + PEER_VAL_BYTES + (size_t)j * 16384 * 16;
    const unsigned char* ids = ws + WS_IDS; const unsigned char* av = ws + WS_ACT;
    const bf16_t* h2b = (const bf16_t*)(ws + WS_H2B) + 512 * j + 128 * g + i; bf16_t* h3b = (bf16_t*)(ws + WS_H3B) + 512 * j + 128 * g + i; float* ssq3 = (float*)(ws + WS_SSQ3);
    LAS unsigned* idl = (LAS unsigned*)(F.lds + F.wave * 4096);
    LAS unsigned* al = idl + 256;
    constexpr size_t ASTR = (size_t)M * 128 * 4;
    int t = lw; if (t >= M) return;
    { const unsigned char* ip = ids + (size_t)t * 512; const unsigned char* ap = av + (size_t)t * 512;
      idl[lane] = *(const unsigned*)(ip + l4); idl[64 + lane] = *(const unsigned*)(ip + 256 + l4);
#pragma unroll
      for (int k = 0; k < 2; ++k) { al[256 * k + lane] = *(const unsigned*)(ap + k * ASTR + l4); al[256 * k + 64 + lane] = *(const unsigned*)(ap + k * ASTR + 256 + l4); } }
    PRow A[8], B[8];
    PW_LOAD(A, 0, idl + 32 * g, vvj, vsj);
    int buf = 0;
#pragma unroll 1
    for (; t < M; t += nw) {
        const int tn = (t + nw < M) ? t + nw : t;
        const LAS unsigned* cur = idl + buf * 128 + 32 * g; LAS unsigned* nxt = idl + (buf ^ 1) * 128;
        const LAS unsigned* acur = al + buf * 128 + 32 * g; LAS unsigned* anxt = al + (buf ^ 1) * 128;
        const unsigned char* ip = ids + (size_t)tn * 512; const unsigned char* ap = av + (size_t)tn * 512;
        const unsigned idn0 = *(const unsigned*)(ip + l4), idn1 = *(const unsigned*)(ip + 256 + l4);
        unsigned an[4];
#pragma unroll
        for (int k = 0; k < 2; ++k) { an[2 * k] = *(const unsigned*)(ap + k * ASTR + l4); an[2 * k + 1] = *(const unsigned*)(ap + k * ASTR + 256 + l4); }
        unsigned short hq[8];
#pragma unroll
        for (int k = 0; k < 8; ++k) hq[k] = h2b[(size_t)t * D + 32 * (k & 3) + 16 * (k >> 2)];
        f32x4 y[4];
#pragma unroll
        for (int k = 0; k < 4; ++k) y[k] = (f32x4){0.f, 0.f, 0.f, 0.f};
        PW_LOAD(B, 8, cur, vvj, vsj); PD_COMP(A, 0, acur);
        PW_LOAD(A, 16, cur, vvj, vsj); PD_COMP(B, 8, acur);
        nxt[lane] = idn0; nxt[64 + lane] = idn1;
#pragma unroll
        for (int k = 0; k < 2; ++k) { anxt[256 * k + lane] = an[2 * k]; anxt[256 * k + 64 + lane] = an[2 * k + 1]; }
        PW_LOAD(B, 24, cur, vvj, vsj); PD_COMP(A, 16, acur);
        PW_LOAD(A, 0, nxt + 32 * g, vvj, vsj);
        PD_COMP(B, 24, acur);
        const f32x4 Y0 = y[0] + y[2], Y1 = y[1] + y[3];
        const float h0 = bf2f(hq[0]) + Y0[0], h1 = bf2f(hq[1]) + Y0[1], h2 = bf2f(hq[2]) + Y0[2], h3 = bf2f(hq[3]) + Y0[3];
        const float h4 = bf2f(hq[4]) + Y1[0], h5 = bf2f(hq[5]) + Y1[1], h6 = bf2f(hq[6]) + Y1[2], h7 = bf2f(hq[7]) + Y1[3];
        { bf16_t* op = h3b + (size_t)t * D;
          op[0] = (bf16_t)(cvt_pk_bf16(h0, h0) & 0xffffu); op[32] = (bf16_t)(cvt_pk_bf16(h1, h1) & 0xffffu); op[64] = (bf16_t)(cvt_pk_bf16(h2, h2) & 0xffffu); op[96] = (bf16_t)(cvt_pk_bf16(h3, h3) & 0xffffu);
          op[16] = (bf16_t)(cvt_pk_bf16(h4, h4) & 0xffffu); op[48] = (bf16_t)(cvt_pk_bf16(h5, h5) & 0xffffu); op[80] = (bf16_t)(cvt_pk_bf16(h6, h6) & 0xffffu); op[112] = (bf16_t)(cvt_pk_bf16(h7, h7) & 0xffffu); }
        const float ss = wave_sum(((h0 * h0 + h1 * h1) + (h2 * h2 + h3 * h3)) + ((h4 * h4 + h5 * h5) + (h6 * h6 + h7 * h7)));
        if (lane == 0) ssq3[(size_t)t * 8 + j] = ss;
        buf ^= 1;
    }
}
__device__ __forceinline__ void p13d_final(const Frame& F, unsigned char* ws, const float* g_final, float* out) {
    const bf16_t* h3b = (const bf16_t*)(ws + WS_H3B); const float* ssq3 = (const float*)(ws + WS_SSQ3);
#pragma unroll 1
    for (int token = F.gw; token < M; token += F.NGW) {
        int lane_ = F.lane; asm volatile("" : "+v"(lane_)); const int lane = lane_;
        const float rf = 1.0f / sqrtf(wave_sum(lane < 8 ? ssq3[(size_t)token * 8 + lane] : 0.f) * (1.0f / D) + EPS);
        u32x4 hv[8];
#pragma unroll
        for (int p = 0; p < 8; ++p) hv[p] = *(const u32x4*)(h3b + (size_t)token * D + p * 512 + lane * 8);
#pragma unroll
        for (int p = 0; p < 8; ++p) { const f32x4 g0 = *(const f32x4*)(g_final + p * 512 + lane * 8), g1 = *(const f32x4*)(g_final + p * 512 + lane * 8 + 4);
            float* op = out + (size_t)token * D + p * 512 + lane * 8;
            *(f32x4*)op = (f32x4){BF_LO(hv[p].x) * rf * g0[0], BF_HI(hv[p].x) * rf * g0[1], BF_LO(hv[p].y) * rf * g0[2], BF_HI(hv[p].y) * rf * g0[3]};
            *(f32x4*)(op + 4) = (f32x4){BF_LO(hv[p].z) * rf * g1[0], BF_HI(hv[p].z) * rf * g1[1], BF_LO(hv[p].w) * rf * g1[2], BF_HI(hv[p].w) * rf * g1[3]}; }
    }
}

__device__ __forceinline__ void final_norm_rows(const Frame& F, const float* h, const float* g, float* out) {
    for (int m = F.gw; m < M; m += F.NGW) {
        const f32x4* xr = (const f32x4*)(h + (size_t)m * D); const f32x4* gr = (const f32x4*)g; f32x4* xo = (f32x4*)(out + (size_t)m * D);
        f32x4 v[16]; float ss = 0.f;
#pragma unroll
        for (int j = 0; j < 16; ++j) v[j] = xr[F.lane + 64 * j];
#pragma unroll
        for (int j = 0; j < 16; ++j) ss += (v[j][0] * v[j][0] + v[j][1] * v[j][1]) + (v[j][2] * v[j][2] + v[j][3] * v[j][3]);
        ss = wave_sum(ss); const float r = 1.0f / sqrtf(ss * (1.0f / D) + EPS);
#pragma unroll
        for (int j = 0; j < 16; ++j) xo[F.lane + 64 * j] = v[j] * r * gr[F.lane + 64 * j];
    }
}

__global__ void __launch_bounds__(NTHREADS, 2) mega_fwd(Args args) {
    extern __shared__ __attribute__((aligned(16))) unsigned char lds_raw[];
    Frame F;
    F.lds = (LAS unsigned char*)lds_raw;
    F.tid = threadIdx.x; F.lane = F.tid & 63; F.wave = __builtin_amdgcn_readfirstlane(F.tid >> 6);
    F.G = gridDim.x; F.bid = blockIdx.x; F.gw = F.bid * NWAVES + F.wave; F.NGW = F.G * NWAVES;
    volatile LAS unsigned* MISC = (volatile LAS unsigned*)(F.lds + MISC_OFF);
    if (F.tid < 16) MISC[F.tid] = 0u;
    __syncthreads();
    XcdBarrier bar = xcd_barrier_post((unsigned*)(args.ws + WS_CTL), MISC + 8);
    const int lo = args.ph_lo, hi = args.ph_hi;
#define IN(k) (lo <= (k) && (k) < hi)
#define BOTH(k) (IN(k) && IN((k) + 1))
#define GRID_BAR() xcd_barrier(bar)

    unsigned char* ws = args.ws;
#define GEMM(KINDS, k) gemm_run<KINDS>(F.lds, args.in[0], args.out, ws, (k), F.G, F.bid)
    if (IN(0)) { p0_prologue(F, args); if (BOTH(0)) GRID_BAR(); }
    if (IN(1)) {
#pragma unroll 1
        for (int gi = 0; gi < 3; ++gi) GEMM(3, gi);
        if (BOTH(1)) GRID_BAR(); }
    if (IN(2)) { p2_stats(F, ws); p2_gla_prep(F, ws, args.in[11], args.in[12]); if (BOTH(2)) GRID_BAR(); }
    if (IN(3)) {
#pragma unroll 1
        for (int gi = 3; gi < 5; ++gi) GEMM(1, gi);
        p3_gla_att(F, ws);
        if (BOTH(3)) GRID_BAR(); }
    if (IN(4)) { p4_mla(F, ws);   }
    if (IN(5)) { p5_gla_scan(F, ws); if (BOTH(5)) GRID_BAR(); }
    if (IN(6)) { p6_mix(F, ws, args.in[10], args.in[13]); if (BOTH(6)) GRID_BAR(); }
    if (IN(7)) {
        GEMM(4, 5);
        if (BOTH(7)) GRID_BAR(); }
    if (IN(8)) {
        { pg8::StaticOrder S; S.init(M, 1024, F.G, F.bid); rstd_for_units(F, S, (const float*)(ws + WS_SSQ1), (float*)(ws + WS_RSTD1)); }
        GEMM(1, 6);
        if (BOTH(8)) GRID_BAR(); }
    if (IN(9)) { p9_xattn(F, ws); if (BOTH(9)) GRID_BAR(); }
    if (IN(10)) {
        GEMM(4, 7);
        if (BOTH(10)) GRID_BAR(); }
    if (IN(11)) {
        { pg8::StaticOrder S; S.init(M, 2048, F.G, F.bid); rstd_for_units(F, S, (const float*)(ws + WS_SSQ2), (float*)(ws + WS_RSTD2)); }
        GEMM(1, 8);
        p12c_quant(F, ws, args.in[20]);
        if (BOTH(11)) GRID_BAR(); }
    if (IN(12)) {
        p12_keys_to_lds(F, ws); __syncthreads();
#pragma unroll 1
        for (int s = 0; s < 2; ++s) { if (((s ^ (F.wave >> 2)) & 1) != 0) peer_tables_to_fp4(F, ws, args.in[23], args.in[24]); else p12_topk(F, ws); }
        if (BOTH(12)) GRID_BAR(); }
    if (IN(13)) {
        { const unsigned nx = MISC[9], nloc = MISC[8], rk = MISC[10];
          const bool hw = (nx == 8u) && (bar.x < 8u) && (nloc > 0u) && (lo < 13);
          F.xj = hw ? (int)bar.x : (F.bid & 7); F.xrank = hw ? (int)rk : (F.bid >> 3); F.xn = hw ? (int)nloc : ((F.G - 1 - (F.bid & 7)) / 8 + 1); }
        p13a_up(F, ws); GRID_BAR(); p13b_act(F, ws); GRID_BAR(); p13c_down(F, ws); GRID_BAR(); p13d_final(F, ws, args.in[25], args.out);
    }
#undef GEMM
#undef IN
#undef BOTH
}

extern "C" void kernel_launch(void* const* d_in, const int* in_sizes, int n_in, void* d_out, int out_size, void* d_ws, size_t ws_size, hipStream_t stream) {
    static int grid = 0;
    if (grid == 0) {
        if (n_in != 26 || out_size != M * D || ws_size < WS_END0) { fprintf(stderr, "kernel_launch: unexpected problem (n_in %d out %d ws %zu need %zu)\n", n_in, out_size, ws_size, (size_t)WS_END0); grid = -1; return; }
        int dev = 0, cus = 0, per_cu = 0;
        if (hipGetDevice(&dev) != hipSuccess || hipDeviceGetAttribute(&cus, hipDeviceAttributeMultiprocessorCount, dev) != hipSuccess) { grid = -1; return; }
        if (hipFuncSetAttribute((const void*)mega_fwd, hipFuncAttributeMaxDynamicSharedMemorySize, LDS_BYTES) != hipSuccess) { fprintf(stderr, "kernel_launch: hipFuncSetAttribute failed\n"); grid = -1; return; }
        if (hipOccupancyMaxActiveBlocksPerMultiprocessor(&per_cu, (const void*)mega_fwd, NTHREADS, LDS_BYTES) != hipSuccess || per_cu < 1) { fprintf(stderr, "kernel_launch: occupancy query says %d\n", per_cu); }
        (void)hipGetLastError();
        if (cus < 8) { fprintf(stderr, "kernel_launch: needs at least 8 CUs\n"); grid = -1; return; }
        grid = cus;
    }
    if (grid < 0) return;
    (void)hipMemsetAsync((char*)d_ws + WS_CTL, 0, CTL_BYTES, stream);
    Args a{};
    for (int i = 0; i < 26; ++i) a.in[i] = (const float*)d_in[i];
    a.out = (float*)d_out; a.ws = (unsigned char*)d_ws; a.ph_lo = 0; a.ph_hi = 14;
    hipLaunchKernelGGL(mega_fwd, dim3(grid), dim3(NTHREADS), LDS_BYTES, stream, a);
}
```

```cpp
#include <hip/hip_runtime.h>
#include <cstdio>
#include <cstdint>

#define LAS __attribute__((address_space(3)))
typedef unsigned short bf16_t;
typedef short bf16x8 __attribute__((ext_vector_type(8)));
typedef short s16x4 __attribute__((ext_vector_type(4)));
typedef float f32x4 __attribute__((ext_vector_type(4)));
typedef float f32x16 __attribute__((ext_vector_type(16)));
typedef unsigned u32x4 __attribute__((ext_vector_type(4)));
typedef unsigned u32x2 __attribute__((ext_vector_type(2)));

constexpr int D = 4096, NB = 2, SEQ = 8192, M = NB * SEQ;
constexpr float EPS = 1e-6f;
constexpr int MEMT = 256, MROWS = NB * MEMT;
constexpr int IN_W = 7760, IN_WP = 7936;
constexpr int NWAVES = 8, NTHREADS = 512;

constexpr size_t al256(size_t x) { return (x + 255) & ~(size_t)255; }
constexpr size_t WS_CTL = 0, CTL_BYTES = 65536;
constexpr size_t WS_WIN = WS_CTL + CTL_BYTES;
constexpr size_t WS_WUQ = WS_WIN + (size_t)IN_WP * D * 2;
constexpr size_t WS_WUKV = WS_WUQ + (size_t)3072 * 1024 * 2;
constexpr size_t WS_WOUT = WS_WUKV + (size_t)4096 * 512 * 2;
constexpr size_t WS_WCQ = WS_WOUT + (size_t)D * D * 2;
constexpr size_t WS_WCK = WS_WCQ + (size_t)1024 * D * 2;
constexpr size_t WS_WCV = WS_WCK + (size_t)1024 * D * 2;
constexpr size_t WS_WCO = WS_WCV + (size_t)1024 * D * 2;
constexpr size_t WS_WPQ = WS_WCO + (size_t)D * 1024 * 2;
constexpr size_t WS_KEYS = WS_WPQ + (size_t)2048 * D * 2;
constexpr size_t WS_MN = WS_KEYS + (size_t)8 * 2 * 128 * 128 * 2;
constexpr size_t WS_KC = WS_MN + (size_t)MROWS * D * 2;
constexpr size_t WS_VC = WS_KC + (size_t)MROWS * 1024 * 2;
constexpr size_t WS_ROPE = WS_VC + (size_t)MROWS * 1024 * 2;
constexpr size_t WS_RSTDX = WS_ROPE + (size_t)M * 32 * 4 * 2;
constexpr size_t WS_RSTDQ = WS_RSTDX + (size_t)M * 4;
constexpr size_t WS_RSTDKV = WS_RSTDQ + (size_t)M * 4;
constexpr size_t WS_SSQ1 = WS_RSTDKV + (size_t)M * 4;
constexpr size_t WS_SSQ2 = WS_SSQ1 + (size_t)M * 64 * 4;
constexpr size_t WS_XB = WS_SSQ2 + (size_t)M * 64 * 4;
constexpr size_t WS_CQ = WS_XB + (size_t)M * D * 2;
constexpr size_t WS_CKV = WS_CQ + (size_t)M * 1024 * 2;
constexpr size_t WS_GQ = WS_CKV + (size_t)M * 512 * 2;
constexpr size_t WS_GK = WS_GQ + (size_t)M * 1024 * 2;
constexpr size_t WS_GV = WS_GK + (size_t)M * 1024 * 2;
constexpr size_t WS_GOG = WS_GV + (size_t)M * 2048 * 2;
constexpr size_t WS_SM = WS_GOG + (size_t)M * 2048 * 2;
constexpr size_t WS_Q = WS_SM + (size_t)M * 256 * 2;
constexpr size_t WS_KV = WS_Q + (size_t)M * 3072 * 2;
constexpr size_t WS_KROPE = WS_KV + (size_t)M * 4096 * 2;
constexpr size_t WS_OMLA = WS_KROPE + (size_t)M * 64 * 2;
constexpr size_t WS_OGLA = WS_OMLA + (size_t)M * 2048 * 2;
constexpr size_t WS_QEP = WS_OGLA + (size_t)M * 2048 * 2;
constexpr size_t WS_KEP = WS_QEP + (size_t)M * 1024 * 2;
constexpr size_t WS_KDT = WS_KEP + (size_t)M * 1024 * 2;
constexpr size_t WS_ATT = WS_KDT + (size_t)M * 1024 * 2;
constexpr size_t WS_DEC = WS_ATT + (size_t)1024 * 64 * 64 * 2;
constexpr size_t WS_RSTD1 = WS_DEC + (size_t)1024 * 256 * 4;
constexpr size_t WS_RSTD2 = WS_RSTD1 + (size_t)M * 4;
constexpr size_t WS_END0 = WS_RSTD2 + (size_t)M * 4;
constexpr size_t WS_QC = WS_Q;
constexpr size_t WS_OC = WS_Q + (size_t)M * 1024 * 2;
constexpr size_t WS_H1B = WS_KV;
constexpr size_t WS_H2B = WS_XB;
constexpr size_t WS_QP = WS_Q;
constexpr int PEER_ROW_BYTES = 2176;
constexpr size_t PEER_VAL_BYTES = (size_t)8 * 16384 * 256;
constexpr size_t WS_PD = WS_Q;
constexpr size_t WS_ACT = WS_OGLA;
constexpr size_t WS_H3B = WS_KV;
constexpr size_t WS_XQ = WS_KV;
constexpr size_t WS_XQS = WS_XQ + (size_t)M * D;
constexpr size_t WS_SSQ3 = WS_SSQ1;
constexpr size_t WS_UB = WS_CQ;
constexpr size_t WS_VB = WS_UB + (size_t)16384 * PEER_ROW_BYTES;
constexpr size_t WS_USC = WS_VB + (size_t)16384 * PEER_ROW_BYTES;
constexpr size_t WS_VSC = WS_USC + (size_t)16384 * 4;
constexpr size_t WS_IDS = WS_VSC + (size_t)16384 * 4;
constexpr size_t WS_GATES = WS_IDS + (size_t)M * 128 * 4;
static_assert(WS_GATES + (size_t)M * 128 * 4 <= WS_Q, "peer scratch overlaps q_p");

__device__ __forceinline__ unsigned cvt_pk_bf16(float lo, float hi) { unsigned r; asm volatile("v_cvt_pk_bf16_f32 %0, %1, %2" : "=v"(r) : "v"(lo), "v"(hi)); return r; }
__device__ __forceinline__ float bf2f(unsigned short b) { return __uint_as_float(((unsigned)b) << 16); }
#define DPP_ADD(v, ctrl, rmask) (v) += __int_as_float(__builtin_amdgcn_update_dpp(0, __float_as_int(v), (ctrl), (rmask), 0xF, false))
__device__ __forceinline__ float wave_sum(float v) {
    DPP_ADD(v, 0xB1, 0xF); DPP_ADD(v, 0x4E, 0xF); DPP_ADD(v, 0x141, 0xF); DPP_ADD(v, 0x140, 0xF);
    DPP_ADD(v, 0x142, 0xA); DPP_ADD(v, 0x143, 0xC);
    return __int_as_float(__builtin_amdgcn_readlane(__float_as_int(v), 63));
}
#define LDS_WAIT() asm volatile("s_waitcnt lgkmcnt(0)" ::: "memory")
__device__ __forceinline__ bf16x8 pack8(f32x4 a, f32x4 b) {
    u32x4 w = {cvt_pk_bf16(a[0], a[1]), cvt_pk_bf16(a[2], a[3]), cvt_pk_bf16(b[0], b[1]), cvt_pk_bf16(b[2], b[3])};
    return *reinterpret_cast<bf16x8*>(&w);
}

#define XB_TMO      128
#define XB_XCNT(j)  (256  + 64 * (j))
#define XB_XSUB(j)  (1280 + 64 * (j))
#define XB_XGEN(j)  (2304 + 64 * (j))
#define XB_TOP      3328
#define XB_TOPGEN   3392
#define XCD_BAR_WORDS 3456
#define XB_SPIN_CAP (1u << 22)

__device__ __forceinline__ unsigned xb_ld(unsigned* p)              { return __hip_atomic_load(p, __ATOMIC_RELAXED, __HIP_MEMORY_SCOPE_AGENT); }
__device__ __forceinline__ unsigned xb_add(unsigned* p, unsigned v) { return __hip_atomic_fetch_add(p, v, __ATOMIC_RELAXED, __HIP_MEMORY_SCOPE_AGENT); }
__device__ __forceinline__ unsigned xb_xcc_id() { return (unsigned)__builtin_amdgcn_s_getreg((3 << 11) | 20) & 0xFu; }
#define XB_SPIN(cond, bar) do { unsigned _sp = 0; while (cond) { __builtin_amdgcn_s_sleep(1); \
    if ((++_sp & 255u) == 0u) { if (xb_ld(&(bar)[XB_TMO])) break; if (_sp > XB_SPIN_CAP) { atomicAdd(&(bar)[XB_TMO], 1u); break; } } } } while (0)

struct XcdBarrier { unsigned* bar; unsigned x; volatile LAS unsigned* st; };

__device__ __forceinline__ XcdBarrier xcd_barrier_post(unsigned* bar, volatile LAS unsigned* st) {
    XcdBarrier b; b.bar = bar; b.x = xb_xcc_id(); b.st = st;
    if (threadIdx.x == 0) st[2] = xb_add(&bar[XB_XCNT(b.x)], 1u);
    return b;
}
__device__ __forceinline__ void xcd_barrier_complete(unsigned* bar, unsigned x, unsigned& nloc, unsigned& nx) {
    const unsigned G = gridDim.x * gridDim.y * gridDim.z;
    unsigned sum, cnt, mine, sp = 0u;
    for (;;) {
        sum = 0u; cnt = 0u; mine = 0u;
#pragma unroll
        for (unsigned j = 0; j < 16; ++j) { const unsigned c = xb_ld(&bar[XB_XCNT(j)]); sum += c; cnt += (c > 0u) ? 1u : 0u; mine = (j == x) ? c : mine; }
        if (sum == G) break;
        __builtin_amdgcn_s_sleep(1);
        if ((++sp & 255u) == 0u) { if (xb_ld(&bar[XB_TMO])) break; if (sp > XB_SPIN_CAP) { atomicAdd(&bar[XB_TMO], 1u); break; } }
    }
    nloc = mine > 0u ? mine : 1u; nx = cnt > 0u ? cnt : 1u;
}
__device__ __forceinline__ void xcd_barrier(const XcdBarrier& b) {
    asm volatile("s_waitcnt vmcnt(0)" ::: "memory");
    __syncthreads();
    if (threadIdx.x == 0) {
        unsigned* bar = b.bar;
        __builtin_amdgcn_s_waitcnt(0);
        unsigned nloc = b.st[0], nx = b.st[1];
        if (nloc == 0u) { xcd_barrier_complete(bar, b.x, nloc, nx); b.st[0] = nloc; b.st[1] = nx; }
        const unsigned old = xb_add(&bar[XB_XSUB(b.x)], 1u);
        const unsigned gen = old / nloc;
        if (old + 1u == (gen + 1u) * nloc) {
            __builtin_amdgcn_fence(__ATOMIC_RELEASE, "agent");
            asm volatile("s_waitcnt vmcnt(0)" ::: "memory");
            const unsigned og = xb_add(&bar[XB_TOP], 1u);
            const unsigned tg = og / nx;
            if (og + 1u == (tg + 1u) * nx) xb_add(&bar[XB_TOPGEN], 1u);
            else XB_SPIN(xb_ld(&bar[XB_TOPGEN]) == tg, bar);
            __builtin_amdgcn_fence(__ATOMIC_ACQUIRE, "agent");
            xb_add(&bar[XB_XGEN(b.x)], 1u);
            asm volatile("s_waitcnt vmcnt(0)" ::: "memory");
        } else {
            XB_SPIN(xb_ld(&bar[XB_XGEN(b.x)]) == gen, bar);
            __builtin_amdgcn_fence(__ATOMIC_ACQUIRE, "agent");
            asm volatile("s_waitcnt vmcnt(0)" ::: "memory");
        }
    }
    __syncthreads();
}


namespace pg8 {
constexpr int BM = 256, BK = 64, HALF = 128, HTB = HALF * BK * 2, NXCD = 8, WGM = 8;
__host__ __device__ __forceinline__ int lds_byte(int r, int c) { const int st = (r >> 4) * 2 + (c >> 5), rr = r & 15, cc = c & 31, ob = rr * 64 + cc * 2; return st * 1024 + (ob ^ (((ob >> 9) & 1) << 5)); }
__host__ __device__ __forceinline__ void stage_rc(int b, int& R, int& C) { const int st = b / 1024, sb = b % 1024, swz = sb ^ (((sb >> 9) & 1) << 5); R = (st >> 1) * 16 + swz / 64; C = (st & 1) * 32 + (swz % 64) / 2; }
__host__ __device__ __forceinline__ int perm32(int rho) { const int n = rho >> 4, i = rho & 15; return 8 * (i >> 2) + 4 * n + (i & 3); }
struct Unit { int pm, pn; };
struct Gemm { const bf16_t* A; const bf16_t* Bt; int M, N, K, lda, ldb; };
struct StaticOrder {
    int nM, nN, nwg, G, c;
    __host__ __device__ void init(int M_, int N_, int G_, int c_) { nM = M_ / BM; nN = N_ / BM; nwg = nM * nN; G = G_; c = c_; }
    __host__ __device__ bool next(int i, Unit& u) const {
        const long L = (long)i * G + c; if (L >= nwg) return false;
        int wgid = (int)L; { const int q = nwg / NXCD, r = nwg % NXCD, xcd = wgid % NXCD, off = wgid / NXCD; wgid = (xcd < r ? xcd * (q + 1) : r * (q + 1) + (xcd - r) * q) + off; }
        const int nig = WGM * nN, gid = wgid / nig, fm = gid * WGM, gsz = (nM - fm) < WGM ? (nM - fm) : WGM;
        u.pm = fm + ((wgid % nig) % gsz); u.pn = (wgid % nig) / gsz; return true;
    }
};
template <class Epi>
__device__ __forceinline__ void gemm_phase(LAS unsigned char* lds, const Gemm g, const StaticOrder& S, const Epi& E, const bool perm) {
    int tid_ = threadIdx.x; asm volatile("" : "+v"(tid_));
    const int tid = tid_, wid = __builtin_amdgcn_readfirstlane(tid >> 6), lane = tid & 63, wr = wid >> 2, wc = wid & 3, fr = lane & 15, fq = lane >> 4;
    const int K = g.K, nt = K / BK;
    unsigned voffA[2], voffB[2];
#pragma unroll
    for (int i = 0; i < 2; ++i) { int R, C; stage_rc(tid * 16 + i * 8192, R, C); const int Rb = perm ? ((R & ~31) + perm32(R & 31)) : R;
        voffA[i] = (unsigned)(R * g.lda + C) * 2u; voffB[i] = (unsigned)(Rb * g.ldb + C) * 2u; }
    const size_t kstep = (size_t)(BK * 2);
    const size_t hstepA = (size_t)HALF * g.lda * 2, hstepB = (size_t)HALF * g.ldb * 2;
    const size_t tstepA = 2 * hstepA, tstepB = 2 * hstepB;
    const unsigned ldsw = (unsigned)wid * 1024u;
    const int aoff = lds_byte(wr * 64 + fr, fq * 8), boff = lds_byte(wc * 32 + fr, fq * 8);
#define PG8_SA(b, h) (((b) * 2 + (h)) * HTB)
#define PG8_SB(b, h) ((4 + (b) * 2 + (h)) * HTB)
#define PG8_STAGE(bufoff, gbase, voff) do { _Pragma("unroll") for (int _i = 0; _i < 2; ++_i) \
        __builtin_amdgcn_global_load_lds((const unsigned*)((const char*)(gbase) + (voff)[_i]), (LAS unsigned*)(lds + (bufoff) + ldsw + _i * 8192), 16, 0, 0); } while (0)
#define PG8_LDA(dst, b, h) do { _Pragma("unroll") for (int m = 0; m < 4; ++m) _Pragma("unroll") for (int k = 0; k < 2; ++k) dst[m][k] = *(const LAS bf16x8*)(lds + PG8_SA(b, h) + aoff + m * 2048 + k * 1024); } while (0)
#define PG8_LDB(dst, b, h) do { _Pragma("unroll") for (int n = 0; n < 2; ++n) _Pragma("unroll") for (int k = 0; k < 2; ++k) dst[n][k] = *(const LAS bf16x8*)(lds + PG8_SB(b, h) + boff + n * 2048 + k * 1024); } while (0)
#define PG8_MMA(ai, bj, At, Bt) do { __builtin_amdgcn_s_setprio(1); _Pragma("unroll") for (int m = 0; m < 4; ++m) _Pragma("unroll") for (int n = 0; n < 2; ++n) _Pragma("unroll") for (int k = 0; k < 2; ++k) \
        acc[ai][bj][m][n] = __builtin_amdgcn_mfma_f32_16x16x32_bf16(Bt[n][k], At[m][k], acc[ai][bj][m][n], 0, 0, 0); __builtin_amdgcn_s_setprio(0); } while (0)
#define PG8_WAIT_V(n) asm volatile("s_waitcnt vmcnt(" #n ")" ::: "memory")
#define PG8_WAIT_L(n) asm volatile("s_waitcnt lgkmcnt(" #n ")" ::: "memory")
#define PG8_BAR __builtin_amdgcn_s_barrier()
#define PG8_SCHED __builtin_amdgcn_sched_barrier(0)
    Unit cur, nxt; int ui = 0;
    if (!S.next(0, cur)) return;
    f32x4 acc[2][2][4][2];
#pragma unroll
    for (int a = 0; a < 2; ++a)
#pragma unroll
        for (int b = 0; b < 2; ++b)
#pragma unroll
            for (int m = 0; m < 4; ++m)
#pragma unroll
                for (int n = 0; n < 2; ++n) acc[a][b][m][n] = (f32x4){0.f, 0.f, 0.f, 0.f};
    bf16x8 At[4][2], B0[2][2], B1[2][2];
    const char* cA = (const char*)g.A + (size_t)cur.pm * tstepA; const char* cB = (const char*)g.Bt + (size_t)cur.pn * tstepB;
    PG8_STAGE(PG8_SB(0, 0), cB, voffB); PG8_STAGE(PG8_SA(0, 0), cA, voffA); PG8_STAGE(PG8_SB(0, 1), cB + hstepB, voffB); PG8_STAGE(PG8_SA(0, 1), cA + hstepA, voffA);
    if (wr == 1) PG8_BAR;
    PG8_WAIT_V(4); PG8_BAR;
    PG8_STAGE(PG8_SB(1, 0), cB + kstep, voffB); PG8_STAGE(PG8_SA(1, 0), cA + kstep, voffA); PG8_STAGE(PG8_SB(1, 1), cB + hstepB + kstep, voffB);
    PG8_WAIT_V(6); PG8_BAR;
    for (;;) {
        const bool has_next = S.next(ui + 1, nxt);
        const char* nA = has_next ? (const char*)g.A + (size_t)nxt.pm * tstepA : cA; const char* nB = has_next ? (const char*)g.Bt + (size_t)nxt.pn * tstepB : cB;
        for (int t = 0; t < nt; t += 2) {
            const bool last = (t == nt - 2);
            const char* a1 = cA + (size_t)(t + 1) * kstep;
            const char* a2 = last ? nA : cA + (size_t)(t + 2) * kstep; const char* b2 = last ? nB : cB + (size_t)(t + 2) * kstep;
            const char* a3 = a2 + kstep; const char* b3 = b2 + kstep;
            PG8_LDB(B0, 0, 0); PG8_SCHED; PG8_LDA(At, 0, 0); PG8_STAGE(PG8_SA(1, 1), a1 + hstepA, voffA);
            PG8_WAIT_L(8); PG8_BAR; PG8_WAIT_L(0); PG8_MMA(0, 0, At, B0); PG8_BAR; PG8_SCHED;
            PG8_LDB(B1, 0, 1); PG8_STAGE(PG8_SB(0, 0), b2, voffB);
            PG8_BAR; PG8_WAIT_L(0); PG8_MMA(0, 1, At, B1); PG8_BAR;
            PG8_LDA(At, 0, 1); PG8_STAGE(PG8_SA(0, 0), a2, voffA);
            PG8_BAR; PG8_WAIT_L(0); PG8_MMA(1, 0, At, B0); PG8_BAR; PG8_SCHED;
            PG8_STAGE(PG8_SB(0, 1), b2 + hstepB, voffB);
            PG8_WAIT_V(6); PG8_BAR; PG8_MMA(1, 1, At, B1); PG8_BAR;
            PG8_LDB(B0, 1, 0); PG8_SCHED; PG8_LDA(At, 1, 0); PG8_STAGE(PG8_SA(0, 1), a2 + hstepA, voffA);
            PG8_WAIT_L(8); PG8_BAR; PG8_WAIT_L(0); PG8_MMA(0, 0, At, B0); PG8_BAR; PG8_SCHED;
            PG8_LDB(B1, 1, 1); PG8_STAGE(PG8_SB(1, 0), b3, voffB);
            PG8_BAR; PG8_WAIT_L(0); PG8_MMA(0, 1, At, B1); PG8_BAR;
            PG8_LDA(At, 1, 1); PG8_STAGE(PG8_SA(1, 0), a3, voffA);
            PG8_BAR; PG8_WAIT_L(0); PG8_MMA(1, 0, At, B0); PG8_BAR; PG8_SCHED;
            PG8_STAGE(PG8_SB(1, 1), b3 + hstepB, voffB);
            PG8_WAIT_V(6); PG8_BAR; PG8_MMA(1, 1, At, B1); PG8_BAR;
        }
        E(acc, cur, wr, wc, fr, fq);
        if (!has_next) break;
#pragma unroll
        for (int a = 0; a < 2; ++a)
#pragma unroll
            for (int b = 0; b < 2; ++b)
#pragma unroll
                for (int m = 0; m < 4; ++m)
#pragma unroll
                    for (int n = 0; n < 2; ++n) acc[a][b][m][n] = (f32x4){0.f, 0.f, 0.f, 0.f};
        cur = nxt; cA = nA; cB = nB; ++ui;
    }
    PG8_WAIT_V(0);
    if (wr == 0) PG8_BAR;
    PG8_BAR;
#undef PG8_SA
#undef PG8_SB
#undef PG8_STAGE
#undef PG8_LDA
#undef PG8_LDB
#undef PG8_MMA
#undef PG8_WAIT_V
#undef PG8_WAIT_L
#undef PG8_BAR
#undef PG8_SCHED
}

struct EpiRowScaleBf16 {
    static constexpr bool PERM = true;
    const float* rs; bf16_t* base; int ldc;
    __device__ __forceinline__ void store(const f32x4 (&acc)[2][2][4][2], bf16_t* __restrict__ dst, int ld, int ctile, const Unit& u, int wr, int wc, int fr, int fq) const {
        const int row0 = u.pm * BM + wr * 64 + fr, col0 = ctile * BM + wc * 32 + 8 * fq;
        float sv[2][4];
        const float* __restrict__ rsp = rs;
#pragma unroll
        for (int ai = 0; ai < 2; ++ai)
#pragma unroll
            for (int m = 0; m < 4; ++m) sv[ai][m] = rsp ? rsp[row0 + ai * HALF + m * 16] : 1.0f;
#pragma unroll
        for (int ai = 0; ai < 2; ++ai)
#pragma unroll
            for (int m = 0; m < 4; ++m) { const int row = row0 + ai * HALF + m * 16; const float s = sv[ai][m]; bf16_t* rowp = dst + (size_t)row * ld + col0;
#pragma unroll
                for (int bj = 0; bj < 2; ++bj) { const f32x4 v0 = acc[ai][bj][m][0] * s, v1 = acc[ai][bj][m][1] * s;
                    u32x4 w; w.x = cvt_pk_bf16(v0[0], v0[1]); w.y = cvt_pk_bf16(v0[2], v0[3]); w.z = cvt_pk_bf16(v1[0], v1[1]); w.w = cvt_pk_bf16(v1[2], v1[3]);
                    *(u32x4*)(rowp + bj * HALF) = w; } }
    }
    __device__ __forceinline__ void operator()(const f32x4 (&acc)[2][2][4][2], const Unit& u, int wr, int wc, int fr, int fq) const { store(acc, base, ldc, u.pn, u, wr, wc, fr, fq); }
};
struct EpiInProj : EpiRowScaleBf16 {
    unsigned char* ws;
    __device__ __forceinline__ void operator()(const f32x4 (&acc)[2][2][4][2], const Unit& u, int wr, int wc, int fr, int fq) const {
        const int pn = u.pn; size_t off; int ld, t0;
        if (pn < 4) { off = WS_CQ; ld = 1024; t0 = 0; } else if (pn < 6) { off = WS_CKV; ld = 512; t0 = 4; } else if (pn < 10) { off = WS_GQ; ld = 1024; t0 = 6; }
        else if (pn < 14) { off = WS_GK; ld = 1024; t0 = 10; } else if (pn < 22) { off = WS_GV; ld = 2048; t0 = 14; } else if (pn < 30) { off = WS_GOG; ld = 2048; t0 = 22; }
        else { off = WS_SM; ld = 256; t0 = 30; }
        store(acc, (bf16_t*)(ws + off), ld, pn - t0, u, wr, wc, fr, fq);
    }
};
struct EpiResidual {
    static constexpr bool PERM = true;
    const float* basef; const bf16_t* baseb; bf16_t* hb; float* ssq; int ldc; int nslots;
    __device__ __forceinline__ void operator()(const f32x4 (&acc)[2][2][4][2], const Unit& u, int wr, int wc, int fr, int fq) const {
        const int row0 = u.pm * BM + wr * 64 + fr, col0 = u.pn * BM + wc * 32 + 8 * fq;
        const float* __restrict__ bf = basef; const bf16_t* __restrict__ bb = baseb; bf16_t* __restrict__ ho = hb;
        if (bf) {
#pragma unroll
            for (int ai = 0; ai < 2; ++ai)
#pragma unroll
                for (int mp = 0; mp < 2; ++mp) {
                    f32x4 bs[2][2][2];
#pragma unroll
                    for (int mm = 0; mm < 2; ++mm) { const size_t off = (size_t)(row0 + ai * HALF + (2 * mp + mm) * 16) * ldc + col0;
#pragma unroll
                        for (int bj = 0; bj < 2; ++bj)
#pragma unroll
                            for (int n = 0; n < 2; ++n) bs[mm][bj][n] = *(const f32x4*)(bf + off + bj * HALF + n * 4); }
#pragma unroll
                    for (int mm = 0; mm < 2; ++mm) { const int m = 2 * mp + mm; const int row = row0 + ai * HALF + m * 16; const size_t off = (size_t)row * ldc + col0; float ss = 0.f;
#pragma unroll
                        for (int bj = 0; bj < 2; ++bj) { const f32x4 h0 = bs[mm][bj][0] + acc[ai][bj][m][0], h1 = bs[mm][bj][1] + acc[ai][bj][m][1];
                            u32x4 w; w.x = cvt_pk_bf16(h0[0], h0[1]); w.y = cvt_pk_bf16(h0[2], h0[3]); w.z = cvt_pk_bf16(h1[0], h1[1]); w.w = cvt_pk_bf16(h1[2], h1[3]);
                            *(u32x4*)(ho + off + bj * HALF) = w;
                            ss += ((h0[0] * h0[0] + h0[1] * h0[1]) + (h0[2] * h0[2] + h0[3] * h0[3])) + ((h1[0] * h1[0] + h1[1] * h1[1]) + (h1[2] * h1[2] + h1[3] * h1[3])); }
                        ss += __shfl_xor(ss, 16); ss += __shfl_xor(ss, 32);
                        if (fq == 0) ssq[(size_t)row * nslots + u.pn * 4 + wc] = ss; }
                }
        } else {
#pragma unroll
            for (int ai = 0; ai < 2; ++ai) {
                u32x4 bs[4][2];
#pragma unroll
                for (int m = 0; m < 4; ++m) { const size_t off = (size_t)(row0 + ai * HALF + m * 16) * ldc + col0;
#pragma unroll
                    for (int bj = 0; bj < 2; ++bj) bs[m][bj] = *(const u32x4*)(bb + off + bj * HALF); }
#pragma unroll
                for (int m = 0; m < 4; ++m) { const int row = row0 + ai * HALF + m * 16; const size_t off = (size_t)row * ldc + col0; float ss = 0.f;
#pragma unroll
                    for (int bj = 0; bj < 2; ++bj) { const u32x4 q = bs[m][bj];
                        const f32x4 h0 = (f32x4){__uint_as_float(q.x << 16), __uint_as_float(q.x & 0xffff0000u), __uint_as_float(q.y << 16), __uint_as_float(q.y & 0xffff0000u)} + acc[ai][bj][m][0];
                        const f32x4 h1 = (f32x4){__uint_as_float(q.z << 16), __uint_as_float(q.z & 0xffff0000u), __uint_as_float(q.w << 16), __uint_as_float(q.w & 0xffff0000u)} + acc[ai][bj][m][1];
                        u32x4 w; w.x = cvt_pk_bf16(h0[0], h0[1]); w.y = cvt_pk_bf16(h0[2], h0[3]); w.z = cvt_pk_bf16(h1[0], h1[1]); w.w = cvt_pk_bf16(h1[2], h1[3]);
                        *(u32x4*)(ho + off + bj * HALF) = w;
                        ss += ((h0[0] * h0[0] + h0[1] * h0[1]) + (h0[2] * h0[2] + h0[3] * h0[3])) + ((h1[0] * h1[0] + h1[1] * h1[1]) + (h1[2] * h1[2] + h1[3] * h1[3])); }
                    ss += __shfl_xor(ss, 16); ss += __shfl_xor(ss, 32);
                    if (fq == 0) ssq[(size_t)row * nslots + u.pn * 4 + wc] = ss; }
            }
        }
    }
};
}


struct GemmDesc { unsigned long long a_off, b_off, d_off, rs_off, ssq_off; int M, N, K, lda, ldb, ldc, kind, base_is_x, crot; };
constexpr unsigned long long NO_OFF = ~0ull;
__device__ __constant__ GemmDesc g_gemm[9] = {
      {WS_XB,  WS_WIN,  0,      WS_RSTDX,  NO_OFF,  M,     IN_WP, D,    D,    D,    0,    1, 0, 0},
      {WS_MN,  WS_WCK,  WS_KC,  NO_OFF,    NO_OFF,  MROWS, 1024,  D,    D,    D,    1024, 0, 0, 64},
      {WS_MN,  WS_WCV,  WS_VC,  NO_OFF,    NO_OFF,  MROWS, 1024,  D,    D,    D,    1024, 0, 0, 56},
      {WS_CQ,  WS_WUQ,  WS_Q,   WS_RSTDQ,  NO_OFF,  M,     3072,  1024, 1024, 1024, 3072, 0, 0, 0},
      {WS_CKV, WS_WUKV, WS_KV,  WS_RSTDKV, NO_OFF,  M,     4096,  512,  512,  512,  4096, 0, 0, 0},
      {WS_XB,  WS_WOUT, WS_H1B, NO_OFF,    WS_SSQ1, M,     D,     D,    D,    D,    D,    2, 1, 0},
      {WS_H1B, WS_WCQ,  WS_QC,  WS_RSTD1,  NO_OFF,  M,     1024,  D,    D,    D,    1024, 0, 0, 0},
      {WS_OC,  WS_WCO,  WS_H2B, NO_OFF,    WS_SSQ2, M,     D,     1024, 1024, 1024, D,    2, 0, 0},
      {WS_H2B, WS_WPQ,  WS_QP,  WS_RSTD2,  NO_OFF,  M,     2048,  D,    D,    D,    2048, 0, 0, 0},
};
template <int KINDS>
struct EpiGeneric {
    int kind; pg8::EpiInProj ein; pg8::EpiResidual eres;
    __device__ __forceinline__ void operator()(const f32x4 (&acc)[2][2][4][2], const pg8::Unit& u, int wr, int wc, int fr, int fq) const {
        if ((KINDS & 4) && (kind == 2 || KINDS == 4)) eres(acc, u, wr, wc, fr, fq);
        else if ((KINDS & 2) && (kind == 1 || KINDS == 2)) ein(acc, u, wr, wc, fr, fq);
        else if (KINDS & 1) ein.pg8::EpiRowScaleBf16::operator()(acc, u, wr, wc, fr, fq);
    }
};
template <int KINDS>
__device__ __forceinline__ void gemm_run(LAS unsigned char* lds, const float* x_in, float* out, unsigned char* ws, int idx, int G, int bid) {
    const GemmDesc d = g_gemm[idx];
    pg8::Gemm g{(const bf16_t*)(ws + d.a_off), (const bf16_t*)(ws + d.b_off), d.M, d.N, d.K, d.lda, d.ldb};
    pg8::StaticOrder S; S.init(d.M, d.N, G, (bid + d.crot) % G);
    EpiGeneric<KINDS> E{};
    E.kind = d.kind;
    E.ein.rs = d.rs_off == NO_OFF ? nullptr : (const float*)(ws + d.rs_off); E.ein.base = (bf16_t*)(ws + d.d_off); E.ein.ldc = d.ldc; E.ein.ws = ws;
    E.eres.basef = d.base_is_x ? x_in : nullptr; E.eres.baseb = (const bf16_t*)(ws + WS_H1B); E.eres.hb = (bf16_t*)(ws + d.d_off); E.eres.ssq = (float*)(ws + (d.ssq_off == NO_OFF ? 0ull : d.ssq_off)); E.eres.ldc = d.ldc; E.eres.nslots = 64;
    pg8::gemm_phase(lds, g, S, E, true);
}

namespace att {
constexpr int KVBLK = 64;
constexpr float THR = 8.f;
#define SBAR() __builtin_amdgcn_sched_barrier(0)
__device__ __forceinline__ int v_st(int k, int c) { const int kk = (k & ~0xC) | ((k & 4) << 1) | ((k & 8) >> 1); return ((kk >> 3) * 4 + (c >> 5)) * 512 + ((kk & 7) * 32 + (c & 31)) * 2; }
__device__ __forceinline__ int v_rd_base(int lane) { return ((lane & 3) << 3) | (((lane >> 2) & 3) << 6) | (((lane >> 4) & 1) << 5) | (((lane >> 5) & 1) << 8); }
constexpr int v_rd_off(int d0, int ks, int half) { return d0 * 512 + ks * 4096 + half * 2048; }
__device__ __forceinline__ int crow(int r, int hi) { return (r & 3) + 8 * (r >> 2) + 4 * hi; }
__device__ __forceinline__ void mask_tile(f32x16& p0, f32x16& p1, int dq, unsigned W) {
    const float NEG = -__builtin_inff();
#pragma unroll
    for (int r = 0; r < 16; ++r) {
        const int c = (r & 3) + 8 * (r >> 2);
        if ((unsigned)(dq - c) >= W) p0[r] = NEG;
        if ((unsigned)(dq - c - 32) >= W) p1[r] = NEG;
    }
}
__device__ __forceinline__ void partialSM(f32x16& p0, f32x16& p1, float& m_reg, float& mn, float& alpha, const float SCALE) {
    float pmax = p0[0];
#pragma unroll
    for (int r = 1; r < 16; ++r) pmax = fmaxf(pmax, p0[r]);
#pragma unroll
    for (int r = 0; r < 16; ++r) pmax = fmaxf(pmax, p1[r]);
    { auto rr = __builtin_amdgcn_permlane32_swap(__float_as_uint(pmax), __float_as_uint(pmax), false, false);
      pmax = fmaxf(__uint_as_float(rr[0]), __uint_as_float(rr[1])); }
    const float C2 = 1.4426950408889634f * SCALE;
    if (__builtin_expect(__all((pmax - m_reg) * SCALE <= THR), 1)) { mn = m_reg; alpha = 1.f; }
    else { mn = fmaxf(m_reg, pmax); alpha = __builtin_amdgcn_exp2f((m_reg - mn) * C2); m_reg = mn; }
    const float mnL = -mn * C2;
#pragma unroll
    for (int r = 0; r < 16; ++r) p0[r] = fmaf(p0[r], C2, mnL);
#pragma unroll
    for (int r = 0; r < 16; ++r) p1[r] = fmaf(p1[r], C2, mnL);
#pragma unroll
    for (int r = 0; r < 16; ++r) p0[r] = __builtin_amdgcn_exp2f(p0[r]);
}
__device__ __forceinline__ void finishSM(f32x16& p0, f32x16& p1, float alpha, float& l_reg, bf16x8& pa0, bf16x8& pa1, bf16x8& pa2, bf16x8& pa3) {
#pragma unroll
    for (int r = 0; r < 16; ++r) p1[r] = __builtin_amdgcn_exp2f(p1[r]);
    float ps = 0;
#pragma unroll
    for (int r = 0; r < 16; ++r) ps += p0[r];
#pragma unroll
    for (int r = 0; r < 16; ++r) ps += p1[r];
    { auto rr = __builtin_amdgcn_permlane32_swap(__float_as_uint(ps), __float_as_uint(ps), false, false);
      ps = __uint_as_float(rr[0]) + __uint_as_float(rr[1]); }
    l_reg = l_reg * alpha + ps;
#define PK4(P, B_, OUT) do { unsigned a0 = cvt_pk_bf16(P[B_+0], P[B_+1]), a1 = cvt_pk_bf16(P[B_+2], P[B_+3]);                          \
        unsigned b0 = cvt_pk_bf16(P[B_+4], P[B_+5]), b1 = cvt_pk_bf16(P[B_+6], P[B_+7]);                                             \
        auto r0 = __builtin_amdgcn_permlane32_swap(a0, b0, false, false); auto r1 = __builtin_amdgcn_permlane32_swap(a1, b1, false, false); \
        u32x4 w = {r0[0], r1[0], r0[1], r1[1]}; OUT = *reinterpret_cast<bf16x8*>(&w); } while (0)
    PK4(p0, 0, pa0); PK4(p0, 8, pa1); PK4(p1, 0, pa2); PK4(p1, 8, pa3);
#undef PK4
}
template <int DQK>
__device__ __forceinline__ void qkt(f32x16& p0, f32x16& p1, const LAS char* Kt, int r32, int hi, const bf16x8* qr) {
    constexpr int PITCH = DQK * 2;
    p0 = f32x16{}; p1 = f32x16{};
    const LAS char* kb[4];
#pragma unroll
    for (int dd = 0; dd < 4; ++dd) kb[dd] = Kt + r32 * PITCH + (((dd * 16 + hi * 8) * 2) ^ ((r32 & 7) << 4));
#pragma unroll
    for (int d0 = 0; d0 < DQK / 16; ++d0) { const LAS char* a = kb[d0 & 3] + (d0 >> 2) * 128;
        bf16x8 b0 = *reinterpret_cast<const LAS bf16x8*>(a);
        bf16x8 b1 = *reinterpret_cast<const LAS bf16x8*>(a + 32 * PITCH);
        p0 = __builtin_amdgcn_mfma_f32_32x32x16_bf16(b0, qr[d0], p0, 0, 0, 0);
        p1 = __builtin_amdgcn_mfma_f32_32x32x16_bf16(b1, qr[d0], p1, 0, 0, 0); }
}
template <int VOFF>
__device__ __forceinline__ void pv_tile(f32x16* o, int vaddr, bf16x8 pa0, bf16x8 pa1, bf16x8 pa2, bf16x8 pa3) {
#define TRRD(dst, off) asm volatile("ds_read_b64_tr_b16 %0, %1 offset:%2" : "=&v"(dst) : "v"(vaddr), "i"(off) : "memory")
#define PV_D0(d0) do { s16x4 l0, l1, l2, l3, h0, h1, h2, h3; constexpr int b_ = VOFF + v_rd_off(d0, 0, 0); \
        TRRD(l0, b_); TRRD(h0, b_ + 2048); TRRD(l1, b_ + 4096); TRRD(h1, b_ + 6144); TRRD(l2, b_ + 8192); TRRD(h2, b_ + 10240); TRRD(l3, b_ + 12288); TRRD(h3, b_ + 14336); \
        asm volatile("s_waitcnt lgkmcnt(0)" ::: "memory"); SBAR();   \
        o[d0] = __builtin_amdgcn_mfma_f32_32x32x16_bf16(pa0, (bf16x8){l0[0], l0[1], l0[2], l0[3], h0[0], h0[1], h0[2], h0[3]}, o[d0], 0, 0, 0);   \
        o[d0] = __builtin_amdgcn_mfma_f32_32x32x16_bf16(pa1, (bf16x8){l1[0], l1[1], l1[2], l1[3], h1[0], h1[1], h1[2], h1[3]}, o[d0], 0, 0, 0);   \
        o[d0] = __builtin_amdgcn_mfma_f32_32x32x16_bf16(pa2, (bf16x8){l2[0], l2[1], l2[2], l2[3], h2[0], h2[1], h2[2], h2[3]}, o[d0], 0, 0, 0);   \
        o[d0] = __builtin_amdgcn_mfma_f32_32x32x16_bf16(pa3, (bf16x8){l3[0], l3[1], l3[2], l3[3], h3[0], h3[1], h3[2], h3[3]}, o[d0], 0, 0, 0); } while (0)
    PV_D0(0); PV_D0(1); PV_D0(2); PV_D0(3);
#undef PV_D0
#undef TRRD
}

constexpr int MLA_TILE = 16384;
constexpr int MLA_V_OFF = 0, MLA_KN_OFF = 2 * MLA_TILE, MLA_KR_OFF = 4 * MLA_TILE, MLA_KR_BYTES = 8192, MLA_WS_OFF = MLA_KR_OFF + 2 * MLA_KR_BYTES;
__device__ __forceinline__ void mla_block(LAS char* lds, const bf16_t* __restrict__ q, const bf16_t* __restrict__ kv, const bf16_t* __restrict__ krope,
                                          const float* __restrict__ cs, const float* __restrict__ sn, bf16_t* __restrict__ omla, int b, int h, int qb) {
    const float SCALE = 0.07216878364870322f;
    int tid_ = threadIdx.x; asm volatile("" : "+v"(tid_));
    const int tid = tid_, wid = __builtin_amdgcn_readfirstlane(tid >> 6), lane = tid & 63, r32 = lane & 31, hi = lane >> 5;
    LAS float* wsf = (LAS float*)(lds + MLA_WS_OFF) + wid * 64; LAS float* li_l = wsf; LAS float* al_l = wsf + 32;
    const int P0 = qb * 256, tb = b * SEQ;
    const int NT = (P0 + 256) / KVBLK;
    const int qlo = P0 + wid * 32, qm = qlo + r32 - 4 * hi;
    bf16x8 qr[12];
    { const size_t qrow = (size_t)(tb + qlo + r32); const bf16_t* qp = q + qrow * 3072 + h * 192;
#pragma unroll
      for (int d0 = 0; d0 < 8; ++d0) qr[d0] = *(const bf16x8*)(qp + d0 * 16 + hi * 8);
      const bf16x8 x8 = *(const bf16x8*)(qp + 128 + hi * 8), x9 = *(const bf16x8*)(qp + 144 + hi * 8), x10 = *(const bf16x8*)(qp + 160 + hi * 8), x11 = *(const bf16x8*)(qp + 176 + hi * 8);
      const float* cp = cs + qrow * 32 + hi * 8; const float* sp = sn + qrow * 32 + hi * 8;
      float n8[8], n9[8], n10[8], n11[8];
#pragma unroll
      for (int e = 0; e < 8; ++e) { const float c0 = cp[e], s0 = sp[e], c1 = cp[16 + e], s1 = sp[16 + e];
          const float a8 = bf2f((unsigned short)x8[e]), a9 = bf2f((unsigned short)x9[e]), a10 = bf2f((unsigned short)x10[e]), a11 = bf2f((unsigned short)x11[e]);
          n8[e] = a8 * c0 - a10 * s0; n10[e] = a10 * c0 + a8 * s0; n9[e] = a9 * c1 - a11 * s1; n11[e] = a11 * c1 + a9 * s1; }
      qr[8] = pack8((f32x4){n8[0], n8[1], n8[2], n8[3]}, (f32x4){n8[4], n8[5], n8[6], n8[7]});
      qr[9] = pack8((f32x4){n9[0], n9[1], n9[2], n9[3]}, (f32x4){n9[4], n9[5], n9[6], n9[7]});
      qr[10] = pack8((f32x4){n10[0], n10[1], n10[2], n10[3]}, (f32x4){n10[4], n10[5], n10[6], n10[7]});
      qr[11] = pack8((f32x4){n11[0], n11[1], n11[2], n11[3]}, (f32x4){n11[4], n11[5], n11[6], n11[7]}); }
    unsigned voff_kn, voff_v, voff_kr;
    { const int row = tid >> 4, cp_ = tid & 15, g = cp_ >> 3, j = cp_ & 7;
      voff_kn = (unsigned)(row * 8192 + (h * 256 + (g * 8 + (j ^ (row & 7))) * 8) * 2);
      const int kk = (tid >> 7) * 8 + ((tid & 31) >> 2), key = (kk & ~0xC) | ((kk & 4) << 1) | ((kk & 8) >> 1), c = ((tid >> 5) & 3) * 32 + (tid & 3) * 8;
      voff_v = (unsigned)(key * 8192 + (h * 256 + 128 + c) * 2);
      const int prow = tid >> 4, half = (tid >> 3) & 1, jr = (tid & 7) ^ (prow & 7);
      voff_kr = (unsigned)((prow + 32 * half) * 128 + jr * 16); }
    const char* kvb = (const char*)(kv + (size_t)tb * 4096); const char* krb = (const char*)(krope + (size_t)tb * 64);
    const unsigned ldsw = (unsigned)wid * 1024u;
#define GLDS(gp, lp) __builtin_amdgcn_global_load_lds((const unsigned*)(gp), (LAS unsigned*)(lp), 16, 0, 0)
#define ST_ISSUE(kb_, BF) do { const char* kt_ = kvb + (size_t)(kb_) * 8192;                                                              \
        GLDS(kt_ + voff_kn, lds + MLA_KN_OFF + (BF) * MLA_TILE + ldsw); GLDS(kt_ + 32 * 8192 + voff_kn, lds + MLA_KN_OFF + (BF) * MLA_TILE + 8192 + ldsw); \
        GLDS(kt_ + voff_v, lds + MLA_V_OFF + (BF) * MLA_TILE + ldsw);   GLDS(kt_ + 32 * 8192 + voff_v, lds + MLA_V_OFF + (BF) * MLA_TILE + 8192 + ldsw);   \
        GLDS(krb + (size_t)(kb_) * 128 + voff_kr, lds + MLA_KR_OFF + (BF) * MLA_KR_BYTES + ldsw); } while (0)
    float m_reg = -1e30f, l_reg = 0.f; f32x16 o[4] = {};
    const int vb0 = (int)(size_t)(lds + MLA_V_OFF) + v_rd_base(lane);
    const LAS char* kbn[4];
#pragma unroll
    for (int dd = 0; dd < 4; ++dd) kbn[dd] = lds + MLA_KN_OFF + r32 * 256 + (((dd * 16 + hi * 8) * 2) ^ ((r32 & 7) << 4));
#define ST_ISSUE_K(kb_, BF) do { const char* kt_ = kvb + (size_t)(kb_) * 8192;                                                             \
        GLDS(kt_ + voff_kn, lds + MLA_KN_OFF + (BF) * MLA_TILE + ldsw); GLDS(kt_ + 32 * 8192 + voff_kn, lds + MLA_KN_OFF + (BF) * MLA_TILE + 8192 + ldsw); \
        GLDS(krb + (size_t)(kb_) * 128 + voff_kr, lds + MLA_KR_OFF + (BF) * MLA_KR_BYTES + ldsw); } while (0)
#define ST_ISSUE_V(kb_, BF) do { const char* kt_ = kvb + (size_t)(kb_) * 8192;                                                             \
        GLDS(kt_ + voff_v, lds + MLA_V_OFF + (BF) * MLA_TILE + ldsw);   GLDS(kt_ + 32 * 8192 + voff_v, lds + MLA_V_OFF + (BF) * MLA_TILE + 8192 + ldsw); } while (0)
#define QK_TILE(P0_, P1_, BF) do { P0_ = f32x16{}; P1_ = f32x16{};                                                                          \
        _Pragma("unroll") for (int d0 = 0; d0 < 8; ++d0) { const LAS char* a_ = kbn[d0 & 3] + (BF) * MLA_TILE + (d0 >> 2) * 128;            \
            const bf16x8 b0 = *reinterpret_cast<const LAS bf16x8*>(a_), b1 = *reinterpret_cast<const LAS bf16x8*>(a_ + 32 * 256);            \
            P0_ = __builtin_amdgcn_mfma_f32_32x32x16_bf16(b0, qr[d0], P0_, 0, 0, 0); P1_ = __builtin_amdgcn_mfma_f32_32x32x16_bf16(b1, qr[d0], P1_, 0, 0, 0); } \
        _Pragma("unroll") for (int d0 = 0; d0 < 4; ++d0) { const LAS char* a_ = kbn[d0] + (MLA_KR_OFF - MLA_KN_OFF) + (BF) * MLA_KR_BYTES;  \
            const bf16x8 b0 = *reinterpret_cast<const LAS bf16x8*>(a_), b1 = *reinterpret_cast<const LAS bf16x8*>(a_ + 128);                 \
            P0_ = __builtin_amdgcn_mfma_f32_32x32x16_bf16(b0, qr[8 + d0], P0_, 0, 0, 0); P1_ = __builtin_amdgcn_mfma_f32_32x32x16_bf16(b1, qr[8 + d0], P1_, 0, 0, 0); } } while (0)
    f32x16 pA0, pA1, pB0, pB1;
    const bool grpA = wid < 4;
#define HB(vm) do { asm volatile("s_waitcnt vmcnt(" #vm ") lgkmcnt(0)" ::: "memory"); __builtin_amdgcn_s_barrier(); asm volatile("" ::: "memory"); } while (0)
#define QK_IF(t_, P0_, P1_, BF) do { if ((t_) < NT && (t_) * KVBLK <= qlo + 31) QK_TILE(P0_, P1_, BF); } while (0)
#define SMPV(t_, C0, C1, BF) do { const int kb = (t_) * KVBLK;                                                                            \
        if (kb <= qlo + 31) {                                                                                                             \
            float mn, alpha; bf16x8 pa0, pa1, pa2, pa3;                                                                                   \
            if (kb + KVBLK - 1 > qlo) mask_tile(C0, C1, qm - kb, 0x7fffffffu);                                                            \
            partialSM(C0, C1, m_reg, mn, alpha, SCALE);                                                                                   \
            finishSM(C0, C1, alpha, l_reg, pa0, pa1, pa2, pa3);                                                                           \
            if (__any(alpha < 1.f)) { if (hi == 0) al_l[r32] = alpha; LDS_WAIT();                                                         \
                _Pragma("unroll") for (int d_ = 0; d_ < 4; ++d_) _Pragma("unroll") for (int r = 0; r < 16; ++r) o[d_][r] *= al_l[crow(r, hi)]; } \
            pv_tile<MLA_V_OFF + (BF) * MLA_TILE>(o, vb0, pa0, pa1, pa2, pa3);                                                             \
        } } while (0)
#define ISSUE_K2(kb_, BF) do { const char* kt_ = kvb + (size_t)(kb_) * 8192; const char* kr_ = krb + (size_t)(kb_) * 128;                   \
        _Pragma("unroll") for (int pp = 0; pp < 2; ++pp) {                                                                                 \
            GLDS(kt_ + pp * 16 * 8192 + voff_kn, lds + MLA_KN_OFF + (BF) * MLA_TILE + pp * 4096 + ldsw);                                    \
            GLDS(kt_ + (32 + pp * 16) * 8192 + voff_kn, lds + MLA_KN_OFF + (BF) * MLA_TILE + 8192 + pp * 4096 + ldsw);                      \
            GLDS(kr_ + pp * 16 * 128 + voff_kr, lds + MLA_KR_OFF + (BF) * MLA_KR_BYTES + pp * 4096 + ldsw); } } while (0)
#define ISSUE_V2(kb_, BF) do { const char* kt_ = kvb + (size_t)(kb_) * 8192;                                                               \
        _Pragma("unroll") for (int pp = 0; pp < 2; ++pp) {                                                                                 \
            GLDS(kt_ + pp * 16 * 8192 + voff_v, lds + MLA_V_OFF + (BF) * MLA_TILE + pp * 4096 + ldsw);                                      \
            GLDS(kt_ + (32 + pp * 16) * 8192 + voff_v, lds + MLA_V_OFF + (BF) * MLA_TILE + 8192 + pp * 4096 + ldsw); } } while (0)
    ST_ISSUE_K(0, 0); ST_ISSUE_V(0, 0); ST_ISSUE_K(KVBLK, 1);
    HB(0);
    QK_TILE(pA0, pA1, 0);
    HB(0);
    if (!grpA) HB(0);
    for (int t = 0; t < NT; t += 2) {
        if (grpA && t + 2 < NT) ISSUE_K2((t + 2) * KVBLK, 0);
        QK_IF(t + 1, pB0, pB1, 1);
        if (t + 2 < NT) HB(6); else HB(0);
        if (grpA) ISSUE_V2((t + 1) * KVBLK, 1);
        SMPV(t, pA0, pA1, 0);
        HB(4);
        if (grpA && t + 3 < NT) ISSUE_K2((t + 3) * KVBLK, 1);
        QK_IF(t + 2, pA0, pA1, 0);
        if (t + 3 < NT) HB(6); else HB(0);
        if (grpA && t + 2 < NT) ISSUE_V2((t + 2) * KVBLK, 0);
        SMPV(t + 1, pB0, pB1, 1);
        if (t + 2 < NT) HB(4); else HB(0);
    }
    if (grpA) HB(0);
#undef ISSUE_K2
#undef ISSUE_V2
#undef SMPV
#undef QK_IF
#undef HB
#undef QK_TILE
#undef ST_ISSUE_K
#undef ST_ISSUE_V
#undef TILE_STEP
#undef ST_ISSUE
#undef GLDS
    if (hi == 0) li_l[r32] = l_reg; LDS_WAIT();
    LAS char* ost = lds + wid * 8192;
#pragma unroll
    for (int r = 0; r < 16; ++r) { const int orow = crow(r, hi); const float rl = __builtin_amdgcn_rcpf(li_l[orow]);
#pragma unroll
        for (int d0 = 0; d0 < 4; ++d0) { const float v = o[d0][r] * rl; const float vn = __shfl_xor(v, 1);
            if ((r32 & 1) == 0) *(LAS unsigned*)(ost + orow * 256 + (d0 * 32 + r32) * 2) = cvt_pk_bf16(v, vn); } }
    LDS_WAIT();
    bf16_t* Ow = omla + (size_t)(tb + qlo) * 2048 + h * 128;
#pragma unroll
    for (int k = 0; k < 8; ++k) { const int row = k * 4 + (lane >> 4), ch = lane & 15;
        const u32x4 w = *(const LAS u32x4*)(ost + row * 256 + ch * 16);
        *(u32x4*)(Ow + (size_t)row * 2048 + ch * 8) = w; }
    __syncthreads();
}

constexpr int XA_K_OFF = 32768, XA_WS_OFF = 65536;
__device__ __forceinline__ void xattn_block(LAS char* lds, const bf16_t* __restrict__ qc, const bf16_t* __restrict__ kc, const bf16_t* __restrict__ vc, bf16_t* __restrict__ oc, int b, int h, int qb) {
    const float SCALE = 0.0625f;
    int tid_ = threadIdx.x; asm volatile("" : "+v"(tid_));
    const int tid = tid_, wid = __builtin_amdgcn_readfirstlane(tid >> 6), lane = tid & 63, r32 = lane & 31, hi = lane >> 5;
    const int rg = wid & 3, vsp = wid >> 2;
    LAS float* wsf = (LAS float*)(lds + XA_WS_OFF) + wid * 64; LAS float* li_l = wsf; LAS float* al_l = wsf + 32;
    const int row0 = b * SEQ + qb * 128 + rg * 32;
    bf16x8 qr[16];
    { const bf16_t* qp = qc + (size_t)(row0 + r32) * 1024 + h * 256;
#pragma unroll
      for (int d0 = 0; d0 < 16; ++d0) qr[d0] = *(const bf16x8*)(qp + d0 * 16 + hi * 8); }
    unsigned voff_k, voff_v;
    { const int row = tid >> 5, cp_ = tid & 31, g = cp_ >> 3, j = cp_ & 7;
      voff_k = (unsigned)(row * 2048 + (h * 256 + (g * 8 + (j ^ (row & 7))) * 8) * 2);
      const int kk = (tid >> 7) * 8 + ((tid & 31) >> 2), key = (kk & ~0xC) | ((kk & 4) << 1) | ((kk & 8) >> 1), c = ((tid >> 5) & 3) * 32 + (tid & 3) * 8;
      voff_v = (unsigned)(key * 2048 + (h * 256 + c) * 2); }
    const char* kcb = (const char*)(kc + (size_t)b * MEMT * 1024); const char* vcb = (const char*)(vc + (size_t)b * MEMT * 1024);
    const unsigned ldsw = (unsigned)wid * 1024u;
#define GLDS(gp, lp) __builtin_amdgcn_global_load_lds((const unsigned*)(gp), (LAS unsigned*)(lp), 16, 0, 0)
    float m_reg = -1e30f, l_reg = 0.f; f32x16 o[4] = {};
    const int vb0 = (int)(size_t)(lds + vsp * 16384) + v_rd_base(lane);
    const LAS char* kbn[4];
#pragma unroll
    for (int dd = 0; dd < 4; ++dd) kbn[dd] = lds + XA_K_OFF + r32 * 512 + (((dd * 16 + hi * 8) * 2) ^ ((r32 & 7) << 4));
    for (int t = 0; t < 4; ++t) {
        const char* kt_ = kcb + (size_t)(t * 64) * 2048; const char* vt_ = vcb + (size_t)(t * 64) * 2048;
        __syncthreads();
#pragma unroll
        for (int i = 0; i < 4; ++i) GLDS(kt_ + (size_t)i * 16 * 2048 + voff_k, lds + XA_K_OFF + i * 8192 + ldsw);
#pragma unroll
        for (int hv = 0; hv < 2; ++hv)
#pragma unroll
            for (int i = 0; i < 2; ++i) GLDS(vt_ + (size_t)i * 32 * 2048 + hv * 256 + voff_v, lds + hv * 16384 + i * 8192 + ldsw);
        asm volatile("s_waitcnt vmcnt(0)" ::: "memory");
        __syncthreads();
        f32x16 p0 = {}, p1 = {}; float mn, alpha; bf16x8 pa0, pa1, pa2, pa3;
#pragma unroll
        for (int d0 = 0; d0 < 16; ++d0) { const LAS char* a_ = kbn[d0 & 3] + (d0 >> 2) * 128;
            const bf16x8 b0 = *reinterpret_cast<const LAS bf16x8*>(a_), b1 = *reinterpret_cast<const LAS bf16x8*>(a_ + 32 * 512);
            p0 = __builtin_amdgcn_mfma_f32_32x32x16_bf16(b0, qr[d0], p0, 0, 0, 0); p1 = __builtin_amdgcn_mfma_f32_32x32x16_bf16(b1, qr[d0], p1, 0, 0, 0); }
        partialSM(p0, p1, m_reg, mn, alpha, SCALE);
        finishSM(p0, p1, alpha, l_reg, pa0, pa1, pa2, pa3);
        if (__any(alpha < 1.f)) { if (hi == 0) al_l[r32] = alpha; LDS_WAIT();
#pragma unroll
            for (int d_ = 0; d_ < 4; ++d_)
#pragma unroll
                for (int r = 0; r < 16; ++r) o[d_][r] *= al_l[crow(r, hi)]; }
        pv_tile<0>(o, vb0, pa0, pa1, pa2, pa3);
    }
#undef GLDS
    if (hi == 0) li_l[r32] = l_reg; LDS_WAIT();
    bf16_t* Ow = oc + (size_t)row0 * 1024 + h * 256 + vsp * 128;
#pragma unroll
    for (int r = 0; r < 16; ++r) { const int orow = crow(r, hi); const float rl = __builtin_amdgcn_rcpf(li_l[orow]);
#pragma unroll
        for (int d0 = 0; d0 < 4; ++d0) { const float v = o[d0][r] * rl; const float vn = __shfl_xor(v, 1);
            if ((r32 & 1) == 0) *(unsigned*)(Ow + (size_t)orow * 1024 + d0 * 32 + r32) = cvt_pk_bf16(v, vn); } }
    __syncthreads();
}
}

constexpr int STAGE_BYTES = 131072;
constexpr int MISC_OFF = STAGE_BYTES;
constexpr int XSTG_OFF = STAGE_BYTES + 256;
constexpr int LDS_BYTES = XSTG_OFF + 8 * 2304;

struct Args { const float* in[26]; float* out; unsigned char* ws; int ph_lo, ph_hi; };

struct Frame {
    LAS unsigned char* lds;
    int tid, lane, wave, G, bid;
    int gw, NGW;
    int xj, xrank, xn;
};

__device__ __forceinline__ int win_map(int n) {
    if (n < 1536) return n;
    if (n < 1600) return 7680 + (n - 1536);
    if (n < 5696) return n - 64;
    if (n < 5712) return 7744 + (n - 5696);
    return n - 80;
}
template <int MODE>
__device__ __forceinline__ void transpose_item(const float* W, int K, int N, bf16_t* WT, const float* gain, LAS float* scr, int item, int lane) {
    const int nblk = (N + 31) / 32, kb = item / nblk, nb = item % nblk, k0 = 64 * kb, n0 = 32 * nb;
    const int n4 = n0 + 4 * (lane & 7); const bool nok = n4 < N;
    f32x4 v[8];
#pragma unroll
    for (int i = 0; i < 8; ++i) v[i] = nok ? *(const f32x4*)(W + (size_t)(k0 + 8 * i + (lane >> 3)) * N + n4) : (f32x4){0.f, 0.f, 0.f, 0.f};
#pragma unroll
    for (int i = 0; i < 8; ++i) { const int kk = 8 * i + (lane >> 3); const float g = gain ? gain[k0 + kk] : 1.0f; LAS float* d = scr + kk * 33 + 4 * (lane & 7);
        d[0] = v[i][0] * g; d[1] = v[i][1] * g; d[2] = v[i][2] * g; d[3] = v[i][3] * g; }
    LDS_WAIT();
    const int c = lane & 7;
#pragma unroll
    for (int j = 0; j < 4; ++j) { const int n = (lane >> 3) + 8 * j; const LAS float* s = scr + (8 * c) * 33 + n;
        u32x4 o; o.x = cvt_pk_bf16(s[0 * 33], s[1 * 33]); o.y = cvt_pk_bf16(s[2 * 33], s[3 * 33]); o.z = cvt_pk_bf16(s[4 * 33], s[5 * 33]); o.w = cvt_pk_bf16(s[6 * 33], s[7 * 33]);
        const int ng = n0 + n;
        if (ng < N) { const int row = MODE == 1 ? win_map(ng) : ng; *(u32x4*)(WT + (size_t)row * K + k0 + 8 * c) = o; } }
    LDS_WAIT();
}
template <int MODE>
__device__ __forceinline__ void transpose_all(const Frame& F, const float* W, int K, int N, bf16_t* WT, const float* gain, int& cursor) {
    LAS float* scr = (LAS float*)(F.lds + F.wave * 8704);
    const int nitems = (K / 64) * ((N + 31) / 32);
    int first = (F.gw - cursor % F.NGW + F.NGW) % F.NGW;
    for (int it = first; it < nitems; it += F.NGW) transpose_item<MODE>(W, K, N, WT, gain, scr, it, F.lane);
    cursor += nitems;
}


__device__ __forceinline__ void p0_prologue(const Frame& F, const Args& a) {
    unsigned char* ws = a.ws;
    int cursor = 0;
    transpose_all<1>(F, a.in[5], D, IN_W, (bf16_t*)(ws + WS_WIN), a.in[4], cursor);
    transpose_all<0>(F, a.in[7], 1024, 3072, (bf16_t*)(ws + WS_WUQ), a.in[6], cursor);
    transpose_all<0>(F, a.in[9], 512, 4096, (bf16_t*)(ws + WS_WUKV), a.in[8], cursor);
    transpose_all<0>(F, a.in[14], D, D, (bf16_t*)(ws + WS_WOUT), nullptr, cursor);
    transpose_all<0>(F, a.in[16], D, 1024, (bf16_t*)(ws + WS_WCQ), a.in[15], cursor);
    transpose_all<0>(F, a.in[17], D, 1024, (bf16_t*)(ws + WS_WCK), nullptr, cursor);
    transpose_all<0>(F, a.in[18], D, 1024, (bf16_t*)(ws + WS_WCV), nullptr, cursor);
    transpose_all<0>(F, a.in[19], 1024, D, (bf16_t*)(ws + WS_WCO), nullptr, cursor);
    transpose_all<0>(F, a.in[21], D, 2048, (bf16_t*)(ws + WS_WPQ), a.in[20], cursor);
    { u32x4* z = (u32x4*)(ws + WS_WIN + (size_t)IN_W * D * 2); const size_t n16 = (size_t)(IN_WP - IN_W) * D * 2 / 16;
      for (size_t i = (size_t)F.bid * NTHREADS + F.tid; i < n16; i += (size_t)F.G * NTHREADS) z[i] = (u32x4){0u, 0u, 0u, 0u}; }
    { const float* k = a.in[22]; bf16_t* o = (bf16_t*)(ws + WS_KEYS); const size_t n8 = (size_t)8 * 2 * 128 * 128 / 8;
      for (size_t i = (size_t)F.bid * NTHREADS + F.tid; i < n8; i += (size_t)F.G * NTHREADS) {
          const f32x4 v0 = *(const f32x4*)(k + i * 8), v1 = *(const f32x4*)(k + i * 8 + 4); *(bf16x8*)(o + i * 8) = pack8(v0, v1); } }
    { const int* pos = (const int*)a.in[2]; float* cs = (float*)(ws + WS_ROPE); float* sn = cs + (size_t)M * 32;
      for (size_t i = (size_t)F.bid * NTHREADS + F.tid; i < (size_t)M * 32; i += (size_t)F.G * NTHREADS) {
          const int m = (int)(i >> 5), fi = (int)(i & 31);
          const float inv = exp2f(-(float)fi * (13.287712379549449f / 32.0f));
          const float ang = (float)pos[m] * inv;
          const float kf = rintf(ang * 0.15915494309189535f);
          float r = fmaf(-kf, 6.28125f, ang); r = fmaf(-kf, 1.9353071795864769e-3f, r);
          const float rev = r * 0.15915494309189535f;
          cs[i] = __builtin_amdgcn_cosf(rev); sn[i] = __builtin_amdgcn_sinf(rev); } }
    { const float* x = a.in[0]; bf16_t* xb = (bf16_t*)(ws + WS_XB); float* rs = (float*)(ws + WS_RSTDX);
      for (int m = F.gw; m < M; m += F.NGW) {
          const f32x4* xr = (const f32x4*)(x + (size_t)m * D); u32x2* xo = (u32x2*)(xb + (size_t)m * D); float ss = 0.f;
          f32x4 v[16];
#pragma unroll
          for (int j = 0; j < 16; ++j) v[j] = xr[F.lane + 64 * j];
#pragma unroll
          for (int j = 0; j < 16; ++j) { ss += (v[j][0] * v[j][0] + v[j][1] * v[j][1]) + (v[j][2] * v[j][2] + v[j][3] * v[j][3]);
              u32x2 p; p.x = cvt_pk_bf16(v[j][0], v[j][1]); p.y = cvt_pk_bf16(v[j][2], v[j][3]); xo[F.lane + 64 * j] = p; }
          ss = wave_sum(ss);
          if (F.lane == 0) rs[m] = 1.0f / sqrtf(ss * (1.0f / D) + EPS); } }
    { const float* mem = a.in[1]; const float* g = a.in[3]; bf16_t* mn = (bf16_t*)(ws + WS_MN);
      for (int m = F.gw; m < MROWS; m += F.NGW) {
          const f32x4* xr = (const f32x4*)(mem + (size_t)m * D); const f32x4* gr = (const f32x4*)g; u32x4* xo = (u32x4*)(mn + (size_t)m * D);
          f32x4 v[16]; float ss = 0.f;
#pragma unroll
          for (int j = 0; j < 8; ++j) { v[2 * j] = xr[2 * F.lane + 128 * j]; v[2 * j + 1] = xr[2 * F.lane + 1 + 128 * j]; }
#pragma unroll
          for (int j = 0; j < 16; ++j) ss += (v[j][0] * v[j][0] + v[j][1] * v[j][1]) + (v[j][2] * v[j][2] + v[j][3] * v[j][3]);
          ss = wave_sum(ss); const float r = 1.0f / sqrtf(ss * (1.0f / D) + EPS);
#pragma unroll
          for (int j = 0; j < 8; ++j) { const f32x4 g0 = gr[2 * F.lane + 128 * j], g1 = gr[2 * F.lane + 1 + 128 * j];
              const bf16x8 p = pack8(v[2 * j] * r * g0, v[2 * j + 1] * r * g1); xo[F.lane + 64 * j] = *(const u32x4*)&p; } } }
}


__device__ __forceinline__ unsigned short f2bf(float v) { return (unsigned short)(cvt_pk_bf16(v, 0.f) & 0xffffu); }
__device__ __forceinline__ float ssq8(bf16x8 v) { float s = 0.f;
#pragma unroll
    for (int e = 0; e < 8; ++e) { const float a = bf2f((unsigned short)v[e]); s += a * a; } return s; }
__device__ __forceinline__ void p2_stats(const Frame& F, unsigned char* ws) {
    const bf16_t* cq = (const bf16_t*)(ws + WS_CQ); const bf16_t* ckv = (const bf16_t*)(ws + WS_CKV); const bf16_t* sm = (const bf16_t*)(ws + WS_SM);
    const float* cs = (const float*)(ws + WS_ROPE); const float* sn = cs + (size_t)M * 32;
    float* rq = (float*)(ws + WS_RSTDQ); float* rkv = (float*)(ws + WS_RSTDKV); bf16_t* kr = (bf16_t*)(ws + WS_KROPE);
    for (int m = F.gw; m < M; m += F.NGW) {
        const bf16x8* a = (const bf16x8*)(cq + (size_t)m * 1024);
        float s1 = ssq8(a[2 * F.lane]) + ssq8(a[2 * F.lane + 1]);
        float s2 = ssq8(((const bf16x8*)(ckv + (size_t)m * 512))[F.lane]);
        s1 = wave_sum(s1); s2 = wave_sum(s2);
        if (F.lane == 0) { rq[m] = 1.0f / sqrtf(s1 * (1.0f / 1024.0f) + EPS); rkv[m] = 1.0f / sqrtf(s2 * (1.0f / 512.0f) + EPS); }
        if (F.lane < 32) { const float x1 = bf2f(sm[(size_t)m * 256 + F.lane]), x2 = bf2f(sm[(size_t)m * 256 + 32 + F.lane]);
            const float c = cs[(size_t)m * 32 + F.lane], s = sn[(size_t)m * 32 + F.lane];
            kr[(size_t)m * 64 + F.lane] = f2bf(x1 * c - x2 * s); kr[(size_t)m * 64 + 32 + F.lane] = f2bf(x2 * c + x1 * s); }
    }
}

__device__ __forceinline__ size_t fr_index(int cgh, int kblk, int mt, int lane, int j) { return ((((size_t)cgh * 8 + kblk) * 4 + mt) * 64 + lane) * 8 + j; }
__device__ __forceinline__ size_t kd_index(int cgh, int w, int t, int s, int lane, int j) { return (((((size_t)cgh * 8 + w) * 2 + t) * 2 + s) * 64 + lane) * 8 + j; }
__device__ __forceinline__ void p2_gla_prep(const Frame& F, unsigned char* ws, const float* __restrict__ w_gate_up, const float* __restrict__ b_gate) {
    const bf16_t* __restrict__ gq = (const bf16_t*)(ws + WS_GQ); const bf16_t* __restrict__ gk = (const bf16_t*)(ws + WS_GK); const bf16_t* __restrict__ sm = (const bf16_t*)(ws + WS_SM);
    bf16_t* __restrict__ qep = (bf16_t*)(ws + WS_QEP); bf16_t* __restrict__ kep = (bf16_t*)(ws + WS_KEP); bf16_t* __restrict__ kdt = (bf16_t*)(ws + WS_KDT); float* __restrict__ dec = (float*)(ws + WS_DEC);
    LAS float* glr = (LAS float*)F.lds;
    LAS float* tot = glr + 1024;
    LAS float* bcl = glr + 1280;
    constexpr int BP = 260;
    for (int cgh = F.bid; cgh < 1024; cgh += F.G) {
        const int cg = cgh >> 2, h = cgh & 3, t0 = cg * 64;
        __syncthreads();
        if (F.tid < 128) { const int tok = F.tid >> 1, half = F.tid & 1; const bf16x8 v = *(const bf16x8*)(sm + (size_t)(t0 + tok) * 256 + 64 + half * 8);
#pragma unroll
            for (int e = 0; e < 8; ++e) glr[tok * 16 + half * 8 + e] = bf2f((unsigned short)v[e]); }
        const int d = F.tid & 255, th = F.tid >> 8;
        float w[16];
#pragma unroll
        for (int r = 0; r < 16; ++r) w[r] = w_gate_up[r * 1024 + h * 256 + d];
        const float bg = b_gate[h * 256 + d];
        unsigned short kraw[32];
#pragma unroll
        for (int c = 0; c < 32; ++c) kraw[c] = gk[(size_t)(t0 + 32 * th + c) * 1024 + h * 256 + d];
        __syncthreads();
        float bc[32]; float cum = 0.f;
#pragma unroll
        for (int c = 0; c < 32; ++c) { float z = bg;
#pragma unroll
            for (int r4 = 0; r4 < 4; ++r4) { const f32x4 gv = *(const LAS f32x4*)(glr + (32 * th + c) * 16 + r4 * 4); z += gv[0] * w[r4 * 4] + gv[1] * w[r4 * 4 + 1] + gv[2] * w[r4 * 4 + 2] + gv[3] * w[r4 * 4 + 3]; }
            const float ls = fminf(z, 0.f) - __logf(1.0f + __expf(-fabsf(z)));
            cum += ls * (1.0f / 16.0f); bc[c] = cum; }
        if (th == 0) tot[d] = cum;
        __syncthreads();
        const float base = th ? tot[d] : 0.f;
        const float blast = th ? base + cum : 0.f;
        if (th == 1) tot[d] = blast;
#pragma unroll
        for (int c = 0; c < 32; ++c) { bc[c] += base; bcl[(32 * th + c) * BP + d] = bc[c]; }
        __syncthreads();
        const float bl = tot[d];
        if (th == 0) dec[(size_t)cgh * 256 + d] = __expf(bl);
        { const int wq = d >> 5, tq = (d >> 4) & 1, col = d & 15;
#pragma unroll
          for (int q_ = 0; q_ < 4; ++q_) { float kd8[8];
#pragma unroll
              for (int j = 0; j < 8; ++j) kd8[j] = bf2f(kraw[8 * q_ + j]) * __expf(bl - bc[8 * q_ + j]);
              *(bf16x8*)(kdt + kd_index(cgh, wq, tq, th, q_ * 16 + col, 0)) = pack8((f32x4){kd8[0], kd8[1], kd8[2], kd8[3]}, (f32x4){kd8[4], kd8[5], kd8[6], kd8[7]}); } }
        { const int c = F.tid & 63, o = F.tid >> 6; const size_t tok = (size_t)(t0 + c);
          bf16x8 qv[4], kv[4];
#pragma unroll
          for (int i = 0; i < 4; ++i) { qv[i] = *(const bf16x8*)(gq + tok * 1024 + h * 256 + 32 * o + 8 * i); kv[i] = *(const bf16x8*)(gk + tok * 1024 + h * 256 + 32 * o + 8 * i); }
          float eb[32];
#pragma unroll
          for (int i = 0; i < 8; ++i) { const f32x4 bv = *(const LAS f32x4*)(bcl + c * BP + 32 * o + 4 * i);
#pragma unroll
              for (int e = 0; e < 4; ++e) eb[4 * i + e] = __expf(bv[e]); }
#pragma unroll
          for (int q_ = 0; q_ < 4; ++q_) { float qe8[8], ke8[8];
#pragma unroll
              for (int j = 0; j < 8; ++j) { const int kk = j < 4 ? 4 * q_ + j : 16 + 4 * q_ + (j - 4);
                  const float e_ = eb[kk];
                  qe8[j] = bf2f((unsigned short)qv[kk >> 3][kk & 7]) * 0.0625f * e_; ke8[j] = bf2f((unsigned short)kv[kk >> 3][kk & 7]) * __builtin_amdgcn_rcpf(e_); }
              const size_t fi = fr_index(cgh, o, c >> 4, q_ * 16 + (c & 15), 0);
              *(bf16x8*)(qep + fi) = pack8((f32x4){qe8[0], qe8[1], qe8[2], qe8[3]}, (f32x4){qe8[4], qe8[5], qe8[6], qe8[7]});
              *(bf16x8*)(kep + fi) = pack8((f32x4){ke8[0], ke8[1], ke8[2], ke8[3]}, (f32x4){ke8[4], ke8[5], ke8[6], ke8[7]}); } }
    }
    __syncthreads();
}
__device__ __forceinline__ void p3_gla_att(const Frame& F, unsigned char* ws) {
    const bf16_t* qep = (const bf16_t*)(ws + WS_QEP); const bf16_t* kep = (const bf16_t*)(ws + WS_KEP); bf16_t* att = (bf16_t*)(ws + WS_ATT);
    const int mt = F.wave >> 1, nt0 = (F.wave & 1) * 2, col = F.lane & 15, q_ = F.lane >> 4;
    for (int cgh = F.bid; cgh < 1024; cgh += F.G) {
        f32x4 a0 = {0.f, 0.f, 0.f, 0.f}, a1 = {0.f, 0.f, 0.f, 0.f};
#pragma unroll
        for (int kb = 0; kb < 8; ++kb) { const bf16x8 A = *(const bf16x8*)(qep + fr_index(cgh, kb, mt, F.lane, 0));
            const bf16x8 B0 = *(const bf16x8*)(kep + fr_index(cgh, kb, nt0, F.lane, 0)), B1 = *(const bf16x8*)(kep + fr_index(cgh, kb, nt0 + 1, F.lane, 0));
            a0 = __builtin_amdgcn_mfma_f32_16x16x32_bf16(A, B0, a0, 0, 0, 0); a1 = __builtin_amdgcn_mfma_f32_16x16x32_bf16(A, B1, a1, 0, 0, 0); }
#pragma unroll
        for (int r = 0; r < 4; ++r) { const int c = mt * 16 + 4 * q_ + r, j0 = nt0 * 16 + col, j1 = j0 + 16;
            att[((size_t)cgh * 64 + c) * 64 + j0] = f2bf(j0 <= c ? a0[r] : 0.f); att[((size_t)cgh * 64 + c) * 64 + j1] = f2bf(j1 <= c ? a1[r] : 0.f); }
    }
}
__device__ __forceinline__ void p5_gla_scan(const Frame& F, unsigned char* ws) {
    const bf16_t* qep = (const bf16_t*)(ws + WS_QEP); const bf16_t* kdt = (const bf16_t*)(ws + WS_KDT); const bf16_t* att = (const bf16_t*)(ws + WS_ATT);
    const float* dec = (const float*)(ws + WS_DEC); const bf16_t* gv = (const bf16_t*)(ws + WS_GV); bf16_t* og = (bf16_t*)(ws + WS_OGLA);
    LAS bf16_t* vbuf = (LAS bf16_t*)F.lds;
    LAS float* red = (LAS float*)(F.lds + 4096);
    const int w = F.wave, lane = F.lane, col = lane & 15, q_ = lane >> 4;
    const int vtr = (int)(size_t)vbuf + (8 * q_ + (col >> 2)) * 32 + 8 * (col & 3);
    for (int item = F.bid; item < 256; item += F.G) {
        const int bh = item >> 5, vs = item & 31, b = bh >> 2, h = bh & 3;
        f32x4 st0 = {0.f, 0.f, 0.f, 0.f}, st1 = {0.f, 0.f, 0.f, 0.f};
        __syncthreads();
        bf16x8 vst = {};
        if (F.tid < 128) vst = *(const bf16x8*)(gv + (size_t)(b * SEQ + (F.tid >> 1)) * 2048 + h * 512 + vs * 16 + (F.tid & 1) * 8);
        if (F.tid < 128) *(LAS bf16x8*)(vbuf + (F.tid >> 1) * 16 + (F.tid & 1) * 8) = vst;
        __syncthreads();
        bf16x8 Aq[4], Ak[2][2], Aa[2] = {}; f32x4 dc0, dc1;
#define GLA_LOAD_OPS(n_) do { const int cg_ = (b * 128 + (n_)) * 4 + h;                                                                   \
            _Pragma("unroll") for (int mt = 0; mt < 4; ++mt) Aq[mt] = *(const bf16x8*)(qep + fr_index(cg_, w, mt, lane, 0));                 \
            _Pragma("unroll") for (int t = 0; t < 2; ++t) _Pragma("unroll") for (int s = 0; s < 2; ++s)                                       \
                Ak[t][s] = *(const bf16x8*)(kdt + kd_index(cg_, w, t, s, lane, 0));                                                              \
            if (w < 4) { _Pragma("unroll") for (int s = 0; s < 2; ++s) Aa[s] = *(const bf16x8*)(att + ((size_t)cg_ * 64 + 16 * w + col) * 64 + 32 * s + 8 * q_); } \
            dc0 = *(const f32x4*)(dec + (size_t)cg_ * 256 + 32 * w + 4 * q_); dc1 = *(const f32x4*)(dec + (size_t)cg_ * 256 + 32 * w + 16 + 4 * q_); } while (0)
        GLA_LOAD_OPS(0);
        for (int n = 0; n < 128; ++n) {
            const int t0 = b * SEQ + n * 64, pb = n & 1;
            if (n + 1 < 128 && F.tid < 128) vst = *(const bf16x8*)(gv + (size_t)(t0 + 64 + (F.tid >> 1)) * 2048 + h * 512 + vs * 16 + (F.tid & 1) * 8);
            bf16x8 Bv[2];
            { const int va = vtr + pb * 2048; s16x4 t0, t1, t2, t3;
              asm volatile("ds_read_b64_tr_b16 %0, %4\n\tds_read_b64_tr_b16 %1, %4 offset:128\n\tds_read_b64_tr_b16 %2, %4 offset:1024\n\tds_read_b64_tr_b16 %3, %4 offset:1152\n\ts_waitcnt lgkmcnt(0)"
                           : "=&v"(t0), "=&v"(t1), "=&v"(t2), "=&v"(t3) : "v"(va) : "memory");
              Bv[0] = (bf16x8){t0[0], t0[1], t0[2], t0[3], t1[0], t1[1], t1[2], t1[3]}; Bv[1] = (bf16x8){t2[0], t2[1], t2[2], t2[3], t3[0], t3[1], t3[2], t3[3]}; }
            u32x4 sw = {cvt_pk_bf16(st0[0], st0[1]), cvt_pk_bf16(st0[2], st0[3]), cvt_pk_bf16(st1[0], st1[1]), cvt_pk_bf16(st1[2], st1[3])};
            const bf16x8 Bs = *reinterpret_cast<bf16x8*>(&sw);
            f32x4 part[4];
#pragma unroll
            for (int mt = 0; mt < 4; ++mt) part[mt] = __builtin_amdgcn_mfma_f32_16x16x32_bf16(Aq[mt], Bs, (f32x4){0.f, 0.f, 0.f, 0.f}, 0, 0, 0);
            if (w < 4) {
#pragma unroll
                for (int mt = 0; mt < 4; ++mt) if (mt == w) {
                    part[mt] = __builtin_amdgcn_mfma_f32_16x16x32_bf16(Aa[0], Bv[0], part[mt], 0, 0, 0);
                    part[mt] = __builtin_amdgcn_mfma_f32_16x16x32_bf16(Aa[1], Bv[1], part[mt], 0, 0, 0); } }
            st0 = st0 * dc0; st1 = st1 * dc1;
            st0 = __builtin_amdgcn_mfma_f32_16x16x32_bf16(Ak[0][0], Bv[0], st0, 0, 0, 0); st0 = __builtin_amdgcn_mfma_f32_16x16x32_bf16(Ak[0][1], Bv[1], st0, 0, 0, 0);
            st1 = __builtin_amdgcn_mfma_f32_16x16x32_bf16(Ak[1][0], Bv[0], st1, 0, 0, 0); st1 = __builtin_amdgcn_mfma_f32_16x16x32_bf16(Ak[1][1], Bv[1], st1, 0, 0, 0);
            __builtin_amdgcn_sched_barrier(0);
            if (n + 1 < 128) GLA_LOAD_OPS(n + 1);
#pragma unroll
            for (int mt = 0; mt < 4; ++mt) *(LAS f32x4*)(red + (size_t)pb * 8192 + ((w * 4 + mt) * 64 + lane) * 4) = part[mt];
            if (n + 1 < 128 && F.tid < 128) *(LAS bf16x8*)(vbuf + (pb ^ 1) * 1024 + (F.tid >> 1) * 16 + (F.tid & 1) * 8) = vst;
            __syncthreads();
            { const int e0 = F.tid * 2, mt = e0 >> 8, ln = (e0 >> 2) & 63, r0 = e0 & 3;
              float s0 = 0.f, s1 = 0.f;
#pragma unroll
              for (int ww = 0; ww < 8; ++ww) { const LAS float* p = red + (size_t)pb * 8192 + ((ww * 4 + mt) * 64 + ln) * 4 + r0; s0 += p[0]; s1 += p[1]; }
              const int c = mt * 16 + 4 * (ln >> 4) + r0, cc = ln & 15;
              og[(size_t)(t0 + c) * 2048 + h * 512 + vs * 16 + cc] = f2bf(s0); og[(size_t)(t0 + c + 1) * 2048 + h * 512 + vs * 16 + cc] = f2bf(s1); }
        }
    }
#undef GLA_LOAD_OPS
    __syncthreads();
}

__device__ __forceinline__ void p6_mix(const Frame& F, unsigned char* ws, const float* g_mla, const float* g_gla) {
    const bf16_t* om = (const bf16_t*)(ws + WS_OMLA); bf16_t* mx = (bf16_t*)(ws + WS_XB); const bf16_t* og = (const bf16_t*)(ws + WS_OGLA); const bf16_t* gog = (const bf16_t*)(ws + WS_GOG);
    for (int m = F.gw; m < M; m += F.NGW) {
        const bf16x8* a = (const bf16x8*)(om + (size_t)m * 2048); bf16x8 v[4]; float ss = 0.f;
#pragma unroll
        for (int j = 0; j < 4; ++j) { v[j] = a[F.lane + 64 * j]; ss += ssq8(v[j]); }
        ss = wave_sum(ss); const float r = 1.0f / sqrtf(ss * (1.0f / 2048.0f) + EPS);
        u32x4* o = (u32x4*)(mx + (size_t)m * D);
#pragma unroll
        for (int j = 0; j < 4; ++j) { const int c0 = (F.lane + 64 * j) * 8; const f32x4 g0 = *(const f32x4*)(g_mla + c0), g1 = *(const f32x4*)(g_mla + c0 + 4);
            f32x4 x0, x1;
#pragma unroll
            for (int e = 0; e < 4; ++e) { x0[e] = bf2f((unsigned short)v[j][e]) * r * g0[e]; x1[e] = bf2f((unsigned short)v[j][4 + e]) * r * g1[e]; }
            const bf16x8 p = pack8(x0, x1); o[F.lane + 64 * j] = *(const u32x4*)&p; }
        const bf16x8* ga = (const bf16x8*)(og + (size_t)m * 2048); const bf16x8* gg = (const bf16x8*)(gog + (size_t)m * 2048);
#pragma unroll
        for (int j = 0; j < 4; ++j) { const bf16x8 ov = ga[F.lane + 64 * j], gt = gg[F.lane + 64 * j];
            const float hs = wave_sum(ssq8(ov)); const float rh = 1.0f / sqrtf(hs * (1.0f / 512.0f) + EPS);
            const int c0 = F.lane * 8; const f32x4 g0 = *(const f32x4*)(g_gla + c0), g1 = *(const f32x4*)(g_gla + c0 + 4);
            f32x4 x0, x1;
#pragma unroll
            for (int e = 0; e < 4; ++e) { const float z0 = bf2f((unsigned short)gt[e]), z1 = bf2f((unsigned short)gt[4 + e]);
                x0[e] = bf2f((unsigned short)ov[e]) * rh * g0[e] * (z0 / (1.0f + __expf(-z0)));
                x1[e] = bf2f((unsigned short)ov[4 + e]) * rh * g1[e] * (z1 / (1.0f + __expf(-z1))); }
            const bf16x8 p = pack8(x0, x1); o[256 + F.lane + 64 * j] = *(const u32x4*)&p; }
    }
}
__device__ __forceinline__ void p4_mla(const Frame& F, unsigned char* ws) {
    const bf16_t* q = (const bf16_t*)(ws + WS_Q); const bf16_t* kv = (const bf16_t*)(ws + WS_KV); const bf16_t* kr = (const bf16_t*)(ws + WS_KROPE);
    const float* cs = (const float*)(ws + WS_ROPE); const float* sn = cs + (size_t)M * 32; bf16_t* om = (bf16_t*)(ws + WS_OMLA);
    for (int L = F.bid; L < 512; L += F.G) {
        const int xcd = L & 7, I = L >> 3, bh = xcd * 4 + (I >> 4), pr = I & 15, b = bh >> 4, h = bh & 15;
        for (int pass = 0; pass < 2; ++pass) att::mla_block((LAS char*)F.lds, q, kv, kr, cs, sn, om, b, h, pass ? pr : 31 - pr);
    }
}


__device__ __forceinline__ void rstd_for_units(const Frame& F, const pg8::StaticOrder& S, const float* __restrict__ ssq, float* __restrict__ rstd) {
    pg8::Unit u;
    for (int i = 0; S.next(i, u); ++i) {
        float v[32];
#pragma unroll
        for (int k = 0; k < 32; ++k) v[k] = ssq[(size_t)(u.pm * 256 + F.wave * 32 + k) * 64 + F.lane];
        float mine = 0.f;
#pragma unroll
        for (int k = 0; k < 32; ++k) { const float s = wave_sum(v[k]); mine = (F.lane == k) ? s : mine; }
        if (F.lane < 32) rstd[u.pm * 256 + F.wave * 32 + F.lane] = 1.0f / sqrtf(mine * (1.0f / D) + EPS);
    }
    asm volatile("s_waitcnt vmcnt(0)" ::: "memory");
    __syncthreads();
}
__device__ __forceinline__ void p9_xattn(const Frame& F, unsigned char* ws) {
    const bf16_t* qc = (const bf16_t*)(ws + WS_QC); const bf16_t* kc = (const bf16_t*)(ws + WS_KC); const bf16_t* vc = (const bf16_t*)(ws + WS_VC); bf16_t* oc = (bf16_t*)(ws + WS_OC);
    for (int L = F.bid; L < 512; L += F.G) { const int h = L & 3, blk = L >> 2, b = blk >> 6, qb = blk & 63;
        att::xattn_block((LAS char*)F.lds, qc, kc, vc, oc, b, h, qb); }
}


typedef float f32x2 __attribute__((ext_vector_type(2)));
__device__ __forceinline__ bool fp4_probe_ok() {
    float a = 1.0f, b = 3.0f, c = 0.5f, d = 6.0f; asm volatile("" : "+v"(a), "+v"(b), "+v"(c), "+v"(d));
    unsigned w = 0u;
    w = __builtin_amdgcn_cvt_scalef32_pk_fp4_f32(w, a, b, 1.0f, 0); w = __builtin_amdgcn_cvt_scalef32_pk_fp4_f32(w, c, d, 1.0f, 3);
    const f32x2 y0 = __builtin_amdgcn_cvt_scalef32_pk_f32_fp4(w, 1.0f, 0), y3 = __builtin_amdgcn_cvt_scalef32_pk_f32_fp4(w, 1.0f, 3), y1 = __builtin_amdgcn_cvt_scalef32_pk_f32_fp4(w, 1.0f, 1);
    return y0.x == 1.0f && y0.y == 3.0f && y3.x == 0.5f && y3.y == 6.0f && y1.x == 0.0f && y1.y == 0.0f;
}
#define DPP_MAX(v, ctrl) (v) = fmaxf((v), __int_as_float(__builtin_amdgcn_update_dpp(0, __float_as_int(v), (ctrl), 0xF, 0xF, false)))
__device__ __forceinline__ void peer_tables_to_fp4(const Frame& F, unsigned char* ws, const float* pu, const float* pv) {
    const bool ok = fp4_probe_ok();
    for (int r = F.gw; r < 2 * 16384; r += F.NGW) {
        const int tab = r >= 16384, row = r & 16383;
        const float* srow = (tab ? pv : pu) + (size_t)row * D;
        unsigned char* vals = ws + (tab ? WS_VB : WS_UB); float* rsc = (float*)(ws + (tab ? WS_VSC : WS_USC));
        float ss = 0.f, am = 0.f;
#pragma unroll
        for (int kh = 0; kh < 2; ++kh) { f32x4 v[8];
#pragma unroll
            for (int k8 = 0; k8 < 8; ++k8) v[k8] = *(const f32x4*)(srow + (kh * 8 + k8) * 256 + F.lane * 4);
#pragma unroll
            for (int k8 = 0; k8 < 8; ++k8) { ss += (v[k8][0] * v[k8][0] + v[k8][1] * v[k8][1]) + (v[k8][2] * v[k8][2] + v[k8][3] * v[k8][3]);
                am = fmaxf(am, fmaxf(fmaxf(fabsf(v[k8][0]), fabsf(v[k8][1])), fmaxf(fabsf(v[k8][2]), fabsf(v[k8][3])))); } }
        ss = wave_sum(ss);
        DPP_MAX(am, 0xB1); DPP_MAX(am, 0x4E); DPP_MAX(am, 0x141); DPP_MAX(am, 0x140);
        am = fmaxf(fmaxf(__int_as_float(__builtin_amdgcn_readlane(__float_as_int(am), 0)), __int_as_float(__builtin_amdgcn_readlane(__float_as_int(am), 16))),
                   fmaxf(__int_as_float(__builtin_amdgcn_readlane(__float_as_int(am), 32)), __int_as_float(__builtin_amdgcn_readlane(__float_as_int(am), 48))));
        const float top = fminf(am, 3.0f * sqrtf(ss * (1.0f / D)));
        const float sc = top > 0.f ? top * (1.0f / 6.0f) : 1.0f, inv = 1.0f / sc;
        if (F.lane == 0) rsc[row] = ok ? sc : __uint_as_float(0x7FC00000u);
#pragma unroll
        for (int kh = 0; kh < 2; ++kh) { f32x4 v[8];
#pragma unroll
            for (int k8 = 0; k8 < 8; ++k8) v[k8] = *(const f32x4*)(srow + (kh * 8 + k8) * 256 + F.lane * 4);
#pragma unroll
            for (int k8 = 0; k8 < 8; ++k8) { const int k = kh * 8 + k8;
                const float q0 = fminf(fmaxf(v[k8][0] * inv, -6.0f), 6.0f), q1 = fminf(fmaxf(v[k8][1] * inv, -6.0f), 6.0f), q2 = fminf(fmaxf(v[k8][2] * inv, -6.0f), 6.0f), q3 = fminf(fmaxf(v[k8][3] * inv, -6.0f), 6.0f);
                unsigned p = 0u;
                p = __builtin_amdgcn_cvt_scalef32_pk_fp4_f32(p, q0, q1, 1.0f, 0); p = __builtin_amdgcn_cvt_scalef32_pk_fp4_f32(p, q2, q3, 1.0f, 1);
                const size_t sl = (size_t)(k >> 1) * 16384 + row;
                *(unsigned short*)(vals + sl * 256 + (k & 1) * 128 + 2 * F.lane) = (unsigned short)p; } }
    }
}
#define CE_(a, b) do { const float hi_ = fmaxf(a, b), lo_ = fminf(a, b); a = hi_; b = lo_; } while (0)
__device__ __forceinline__ void sort16_desc(float (&v)[16]) {
    CE_(v[0], v[1]); CE_(v[2], v[3]); CE_(v[0], v[2]); CE_(v[1], v[3]); CE_(v[1], v[2]); CE_(v[4], v[5]); CE_(v[6], v[7]); CE_(v[4], v[6]); CE_(v[5], v[7]); CE_(v[5], v[6]); CE_(v[0], v[4]); CE_(v[2], v[6]); CE_(v[2], v[4]); CE_(v[1], v[5]); CE_(v[3], v[7]); CE_(v[3], v[5]); CE_(v[1], v[2]); CE_(v[3], v[4]); CE_(v[5], v[6]); CE_(v[8], v[9]); CE_(v[10], v[11]); CE_(v[8], v[10]); CE_(v[9], v[11]); CE_(v[9], v[10]); CE_(v[12], v[13]); CE_(v[14], v[15]); CE_(v[12], v[14]); CE_(v[13], v[15]); CE_(v[13], v[14]); CE_(v[8], v[12]); CE_(v[10], v[14]); CE_(v[10], v[12]); CE_(v[9], v[13]); CE_(v[11], v[15]); CE_(v[11], v[13]); CE_(v[9], v[10]); CE_(v[11], v[12]); CE_(v[13], v[14]); CE_(v[0], v[8]); CE_(v[4], v[12]); CE_(v[4], v[8]); CE_(v[2], v[10]); CE_(v[6], v[14]); CE_(v[6], v[10]); CE_(v[2], v[4]); CE_(v[6], v[8]); CE_(v[10], v[12]); CE_(v[1], v[9]); CE_(v[5], v[13]); CE_(v[5], v[9]); CE_(v[3], v[11]); CE_(v[7], v[15]); CE_(v[7], v[11]); CE_(v[3], v[5]); CE_(v[7], v[9]); CE_(v[11], v[13]); CE_(v[1], v[2]); CE_(v[3], v[4]); CE_(v[5], v[6]); CE_(v[7], v[8]); CE_(v[9], v[10]); CE_(v[11], v[12]); CE_(v[13], v[14]);
}
__device__ __forceinline__ void bitonic16_desc(float (&v)[16]) {
    CE_(v[0], v[8]); CE_(v[1], v[9]); CE_(v[2], v[10]); CE_(v[3], v[11]); CE_(v[4], v[12]); CE_(v[5], v[13]); CE_(v[6], v[14]); CE_(v[7], v[15]); CE_(v[0], v[4]); CE_(v[1], v[5]); CE_(v[2], v[6]); CE_(v[3], v[7]); CE_(v[8], v[12]); CE_(v[9], v[13]); CE_(v[10], v[14]); CE_(v[11], v[15]); CE_(v[0], v[2]); CE_(v[1], v[3]); CE_(v[4], v[6]); CE_(v[5], v[7]); CE_(v[8], v[10]); CE_(v[9], v[11]); CE_(v[12], v[14]); CE_(v[13], v[15]); CE_(v[0], v[1]); CE_(v[2], v[3]); CE_(v[4], v[5]); CE_(v[6], v[7]); CE_(v[8], v[9]); CE_(v[10], v[11]); CE_(v[12], v[13]); CE_(v[14], v[15]);
}

__device__ __forceinline__ void merge_top16(float (&a)[16], const float (&b)[16]) {
#pragma unroll
    for (int i = 0; i < 16; ++i) a[i] = fmaxf(a[i], b[15 - i]);
    bitonic16_desc(a);
}
__device__ __forceinline__ void top16_of_64(const float (&s)[64], float (&t)[16]) {
    float g1[16], g2[16], g3[16];
#pragma unroll
    for (int i = 0; i < 16; ++i) { t[i] = s[i]; g1[i] = s[16 + i]; g2[i] = s[32 + i]; g3[i] = s[48 + i]; }
    sort16_desc(t); sort16_desc(g1); sort16_desc(g2); sort16_desc(g3);
    merge_top16(t, g1); merge_top16(g2, g3); merge_top16(t, g2);
}
__device__ __forceinline__ void p12_keys_to_lds(const Frame& F, unsigned char* ws) {
    const bf16_t* keys = (const bf16_t*)(ws + WS_KEYS) + (size_t)(F.bid & 7) * 256 * 128;
#pragma unroll
    for (int i = 0; i < 8; ++i) { const int gch = F.tid + 512 * i, R = gch >> 4, c = gch & 15;
        *(LAS u32x4*)(F.lds + R * 256 + ((c ^ (R & 15)) * 16)) = *(const u32x4*)(keys + (size_t)R * 128 + c * 8); }
}
__device__ __forceinline__ void p12_topk(const Frame& F, unsigned char* ws) {
    const bf16_t* qp = (const bf16_t*)(ws + WS_QP); int* ids = (int*)(ws + WS_IDS); float* gates = (float*)(ws + WS_GATES);
    const float NEG = -__builtin_inff();
    const int ngrp = (F.G - 1 - (F.bid & 7)) / 8 + 1;
#pragma unroll 1
    for (int it = 0; ; ++it) {
        const int tg = ((F.bid >> 3) + it * ngrp) * 8 + F.wave; if (tg >= 512) break;
        int lane_ = F.lane; asm volatile("" : "+v"(lane_));
        const int tok = lane_ & 31, hi = lane_ >> 5;
        const int h = F.bid & 7, token = tg * 32 + tok;
        float top[2][16];
#pragma unroll
        for (int p = 0; p < 2; ++p) {
            bf16x8 qr[8];
#pragma unroll
            for (int d0 = 0; d0 < 8; ++d0) qr[d0] = *(const bf16x8*)(qp + (size_t)token * 2048 + h * 256 + p * 128 + d0 * 16 + hi * 8);
            float s[64];
#pragma unroll
            for (int kb = 0; kb < 4; ++kb) { f32x16 acc = {};
                const int R = p * 128 + kb * 32 + tok; const LAS unsigned char* kl = F.lds + R * 256;
#pragma unroll
                for (int d0 = 0; d0 < 8; ++d0) acc = __builtin_amdgcn_mfma_f32_32x32x16_bf16(*(const LAS bf16x8*)(kl + (((2 * d0 + hi) ^ (R & 15)) * 16)), qr[d0], acc, 0, 0, 0);
#pragma unroll
                for (int r = 0; r < 16; ++r) { const int idx = kb * 32 + (r & 3) + 8 * (r >> 2) + 4 * hi;
                    s[kb * 16 + r] = __uint_as_float((__float_as_uint(acc[r]) & ~0x7Fu) | (unsigned)(127 - idx)); } }
            float t[16]; top16_of_64(s, t);
            float pt[16];
#pragma unroll
            for (int i = 0; i < 16; ++i) { const unsigned own = __float_as_uint(t[i]); auto rr = __builtin_amdgcn_permlane32_swap(own, own, false, false); pt[i] = __uint_as_float(rr[0] ^ rr[1] ^ own); }
            merge_top16(t, pt);
#pragma unroll
            for (int i = 0; i < 16; ++i) top[p][i] = t[i];
        }
        float c[64], cs_[16];
#define CAND_(k, i, j) c[k] = __uint_as_float((__float_as_uint(top[0][i] + top[1][j]) & ~0xFFu) | (unsigned)(255 - ((i) * 16 + (j))))
        CAND_(0, 0, 0); CAND_(1, 0, 1); CAND_(2, 0, 2); CAND_(3, 0, 3); CAND_(4, 0, 4); CAND_(5, 0, 5); CAND_(6, 0, 6); CAND_(7, 0, 7); CAND_(8, 0, 8); CAND_(9, 0, 9); CAND_(10, 0, 10); CAND_(11, 0, 11); CAND_(12, 0, 12); CAND_(13, 0, 13); CAND_(14, 0, 14); CAND_(15, 0, 15); CAND_(16, 1, 0); CAND_(17, 1, 1); CAND_(18, 1, 2); CAND_(19, 1, 3); CAND_(20, 1, 4); CAND_(21, 1, 5); CAND_(22, 1, 6); CAND_(23, 1, 7); CAND_(24, 2, 0); CAND_(25, 2, 1); CAND_(26, 2, 2); CAND_(27, 2, 3); CAND_(28, 2, 4); CAND_(29, 3, 0); CAND_(30, 3, 1); CAND_(31, 3, 2); CAND_(32, 3, 3); CAND_(33, 4, 0); CAND_(34, 4, 1); CAND_(35, 4, 2); CAND_(36, 5, 0); CAND_(37, 5, 1); CAND_(38, 6, 0); CAND_(39, 6, 1); CAND_(40, 7, 0); CAND_(41, 7, 1); CAND_(42, 8, 0); CAND_(43, 9, 0); CAND_(44, 10, 0); CAND_(45, 11, 0); CAND_(46, 12, 0); CAND_(47, 13, 0); CAND_(48, 14, 0); CAND_(49, 15, 0);
#undef CAND_
#pragma unroll
        for (int k = 50; k < 64; ++k) c[k] = NEG;
        top16_of_64(c, cs_);
        int ex[16];
#pragma unroll
        for (int k = 0; k < 16; ++k) { const int flat = 255 - (int)(__float_as_uint(cs_[k]) & 0xFFu), ci = flat >> 4, cj = flat & 15;
            float t0 = top[0][0], t1 = top[1][0];
#pragma unroll
            for (int t = 1; t < 16; ++t) { t0 = (ci == t) ? top[0][t] : t0; t1 = (cj == t) ? top[1][t] : t1; }
            const int i1 = 127 - (int)(__float_as_uint(t0) & 0x7Fu), i2 = 127 - (int)(__float_as_uint(t1) & 0x7Fu);
            ex[k] = i1 * 128 + i2; }
        float den = 0.f, ev[16];
#pragma unroll
        for (int k = 0; k < 16; ++k) { ev[k] = __expf(cs_[k] - cs_[0]); den += ev[k]; }
        const float rden = 1.0f / den;
        const size_t ob = ((size_t)token * 8 + h) * 16;
        if (hi == 0) {
#pragma unroll
            for (int k4 = 0; k4 < 4; ++k4) *(int4*)(ids + ob + k4 * 4) = make_int4(ex[k4 * 4], ex[k4 * 4 + 1], ex[k4 * 4 + 2], ex[k4 * 4 + 3]); }
        else {
#pragma unroll
            for (int k4 = 0; k4 < 4; ++k4) *(f32x4*)(gates + ob + k4 * 4) = (f32x4){ev[k4 * 4] * rden, ev[k4 * 4 + 1] * rden, ev[k4 * 4 + 2] * rden, ev[k4 * 4 + 3] * rden}; }
    }
}
__device__ __forceinline__ float gelu_erf(float v) {
    const float av = fabsf(v), t = __builtin_amdgcn_rcpf(fmaf(av, 0.2316418882f, 1.0f));
    float q = fmaf(t, 0.5307027145f, -0.7265760135f); q = fmaf(q, t, 0.7107068705f); q = fmaf(q, t, -0.142248368f); q = fmaf(q, t, 0.127414796f); q = q * t;
    const float e = __builtin_amdgcn_exp2f(v * v * -0.72134752044f), m = v * (q * e);
    return v < 0.f ? m : v - m;
}
struct PRow { u32x4 v; };
#define ROW16_ADD(v) do { DPP_ADD(v, 0xB1, 0xF); DPP_ADD(v, 0x4E, 0xF); DPP_ADD(v, 0x141, 0xF); DPP_ADD(v, 0x140, 0xF); } while (0)
#define PW_LOAD(W, q0, idp, vb, sb) do { const u32x4 ia_ = *(const LAS u32x4*)((idp) + (q0)), ib_ = *(const LAS u32x4*)((idp) + (q0) + 4); \
        _Pragma("unroll") for (int r_ = 0; r_ < 8; ++r_) { const unsigned id_ = r_ < 4 ? ia_[r_ & 3] : ib_[r_ & 3]; \
            W[r_].v = *(const u32x4*)((vb) + ((id_ << 8) + i16)); } } while (0)
#define PD_COMP(W, q0, ap) do { const u32x4 ta1_ = *(const LAS u32x4*)((ap) + (q0)), tb1_ = *(const LAS u32x4*)((ap) + (q0) + 4), tas_ = *(const LAS u32x4*)((ap) + 256 + (q0)), tbs_ = *(const LAS u32x4*)((ap) + 256 + (q0) + 4); \
        _Pragma("unroll") for (int r_ = 0; r_ < 8; ++r_) { const unsigned d1_ = r_ < 4 ? ta1_[r_ & 3] : tb1_[r_ & 3]; const int s1_ = (int)(r_ < 4 ? tas_[r_ & 3] : tbs_[r_ & 3]); \
            const i32x8 A8_ = {(int)W[r_].v.x, (int)W[r_].v.y, (int)W[r_].v.z, (int)W[r_].v.w, 0, 0, 0, 0}; \
            if (r_ & 1) { Q1a[0] = (int)(d1_ & mlo); Q1a[1] = (int)(d1_ & mhi); Q1b[2] = Q1a[0]; Q1b[3] = Q1a[1]; \
                y[2] = __builtin_amdgcn_mfma_scale_f32_16x16x128_f8f6f4(A8_, Q1a, y[2], 4, 4, 0, 127, 0, s1_); y[3] = __builtin_amdgcn_mfma_scale_f32_16x16x128_f8f6f4(A8_, Q1b, y[3], 4, 4, 0, 127, 0, s1_); } \
            else { P1a[0] = (int)(d1_ & mlo); P1a[1] = (int)(d1_ & mhi); P1b[2] = P1a[0]; P1b[3] = P1a[1]; \
                y[0] = __builtin_amdgcn_mfma_scale_f32_16x16x128_f8f6f4(A8_, P1a, y[0], 4, 4, 0, 127, 0, s1_); y[1] = __builtin_amdgcn_mfma_scale_f32_16x16x128_f8f6f4(A8_, P1b, y[1], 4, 4, 0, 127, 0, s1_); } } \
        __builtin_amdgcn_sched_barrier(0); } while (0)
#define BF_LO(w) __uint_as_float((w) << 16)
#define BF_HI(w) __uint_as_float((w) & 0xffff0000u)
#define FP4X2(q, k) __builtin_amdgcn_cvt_scalef32_pk_f32_fp4((q), 1.0f, (k))
__device__ __forceinline__ void p12c_quant(const Frame& F, unsigned char* ws, const float* g_ffn) {
    const bf16_t* h2b = (const bf16_t*)(ws + WS_H2B); unsigned char* xq = ws + WS_XQ; unsigned char* xsc = ws + WS_XQS;
    const bool ok = fp4_probe_ok();
#pragma unroll 1
    for (int token = F.gw; token < M; token += F.NGW) {
        int lane_ = F.lane; asm volatile("" : "+v"(lane_)); const int lane = lane_;
#pragma unroll
        for (int blk = 0; blk < 2; ++blk) { const int c0 = 64 * lane + 32 * blk;
            float v[32];
#pragma unroll
            for (int m = 0; m < 4; ++m) { const u32x4 hw = *(const u32x4*)(h2b + (size_t)token * D + c0 + 8 * m); const f32x4 g0 = *(const f32x4*)(g_ffn + c0 + 8 * m), g1 = *(const f32x4*)(g_ffn + c0 + 8 * m + 4);
                v[8 * m + 0] = BF_LO(hw.x) * g0[0]; v[8 * m + 1] = BF_HI(hw.x) * g0[1]; v[8 * m + 2] = BF_LO(hw.y) * g0[2]; v[8 * m + 3] = BF_HI(hw.y) * g0[3];
                v[8 * m + 4] = BF_LO(hw.z) * g1[0]; v[8 * m + 5] = BF_HI(hw.z) * g1[1]; v[8 * m + 6] = BF_LO(hw.w) * g1[2]; v[8 * m + 7] = BF_HI(hw.w) * g1[3]; }
#pragma unroll
            for (int term = 0; term < 2; ++term) { float am = 0.f;
#pragma unroll
                for (int k = 0; k < 32; ++k) am = fmaxf(am, fabsf(v[k]));
                const unsigned rb = __float_as_uint(am * (1.0f / 6.0f));
                int e = (int)(rb >> 23) - 127 + ((rb & 0x7FFFFFu) != 0u ? 1 : 0); e = e < -120 ? -120 : (e > 120 ? 120 : e);
                const float inv = __uint_as_float((unsigned)(127 - e) << 23), sc = __uint_as_float((unsigned)(127 + e) << 23);
                unsigned w[4];
#pragma unroll
                for (int k = 0; k < 4; ++k) { unsigned d = 0u;
                    d = __builtin_amdgcn_cvt_scalef32_pk_fp4_f32(d, v[8 * k] * inv, v[8 * k + 1] * inv, 1.0f, 0); d = __builtin_amdgcn_cvt_scalef32_pk_fp4_f32(d, v[8 * k + 2] * inv, v[8 * k + 3] * inv, 1.0f, 1);
                    d = __builtin_amdgcn_cvt_scalef32_pk_fp4_f32(d, v[8 * k + 4] * inv, v[8 * k + 5] * inv, 1.0f, 2); d = __builtin_amdgcn_cvt_scalef32_pk_fp4_f32(d, v[8 * k + 6] * inv, v[8 * k + 7] * inv, 1.0f, 3);
                    w[k] = d;
                    if (term == 0) { const f32x2 y0 = FP4X2(d, 0), y1 = FP4X2(d, 1), y2 = FP4X2(d, 2), y3 = FP4X2(d, 3);
                        v[8 * k] -= y0.x * sc; v[8 * k + 1] -= y0.y * sc; v[8 * k + 2] -= y1.x * sc; v[8 * k + 3] -= y1.y * sc; v[8 * k + 4] -= y2.x * sc; v[8 * k + 5] -= y2.y * sc; v[8 * k + 6] -= y3.x * sc; v[8 * k + 7] -= y3.y * sc; } }
                *(u32x4*)(xq + (size_t)term * M * 2048 + (size_t)token * 2048 + c0 / 2) = (u32x4){w[0], w[1], w[2], w[3]};
                xsc[(size_t)term * M * 128 + (size_t)token * 128 + 2 * lane + blk] = (unsigned char)(ok ? (unsigned)(e + 127) : 255u); }
        }
    }
}
typedef int i32x8 __attribute__((ext_vector_type(8)));
#define UG_LOAD(SB, TB, CB, idp) do { _Pragma("unroll") for (int tt_ = 0; tt_ < 4; ++tt_) _Pragma("unroll") for (int h_ = 0; h_ < 2; ++h_) { const unsigned id_ = (idp)[16 * ((TB) + tt_) + 8 * h_]; \
        __builtin_amdgcn_global_load_lds((const unsigned*)(uvj + ((id_ << 8) + 64u * (CB) + gsw16)), (LAS unsigned*)(slots + ((SB) + tt_ * 2 + h_) * 1024), 16, 0, 0); } \
        __builtin_amdgcn_sched_barrier(0); } while (0)
#define BPERM(v) ((unsigned)__builtin_amdgcn_ds_bpermute(pa, (int)(v)))
#define UG_COMP(SB, TB, CB, xp, NV) do { asm volatile("s_waitcnt vmcnt(" #NV ")" ::: "memory"); __builtin_amdgcn_sched_barrier(0); \
        u32x4 P_[8]; _Pragma("unroll") for (int tt_ = 0; tt_ < 4; ++tt_) { P_[tt_ * 2] = *(const LAS u32x4*)(slots + ((SB) + tt_ * 2) * 1024 + rdo0); P_[tt_ * 2 + 1] = *(const LAS u32x4*)(slots + ((SB) + tt_ * 2) * 1024 + rdo1); } \
        _Pragma("unroll") for (int cc_ = 0; cc_ < 2; ++cc_) { const int c_ = (CB) + cc_; \
            const u32x4 b0_ = *(const LAS u32x4*)((xp) + 64 * c_), b1_ = *(const LAS u32x4*)((xp) + 256 + 64 * c_); \
            const int s0_ = (int)*(const LAS unsigned char*)((xp) + 512 + 4 * c_ - 15 * kq), s1_ = (int)*(const LAS unsigned char*)((xp) + 528 + 4 * c_ - 15 * kq); \
            const i32x8 x0_ = {(int)b0_.x, (int)b0_.y, (int)b0_.z, (int)b0_.w, 0, 0, 0, 0}, x1_ = {(int)b1_.x, (int)b1_.y, (int)b1_.z, (int)b1_.w, 0, 0, 0, 0}; \
            _Pragma("unroll") for (int tt_ = 0; tt_ < 4; ++tt_) { const u32x4 q_ = P_[tt_ * 2 + cc_]; const i32x8 A8_ = {(int)q_.x, (int)q_.y, (int)q_.z, (int)q_.w, 0, 0, 0, 0}; \
                dacc[(TB) + tt_] = __builtin_amdgcn_mfma_scale_f32_16x16x128_f8f6f4(A8_, x0_, dacc[(TB) + tt_], 4, 4, 0, 127, 0, s0_); } \
            _Pragma("unroll") for (int tt_ = 0; tt_ < 4; ++tt_) { const u32x4 q_ = P_[tt_ * 2 + cc_]; const i32x8 A8_ = {(int)q_.x, (int)q_.y, (int)q_.z, (int)q_.w, 0, 0, 0, 0}; \
                dacc[(TB) + tt_] = __builtin_amdgcn_mfma_scale_f32_16x16x128_f8f6f4(A8_, x1_, dacc[(TB) + tt_], 4, 4, 0, 127, 0, s1_); } } \
        __builtin_amdgcn_sched_barrier(0); } while (0)
__device__ __forceinline__ void p13a_up(const Frame& F, unsigned char* ws) {
    const int j = F.xj, lw = F.xrank * NWAVES + F.wave, nw = F.xn * NWAVES;
    int lane_ = F.lane; asm volatile("" : "+v"(lane_));
    const int lane = lane_, r = lane & 15, kq = lane >> 4, ge = lane >> 2; const unsigned gp4 = 4u * (unsigned)(lane & 3), l4 = 4u * (unsigned)lane;
    const unsigned gsw16 = 16u * (unsigned)((lane & 7) ^ ((lane >> 3) & 6));
    const int rdo0 = (r >> 3) * 1024 + 128 * (r & 7) + 16 * (kq ^ (r & 6)), rdo1 = (r >> 3) * 1024 + 128 * (r & 7) + 16 * ((4 + kq) ^ (r & 6));
    const unsigned char* uvj = ws + WS_UB + (size_t)j * 16384 * 256; const unsigned char* usj = ws + WS_UB + PEER_VAL_BYTES + (size_t)j * 16384 * 16;
    const unsigned char* ids = ws + WS_IDS;
    const unsigned char* xq = ws + WS_XQ + (size_t)(lane >> 5) * M * 2048 + 256 * j + 8 * (lane & 31);
    const unsigned char* xsc = ws + WS_XQS + (size_t)((lane >> 4) & 1) * M * 128 + 16 * j + (lane & 15);
    float* pd = (float*)(ws + WS_PD) + (size_t)j * M * 128 + 4 * kq;
    LAS unsigned char* wl = F.lds + XSTG_OFF + F.wave * 2304; LAS unsigned char* slots = F.lds + F.wave * 16384;
    int t = lw; if (t >= M) return;
    { LAS unsigned* il = (LAS unsigned*)wl; const unsigned char* ip = ids + (size_t)t * 512; il[lane] = *(const unsigned*)(ip + l4); il[64 + lane] = *(const unsigned*)(ip + 256 + l4);
      *(LAS u32x2*)(wl + 512 + 8 * lane) = *(const u32x2*)(xq + (size_t)t * 2048); if (lane < 32) wl[1024 + lane] = xsc[(size_t)t * 128]; }
    UG_LOAD(0, 0, 0, (const LAS unsigned*)wl + (lane >> 3));
    asm volatile("s_waitcnt vmcnt(0)" ::: "memory");
    int buf = 0;
#pragma unroll 1
    for (; t < M; t += nw) {
        const int tn = (t + nw < M) ? t + nw : t;
        const LAS unsigned char* cb = wl + buf * 1152; LAS unsigned char* nb = wl + (buf ^ 1) * 1152;
        const LAS unsigned* idc = (const LAS unsigned*)cb + (lane >> 3); const LAS unsigned char* xc = cb + 512 + 16 * kq;
        const unsigned char* ip = ids + (size_t)tn * 512; const unsigned idn0 = *(const unsigned*)(ip + l4), idn1 = *(const unsigned*)(ip + 256 + l4);
        const u32x2 xn = *(const u32x2*)(xq + (size_t)tn * 2048); const unsigned char sn = xsc[(size_t)tn * 128];
        __builtin_amdgcn_sched_barrier(0);
        f32x4 dacc[8];
#pragma unroll
        for (int T = 0; T < 8; ++T) dacc[T] = (f32x4){0.f, 0.f, 0.f, 0.f};
        UG_LOAD(8, 4, 0, idc); UG_COMP(0, 0, 0, xc, 8);
        UG_LOAD(0, 0, 2, idc); UG_COMP(8, 4, 0, xc, 8);
        { LAS unsigned* il = (LAS unsigned*)nb; il[lane] = idn0; il[64 + lane] = idn1; *(LAS u32x2*)(nb + 512 + 8 * lane) = xn; if (lane < 32) nb[1024 + lane] = sn; }
        UG_LOAD(8, 4, 2, idc); UG_COMP(0, 0, 2, xc, 8);
        UG_LOAD(0, 0, 0, (const LAS unsigned*)nb + (lane >> 3));
        UG_COMP(8, 4, 2, xc, 8);
#pragma unroll
        for (int T = 0; T < 8; ++T) asm volatile("" : "+v"(dacc[T]));
        if (r == 0) {
#pragma unroll
            for (int T = 0; T < 8; ++T) *(f32x4*)(pd + (size_t)t * 128 + 16 * T) = dacc[T]; }
        buf ^= 1;
    }
}
__device__ __forceinline__ unsigned fp4_code_scale(float v, float& back) {
    const unsigned rb = __float_as_uint(fabsf(v) * (1.0f / 6.0f));
    int e = (int)(rb >> 23) - 127 + ((rb & 0x7FFFFFu) != 0u ? 1 : 0); e = e < -120 ? -120 : (e > 120 ? 120 : e);
    const float inv = __uint_as_float((unsigned)(127 - e) << 23), sc = __uint_as_float((unsigned)(127 + e) << 23);
    const unsigned by = __builtin_amdgcn_cvt_scalef32_pk_fp4_f32(0u, v * inv, v * inv, 1.0f, 0);
    const f32x2 dd = FP4X2(by, 0); back = dd.x * sc;
    return (by & 0xFu) | ((unsigned)(e + 127) << 8);
}
__device__ __forceinline__ void p13b_act(const Frame& F, unsigned char* ws) {
    const float* pd = (const float*)(ws + WS_PD); float* gates = (float*)(ws + WS_GATES); const float* ssq2 = (const float*)(ws + WS_SSQ2); unsigned* act = (unsigned*)(ws + WS_ACT);
    const int* ids = (const int*)(ws + WS_IDS); const float* usc = (const float*)(ws + WS_USC); const float* vsc = (const float*)(ws + WS_VSC);
    const bool ok = fp4_probe_ok();
#pragma unroll 1
    for (int token = F.gw; token < M; token += F.NGW) {
        const float r2 = 1.0f / sqrtf(wave_sum(ssq2[(size_t)token * 64 + F.lane]) * (1.0f / D) + EPS);
#pragma unroll
        for (int hh = 0; hh < 2; ++hh) { const size_t o = (size_t)token * 128 + hh * 64 + F.lane; float d = 0.f;
#pragma unroll
            for (int jj = 0; jj < 8; ++jj) d += pd[(size_t)jj * M * 128 + o];
            const int id = ids[o];
            const float a = gelu_erf(d * r2 * usc[id]) * gates[o] * vsc[id];
            float b1; const unsigned t1 = fp4_code_scale(a, b1);
            act[o] = (t1 & 0xFu) * 0x11111111u;
            act[(size_t)M * 128 + o] = ok ? ((t1 >> 8) & 0xFFu) : 0xFFu; }
    }
}
__device__ __forceinline__ void p13c_down(const Frame& F, unsigned char* ws) {
    const int j = F.xj, lw = F.xrank * NWAVES + F.wave, nw = F.xn * NWAVES;
    int lane_ = F.lane; asm volatile("" : "+v"(lane_));
    const int lane = lane_, g = lane >> 4, i = lane & 15; const unsigned i16 = 16u * (unsigned)i, sidx = (unsigned)((i & 3) * 4 + (i >> 2)), l4 = 4u * (unsigned)lane;
    const unsigned sh = 4u * (unsigned)(i & 7), mlo = i < 8 ? (0xFu << sh) : 0u, mhi = i >= 8 ? (0xFu << sh) : 0u;
    i32x8 P1a = {0, 0, 0, 0, 0, 0, 0, 0}, P1b = P1a, Q1a = P1a, Q1b = P1a;
    const unsigned char* vvj = ws + WS_VB + (size_t)j * 16384 * 256; const unsigned char* vsj = ws + WS_VB + PEER_VAL_BYTES + (size_t)j * 16384 * 16;
    const unsigned char* ids = ws + WS_IDS; const unsigned char* av = ws + WS_ACT;
    const bf16_t* h2b = (const bf16_t*)(ws + WS_H2B) + 512 * j + 128 * g + i; bf16_t* h3b = (bf16_t*)(ws + WS_H3B) + 512 * j + 128 * g + i; float* ssq3 = (float*)(ws + WS_SSQ3);
    LAS unsigned* idl = (LAS unsigned*)(F.lds + F.wave * 4096);
    LAS unsigned* al = idl + 256;
    constexpr size_t ASTR = (size_t)M * 128 * 4;
    int t = lw; if (t >= M) return;
    { const unsigned char* ip = ids + (size_t)t * 512; const unsigned char* ap = av + (size_t)t * 512;
      idl[lane] = *(const unsigned*)(ip + l4); idl[64 + lane] = *(const unsigned*)(ip + 256 + l4);
#pragma unroll
      for (int k = 0; k < 2; ++k) { al[256 * k + lane] = *(const unsigned*)(ap + k * ASTR + l4); al[256 * k + 64 + lane] = *(const unsigned*)(ap + k * ASTR + 256 + l4); } }
    PRow A[8], B[8];
    PW_LOAD(A, 0, idl + 32 * g, vvj, vsj);
    int buf = 0;
#pragma unroll 1
    for (; t < M; t += nw) {
        const int tn = (t + nw < M) ? t + nw : t;
        const LAS unsigned* cur = idl + buf * 128 + 32 * g; LAS unsigned* nxt = idl + (buf ^ 1) * 128;
        const LAS unsigned* acur = al + buf * 128 + 32 * g; LAS unsigned* anxt = al + (buf ^ 1) * 128;
        const unsigned char* ip = ids + (size_t)tn * 512; const unsigned char* ap = av + (size_t)tn * 512;
        const unsigned idn0 = *(const unsigned*)(ip + l4), idn1 = *(const unsigned*)(ip + 256 + l4);
        unsigned an[4];
#pragma unroll
        for (int k = 0; k < 2; ++k) { an[2 * k] = *(const unsigned*)(ap + k * ASTR + l4); an[2 * k + 1] = *(const unsigned*)(ap + k * ASTR + 256 + l4); }
        unsigned short hq[8];
#pragma unroll
        for (int k = 0; k < 8; ++k) hq[k] = h2b[(size_t)t * D + 32 * (k & 3) + 16 * (k >> 2)];
        f32x4 y[4];
#pragma unroll
        for (int k = 0; k < 4; ++k) y[k] = (f32x4){0.f, 0.f, 0.f, 0.f};
        PW_LOAD(B, 8, cur, vvj, vsj); PD_COMP(A, 0, acur);
        PW_LOAD(A, 16, cur, vvj, vsj); PD_COMP(B, 8, acur);
        nxt[lane] = idn0; nxt[64 + lane] = idn1;
#pragma unroll
        for (int k = 0; k < 2; ++k) { anxt[256 * k + lane] = an[2 * k]; anxt[256 * k + 64 + lane] = an[2 * k + 1]; }
        PW_LOAD(B, 24, cur, vvj, vsj); PD_COMP(A, 16, acur);
        PW_LOAD(A, 0, nxt + 32 * g, vvj, vsj);
        PD_COMP(B, 24, acur);
        const f32x4 Y0 = y[0] + y[2], Y1 = y[1] + y[3];
        const float h0 = bf2f(hq[0]) + Y0[0], h1 = bf2f(hq[1]) + Y0[1], h2 = bf2f(hq[2]) + Y0[2], h3 = bf2f(hq[3]) + Y0[3];
        const float h4 = bf2f(hq[4]) + Y1[0], h5 = bf2f(hq[5]) + Y1[1], h6 = bf2f(hq[6]) + Y1[2], h7 = bf2f(hq[7]) + Y1[3];
        { bf16_t* op = h3b + (size_t)t * D;
          op[0] = (bf16_t)(cvt_pk_bf16(h0, h0) & 0xffffu); op[32] = (bf16_t)(cvt_pk_bf16(h1, h1) & 0xffffu); op[64] = (bf16_t)(cvt_pk_bf16(h2, h2) & 0xffffu); op[96] = (bf16_t)(cvt_pk_bf16(h3, h3) & 0xffffu);
          op[16] = (bf16_t)(cvt_pk_bf16(h4, h4) & 0xffffu); op[48] = (bf16_t)(cvt_pk_bf16(h5, h5) & 0xffffu); op[80] = (bf16_t)(cvt_pk_bf16(h6, h6) & 0xffffu); op[112] = (bf16_t)(cvt_pk_bf16(h7, h7) & 0xffffu); }
        const float ss = wave_sum(((h0 * h0 + h1 * h1) + (h2 * h2 + h3 * h3)) + ((h4 * h4 + h5 * h5) + (h6 * h6 + h7 * h7)));
        if (lane == 0) ssq3[(size_t)t * 8 + j] = ss;
        buf ^= 1;
    }
}
__device__ __forceinline__ void p13d_final(const Frame& F, unsigned char* ws, const float* g_final, float* out) {
    const bf16_t* h3b = (const bf16_t*)(ws + WS_H3B); const float* ssq3 = (const float*)(ws + WS_SSQ3);
    int lane_ = F.lane; asm volatile("" : "+v"(lane_)); const int lane = lane_;
    f32x4 g0[8], g1[8];
#pragma unroll
    for (int p = 0; p < 8; ++p) { g0[p] = *(const f32x4*)(g_final + p * 512 + lane * 8); g1[p] = *(const f32x4*)(g_final + p * 512 + lane * 8 + 4); }
#pragma unroll 1
    for (int token = F.gw; token < M; token += F.NGW) {
        const float rf = 1.0f / sqrtf(wave_sum(lane < 8 ? ssq3[(size_t)token * 8 + lane] : 0.f) * (1.0f / D) + EPS);
        u32x4 hv[8];
#pragma unroll
        for (int p = 0; p < 8; ++p) hv[p] = *(const u32x4*)(h3b + (size_t)token * D + p * 512 + lane * 8);
#pragma unroll
        for (int p = 0; p < 8; ++p) { float* op = out + (size_t)token * D + p * 512 + lane * 8;
            *(f32x4*)op = (f32x4){BF_LO(hv[p].x) * rf * g0[p][0], BF_HI(hv[p].x) * rf * g0[p][1], BF_LO(hv[p].y) * rf * g0[p][2], BF_HI(hv[p].y) * rf * g0[p][3]};
            *(f32x4*)(op + 4) = (f32x4){BF_LO(hv[p].z) * rf * g1[p][0], BF_HI(hv[p].z) * rf * g1[p][1], BF_LO(hv[p].w) * rf * g1[p][2], BF_HI(hv[p].w) * rf * g1[p][3]}; }
    }
}

__device__ __forceinline__ void final_norm_rows(const Frame& F, const float* h, const float* g, float* out) {
    for (int m = F.gw; m < M; m += F.NGW) {
        const f32x4* xr = (const f32x4*)(h + (size_t)m * D); const f32x4* gr = (const f32x4*)g; f32x4* xo = (f32x4*)(out + (size_t)m * D);
        f32x4 v[16]; float ss = 0.f;
#pragma unroll
        for (int j = 0; j < 16; ++j) v[j] = xr[F.lane + 64 * j];
#pragma unroll
        for (int j = 0; j < 16; ++j) ss += (v[j][0] * v[j][0] + v[j][1] * v[j][1]) + (v[j][2] * v[j][2] + v[j][3] * v[j][3]);
        ss = wave_sum(ss); const float r = 1.0f / sqrtf(ss * (1.0f / D) + EPS);
#pragma unroll
        for (int j = 0; j < 16; ++j) xo[F.lane + 64 * j] = v[j] * r * gr[F.lane + 64 * j];
    }
}

__global__ void __launch_bounds__(NTHREADS, 2) mega_fwd(Args args) {
    extern __shared__ __attribute__((aligned(16))) unsigned char lds_raw[];
    Frame F;
    F.lds = (LAS unsigned char*)lds_raw;
    F.tid = threadIdx.x; F.lane = F.tid & 63; F.wave = __builtin_amdgcn_readfirstlane(F.tid >> 6);
    F.G = gridDim.x; F.bid = blockIdx.x; F.gw = F.bid * NWAVES + F.wave; F.NGW = F.G * NWAVES;
    volatile LAS unsigned* MISC = (volatile LAS unsigned*)(F.lds + MISC_OFF);
    if (F.tid < 16) MISC[F.tid] = 0u;
    __syncthreads();
    XcdBarrier bar = xcd_barrier_post((unsigned*)(args.ws + WS_CTL), MISC + 8);
    const int lo = args.ph_lo, hi = args.ph_hi;
#define IN(k) (lo <= (k) && (k) < hi)
#define BOTH(k) (IN(k) && IN((k) + 1))
#define GRID_BAR() xcd_barrier(bar)

    unsigned char* ws = args.ws;
#define GEMM(KINDS, k) gemm_run<KINDS>(F.lds, args.in[0], args.out, ws, (k), F.G, F.bid)
    if (IN(0)) { p0_prologue(F, args); if (BOTH(0)) GRID_BAR(); }
    if (IN(1)) {
#pragma unroll 1
        for (int gi = 0; gi < 3; ++gi) GEMM(3, gi);
        if (BOTH(1)) GRID_BAR(); }
    if (IN(2)) { p2_stats(F, ws); p2_gla_prep(F, ws, args.in[11], args.in[12]); if (BOTH(2)) GRID_BAR(); }
    if (IN(3)) {
#pragma unroll 1
        for (int gi = 3; gi < 5; ++gi) GEMM(1, gi);
        p3_gla_att(F, ws);
        if (BOTH(3)) GRID_BAR(); }
    if (IN(4)) { p4_mla(F, ws);   }
    if (IN(5)) { p5_gla_scan(F, ws); if (BOTH(5)) GRID_BAR(); }
    if (IN(6)) { p6_mix(F, ws, args.in[10], args.in[13]); if (BOTH(6)) GRID_BAR(); }
    if (IN(7)) {
        GEMM(4, 5);
        if (BOTH(7)) GRID_BAR(); }
    if (IN(8)) {
        { pg8::StaticOrder S; S.init(M, 1024, F.G, F.bid); rstd_for_units(F, S, (const float*)(ws + WS_SSQ1), (float*)(ws + WS_RSTD1)); }
        GEMM(1, 6);
        if (BOTH(8)) GRID_BAR(); }
    if (IN(9)) { p9_xattn(F, ws); if (BOTH(9)) GRID_BAR(); }
    if (IN(10)) {
        GEMM(4, 7);
        if (BOTH(10)) GRID_BAR(); }
    if (IN(11)) {
        { pg8::StaticOrder S; S.init(M, 2048, F.G, F.bid); rstd_for_units(F, S, (const float*)(ws + WS_SSQ2), (float*)(ws + WS_RSTD2)); }
        GEMM(1, 8);
        p12c_quant(F, ws, args.in[20]);
        if (BOTH(11)) GRID_BAR(); }
    if (IN(12)) {
        p12_keys_to_lds(F, ws); __syncthreads();
#pragma unroll 1
        for (int s = 0; s < 2; ++s) { if (((s ^ (F.wave >> 2)) & 1) != 0) peer_tables_to_fp4(F, ws, args.in[23], args.in[24]); else p12_topk(F, ws); }
        if (BOTH(12)) GRID_BAR(); }
    if (IN(13)) {
        { const unsigned nx = MISC[9], nloc = MISC[8], rk = MISC[10];
          const bool hw = (nx == 8u) && (bar.x < 8u) && (nloc > 0u) && (lo < 13);
          F.xj = hw ? (int)bar.x : (F.bid & 7); F.xrank = hw ? (int)rk : (F.bid >> 3); F.xn = hw ? (int)nloc : ((F.G - 1 - (F.bid & 7)) / 8 + 1); }
        p13a_up(F, ws); GRID_BAR(); p13b_act(F, ws); GRID_BAR(); p13c_down(F, ws); GRID_BAR(); p13d_final(F, ws, args.in[25], args.out);
    }
#undef GEMM
#undef IN
#undef BOTH
}

extern "C" void kernel_launch(void* const* d_in, const int* in_sizes, int n_in, void* d_out, int out_size, void* d_ws, size_t ws_size, hipStream_t stream) {
    static int grid = 0;
    if (grid == 0) {
        if (n_in != 26 || out_size != M * D || ws_size < WS_END0) { fprintf(stderr, "kernel_launch: unexpected problem (n_in %d out %d ws %zu need %zu)\n", n_in, out_size, ws_size, (size_t)WS_END0); grid = -1; return; }
        int dev = 0, cus = 0, per_cu = 0;
        if (hipGetDevice(&dev) != hipSuccess || hipDeviceGetAttribute(&cus, hipDeviceAttributeMultiprocessorCount, dev) != hipSuccess) { grid = -1; return; }
        if (hipFuncSetAttribute((const void*)mega_fwd, hipFuncAttributeMaxDynamicSharedMemorySize, LDS_BYTES) != hipSuccess) { fprintf(stderr, "kernel_launch: hipFuncSetAttribute failed\n"); grid = -1; return; }
        if (hipOccupancyMaxActiveBlocksPerMultiprocessor(&per_cu, (const void*)mega_fwd, NTHREADS, LDS_BYTES) != hipSuccess || per_cu < 1) { fprintf(stderr, "kernel_launch: occupancy query says %d\n", per_cu); }
        (void)hipGetLastError();
        if (cus < 8) { fprintf(stderr, "kernel_launch: needs at least 8 CUs\n"); grid = -1; return; }
        grid = cus;
    }
    if (grid < 0) return;
    (void)hipMemsetAsync((char*)d_ws + WS_CTL, 0, CTL_BYTES, stream);
    Args a{};
    for (int i = 0; i < 26; ++i) a.in[i] = (const float*)d_in[i];
    a.out = (float*)d_out; a.ws = (unsigned char*)d_ws; a.ph_lo = 0; a.ph_hi = 14;
    hipLaunchKernelGGL(mega_fwd, dim3(grid), dim3(NTHREADS), LDS_BYTES, stream, a);
}
```
